# Optimizing an MI355X kernel written in HIP

```python
import jax, jax.numpy as jnp
from jax import lax
import numpy as np

D_MODEL = 2048
BATCH = 2
SEQ = 8192
DEPTH = 1

MIX_WIDTH = D_MODEL
HEAD_DIM = 64
RWKV_WIDTH = MIX_WIDTH // 2
FOX_WIDTH = MIX_WIDTH - RWKV_WIDTH
RWKV_HEADS = RWKV_WIDTH // HEAD_DIM
FOX_HEADS = FOX_WIDTH // HEAD_DIM
DECAY_LORA = 64
ICLR_LORA = 64
GATE_LORA = 128
RWKV_COLS = 3 * RWKV_WIDTH + DECAY_LORA + ICLR_LORA + GATE_LORA
FOX_COLS = 3 * FOX_WIDTH + FOX_HEADS
IN_COLS = RWKV_COLS + FOX_COLS
Q_BLOCK = 128
RMS_EPS = 1e-6
LNX_EPS = 64e-5
PEER_HEADS = 8
PEER_NKEYS = 128
PEER_EXPERTS = PEER_NKEYS * PEER_NKEYS
PEER_QDIM = 128
PEER_HALF = PEER_QDIM // 2
PEER_TOPK = 16
PEER_TOK_BLOCK = 128

kernel_name = "hymba_rwkv7_fox_peer_layer"


def rms_norm(x, g):
    xf = x.astype(jnp.float32)
    xf = xf * lax.rsqrt(jnp.mean(xf * xf, axis=-1, keepdims=True) + RMS_EPS)
    return (xf * g.astype(jnp.float32)).astype(x.dtype)


def rwkv7_scan(r, decay, k, v, a, b):
    B, S, H, N = r.shape

    def step(state, xs):
        r_t, w_t, k_t, v_t, a_t, b_t = xs
        sa = jnp.einsum('bhvk,bhk->bhv', state, a_t)
        state = (state * w_t[:, :, None, :]
                 + sa[..., None] * b_t[:, :, None, :]
                 + v_t[..., None] * k_t[:, :, None, :])
        y = jnp.einsum('bhvk,bhk->bhv', state, r_t)
        return state, y

    xs = tuple(jnp.moveaxis(t.astype(jnp.float32), 1, 0) for t in (r, decay, k, v, a, b))
    state0 = jnp.zeros((B, H, N, N), jnp.float32)
    _, ys = lax.scan(step, state0, xs)
    return jnp.moveaxis(ys, 0, 1)


def rwkv7_group(p, mu_shift, w_decay_up, w0, w_iclr_up, a0, w_gate_up, k_k, k_a, r_k, lnx_g, lnx_b):
    B, S, _ = p.shape
    H, N = RWKV_HEADS, HEAD_DIM
    pf = p.astype(jnp.float32)
    prev = jnp.pad(pf, ((0, 0), (1, 0), (0, 0)))[:, :-1]
    pf = pf + mu_shift.astype(jnp.float32) * (prev - pf)
    o = np.cumsum([RWKV_WIDTH, RWKV_WIDTH, RWKV_WIDTH, DECAY_LORA, ICLR_LORA])
    r, k, v, wd, ad, gd = jnp.split(pf, o.tolist(), axis=-1)
    w_raw = -jax.nn.softplus(-(w0 + jnp.tanh(wd) @ w_decay_up)) - 0.5
    decay = jnp.exp(-jnp.exp(w_raw))
    a = jax.nn.sigmoid(a0 + ad @ w_iclr_up)
    g = jax.nn.sigmoid(gd) @ w_gate_up
    kk = (k * k_k).reshape(B, S, H, N)
    kk = kk / jnp.maximum(jnp.linalg.norm(kk, axis=-1, keepdims=True), 1e-12)
    k = k * (1.0 + (a - 1.0) * k_a)
    hs = lambda t: t.reshape(B, S, H, N)
    r_h, k_h, v_h, a_h = hs(r), hs(k), hs(v), hs(a)
    y = rwkv7_scan(r_h, hs(decay), k_h, v_h, -kk, kk * a_h)
    mean = jnp.mean(y, axis=-1, keepdims=True)
    var = jnp.mean(jnp.square(y - mean), axis=-1, keepdims=True)
    y = ((y - mean) * lax.rsqrt(var + LNX_EPS)).reshape(B, S, RWKV_WIDTH) * lnx_g + lnx_b
    bonus = jnp.sum(r_h * k_h * r_k, axis=-1, keepdims=True) * v_h
    y = (y + bonus.reshape(B, S, RWKV_WIDTH)) * g
    return y.astype(p.dtype)


def fox_group(p, fox_b_f, q_norm_g, k_norm_g):
    B, S, _ = p.shape
    H, D = FOX_HEADS, HEAD_DIM
    NB = S // Q_BLOCK
    o = np.cumsum([FOX_WIDTH, FOX_WIDTH, FOX_WIDTH])
    q, k, v, f_logit = jnp.split(p, o.tolist(), axis=-1)
    q = rms_norm(q.reshape(B, S, H, D), q_norm_g).transpose(0, 2, 1, 3)
    k = rms_norm(k.reshape(B, S, H, D), k_norm_g).transpose(0, 2, 1, 3)
    v = v.reshape(B, S, H, D).transpose(0, 2, 1, 3)
    log_f = jax.nn.log_sigmoid(f_logit.astype(jnp.float32) + fox_b_f.astype(jnp.float32))
    c = jnp.cumsum(log_f, axis=1).transpose(0, 2, 1)
    scale = HEAD_DIM ** -0.5
    q_blocks = jnp.moveaxis(q.reshape(B, H, NB, Q_BLOCK, D), 2, 0)
    c_blocks = jnp.moveaxis(c.reshape(B, H, NB, Q_BLOCK), 2, 0)
    starts = jnp.arange(NB, dtype=jnp.int32) * Q_BLOCK
    key_pos = jnp.arange(S, dtype=jnp.int32)

    def attend(args):
        qb, cb, start = args
        s = jnp.einsum('bhqd,bhkd->bhqk', qb, k).astype(jnp.float32) * scale
        s = s + cb[..., :, None] - c[:, :, None, :]
        q_pos = start + jnp.arange(Q_BLOCK, dtype=jnp.int32)
        mask = key_pos[None, :] <= q_pos[:, None]
        s = jnp.where(mask, s, -jnp.inf)
        prob = jax.nn.softmax(s, axis=-1)
        return jnp.einsum('bhqk,bhkd->bhqd', prob.astype(v.dtype), v)

    out = lax.map(attend, (q_blocks, c_blocks, starts))
    return out.transpose(1, 0, 3, 2, 4).reshape(B, S, FOX_WIDTH).astype(p.dtype)


def peer(xn, w_q, sub_keys, u_tab, v_tab):
    B, S, D = xn.shape
    T = B * S
    xt = xn.reshape(T // PEER_TOK_BLOCK, PEER_TOK_BLOCK, D)

    def block(xb):
        q = (xb @ w_q).reshape(PEER_TOK_BLOCK, PEER_HEADS, 2, PEER_HALF).astype(jnp.float32)
        s = jnp.einsum('thpd,hpnd->thpn', q, sub_keys.astype(jnp.float32))
        s1, i1 = lax.top_k(s[:, :, 0], PEER_TOPK)
        s2, i2 = lax.top_k(s[:, :, 1], PEER_TOPK)
        cand = (s1[..., :, None] + s2[..., None, :]).reshape(PEER_TOK_BLOCK, PEER_HEADS, PEER_TOPK * PEER_TOPK)
        cidx = (i1[..., :, None] * PEER_NKEYS + i2[..., None, :]).reshape(PEER_TOK_BLOCK, PEER_HEADS, PEER_TOPK * PEER_TOPK)
        top, pos = lax.top_k(cand, PEER_TOPK)
        idx = jnp.take_along_axis(cidx, pos, axis=-1)
        gate = jax.nn.softmax(top, axis=-1)
        u = u_tab[idx]
        h = jax.nn.gelu(jnp.einsum('thkd,td->thk', u, xb), approximate=False)
        vv = v_tab[idx]
        return jnp.einsum('thk,thkd->td', gate.astype(h.dtype) * h, vv)

    return lax.map(block, xt).reshape(B, S, D).astype(xn.dtype)


def setup_inputs(seed: int = 0) -> dict:
    key = jax.random.key(seed)
    ks = jax.random.split(key, 24)
    L = DEPTH
    f32 = jnp.float32
    nrm = lambda k, shape, sc: jax.random.normal(k, shape, f32) * sc
    return {
        "x": nrm(ks[0], (BATCH, SEQ, D_MODEL), 1.0),
        "norm1_g": 1.0 + nrm(ks[1], (L, D_MODEL), 0.02),
        "w_in": nrm(ks[2], (L, D_MODEL, IN_COLS), D_MODEL ** -0.5),
        "mu_shift": jax.random.uniform(ks[3], (L, RWKV_COLS), f32, 0.0, 1.0),
        "w_decay_up": nrm(ks[4], (L, DECAY_LORA, RWKV_WIDTH), 0.5 * DECAY_LORA ** -0.5),
        "w0": jax.random.uniform(ks[5], (L, RWKV_WIDTH), f32, -5.0, 0.0),
        "w_iclr_up": nrm(ks[6], (L, ICLR_LORA, RWKV_WIDTH), 0.5 * ICLR_LORA ** -0.5),
        "a0": nrm(ks[7], (L, RWKV_WIDTH), 0.5),
        "w_gate_up": nrm(ks[8], (L, GATE_LORA, RWKV_WIDTH), GATE_LORA ** -0.5),
        "k_k": 0.85 + nrm(ks[9], (L, RWKV_WIDTH), 0.05),
        "k_a": 1.0 + nrm(ks[10], (L, RWKV_WIDTH), 0.05),
        "r_k": nrm(ks[11], (L, RWKV_HEADS, HEAD_DIM), 0.1),
        "lnx_g": 1.0 + nrm(ks[12], (L, RWKV_WIDTH), 0.02),
        "lnx_b": nrm(ks[13], (L, RWKV_WIDTH), 0.02),
        "fox_b_f": jax.random.uniform(ks[14], (L, FOX_HEADS), f32, 1.0, 5.0),
        "q_norm_g": 1.0 + nrm(ks[15], (L, HEAD_DIM), 0.02),
        "k_norm_g": 1.0 + nrm(ks[16], (L, HEAD_DIM), 0.02),
        "w_out": nrm(ks[17], (L, MIX_WIDTH, D_MODEL), MIX_WIDTH ** -0.5),
        "norm2_g": 1.0 + nrm(ks[18], (L, D_MODEL), 0.02),
        "peer_w_q": nrm(ks[19], (L, D_MODEL, PEER_HEADS * PEER_QDIM), D_MODEL ** -0.5),
        "peer_sub_keys": nrm(ks[20], (L, PEER_HEADS, 2, PEER_NKEYS, PEER_HALF), PEER_HALF ** -0.5),
        "peer_u": nrm(ks[21], (L, PEER_EXPERTS, D_MODEL), D_MODEL ** -0.5),
        "peer_v": nrm(ks[22], (L, PEER_EXPERTS, D_MODEL), D_MODEL ** -0.5),
    }


def reference(x, norm1_g, w_in, mu_shift, w_decay_up, w0, w_iclr_up, a0, w_gate_up,
              k_k, k_a, r_k, lnx_g, lnx_b, fox_b_f, q_norm_g, k_norm_g, w_out,
              norm2_g, peer_w_q, peer_sub_keys, peer_u, peer_v):
    h = x
    for l in range(DEPTH):
        xn = rms_norm(h, norm1_g[l])
        proj = xn @ w_in[l]
        p_rwkv, p_fox = proj[..., :RWKV_COLS], proj[..., RWKV_COLS:]
        y_rwkv = rwkv7_group(p_rwkv, mu_shift[l], w_decay_up[l], w0[l], w_iclr_up[l], a0[l],
                             w_gate_up[l], k_k[l], k_a[l], r_k[l], lnx_g[l], lnx_b[l])
        y_fox = fox_group(p_fox, fox_b_f[l], q_norm_g[l], k_norm_g[l])
        mixed = jnp.concatenate([y_rwkv.astype(h.dtype), y_fox.astype(h.dtype)], axis=-1)
        h = h + (mixed @ w_out[l]).astype(h.dtype)
        h = h + peer(rms_norm(h, norm2_g[l]), peer_w_q[l], peer_sub_keys[l], peer_u[l], peer_v[l])
    return h
```

```cpp
#include <hip/hip_runtime.h>
#include <cstdio>
#include <cstdint>
namespace pg8 {
#define PG8_LAS __attribute__((address_space(3)))
typedef unsigned short bf16_t;
typedef short bf16x8 __attribute__((ext_vector_type(8)));
typedef float f32x4 __attribute__((ext_vector_type(4)));
typedef unsigned u32x4 __attribute__((ext_vector_type(4)));
constexpr int BM = 256, BK = 64, HALF = 128, HTB = HALF * BK * 2  , STAGE_BYTES = 8 * HTB, NXCD = 8, WGM = 8;

__host__ __device__ __forceinline__ int lds_byte(int r, int c) { const int st = (r >> 4) * 2 + (c >> 5), rr = r & 15, cc = c & 31, ob = rr * 64 + cc * 2; return st * 1024 + (ob ^ (((ob >> 9) & 1) << 5)); }
__host__ __device__ __forceinline__ void stage_rc(int b, int& R, int& C) { const int st = b / 1024, sb = b % 1024, swz = sb ^ (((sb >> 9) & 1) << 5); R = (st >> 1) * 16 + swz / 64; C = (st & 1) * 32 + (swz % 64) / 2; }
__host__ __device__ __forceinline__ int perm32(int rho) { const int n = rho >> 4, i = rho & 15; return 8 * (i >> 2) + 4 * n + (i & 3); }

struct Unit { int pm, pn; };
struct Gemm { const bf16_t* A; const bf16_t* Bt; int M, N, K; };

struct StaticOrder {
    int nM, nN, nwg, G, c;
    __host__ __device__ void init(int M, int N, int G_, int c_) { nM = M / BM; nN = N / BM; nwg = nM * nN; G = G_; c = c_; }
    __host__ __device__ bool next(int i, Unit& u) const {
        const long L = (long)i * G + c; if (L >= nwg) return false;
        int wgid = (int)L; { const int q = nwg / NXCD, r = nwg % NXCD, xcd = wgid % NXCD, off = wgid / NXCD; wgid = (xcd < r ? xcd * (q + 1) : r * (q + 1) + (xcd - r) * q) + off; }
        const int nig = WGM * nN, gid = wgid / nig, fm = gid * WGM, gsz = (nM - fm) < WGM ? (nM - fm) : WGM;
        u.pm = fm + ((wgid % nig) % gsz); u.pn = (wgid % nig) / gsz; return true;
    }
    __device__ __forceinline__ void a_ready(const Unit&) const {}
    __device__ __forceinline__ void done(const Unit&) const {}
};

__device__ __forceinline__ unsigned cvt_pk_bf16(float lo, float hi) { unsigned r; asm volatile("v_cvt_pk_bf16_f32 %0, %1, %2" : "=v"(r) : "v"(lo), "v"(hi)); return r; }
typedef float f32x2 __attribute__((ext_vector_type(2)));
__device__ __forceinline__ f32x2 gelu_pk(f32x2 v) {
    const f32x2 av = __builtin_elementwise_abs(v), d = av * 0.2316418882f + 1.0f;
    f32x2 t; t.x = __builtin_amdgcn_rcpf(d.x); t.y = __builtin_amdgcn_rcpf(d.y);
    f32x2 q = t * 0.5307027145f + (-0.7265760135f); q = q * t + 0.7107068705f; q = q * t + (-0.142248368f); q = q * t + 0.127414796f; q = q * t;
    const f32x2 s = (v * v) * (-0.72134752044f);
    f32x2 e; e.x = __builtin_amdgcn_exp2f(s.x); e.y = __builtin_amdgcn_exp2f(s.y);
    const f32x2 m = v * (q * e), r = v - m;
    f32x2 o; o.x = v.x < 0.f ? m.x : r.x; o.y = v.y < 0.f ? m.y : r.y; return o;
}

template <int ACT  > struct EpiBf16 {
    static constexpr bool PERM = true, AFTER_DRAIN = false; static_assert(ACT == 0 || ACT == 1, "EpiBf16: ACT is 0 (none) or 1 (gelu_pk)");
    bf16_t* O; int ldc; const float* bias; int split_cols; size_t split_stride; float scale0;
    __device__ __forceinline__ void operator()(const f32x4 (&acc)[2][2][4][2], const Unit& u, int wr, int wc, int fr, int fq) const {
        const int row0 = u.pm * BM + wr * 64 + fr; int colt = u.pn * BM; bf16_t* base = O;
        float sc = 1.f; if (split_cols) { const int t = colt / split_cols; base += (size_t)t * split_stride; colt -= t * split_cols; if (t == 0) sc = scale0; }
        const int col0 = colt + wc * 32 + 8 * fq, bcol0 = u.pn * BM + wc * 32 + 8 * fq;
        f32x4 bv[2][2];
#pragma unroll
        for (int bj = 0; bj < 2; ++bj)
#pragma unroll
            for (int n = 0; n < 2; ++n) bv[bj][n] = bias ? *(const f32x4*)(bias + bcol0 + bj * HALF + 4 * n) : (f32x4){0.f, 0.f, 0.f, 0.f};
#pragma unroll
        for (int ai = 0; ai < 2; ++ai)
#pragma unroll
            for (int m = 0; m < 4; ++m) { bf16_t* rowp = base + (size_t)(row0 + ai * HALF + m * 16) * ldc + col0;
#pragma unroll
                for (int bj = 0; bj < 2; ++bj) { f32x4 v0 = acc[ai][bj][m][0] + bv[bj][0], v1 = acc[ai][bj][m][1] + bv[bj][1];
                    if (ACT == 1) { f32x2 a = gelu_pk((f32x2){v0[0], v0[1]}), b = gelu_pk((f32x2){v0[2], v0[3]}), c = gelu_pk((f32x2){v1[0], v1[1]}), d = gelu_pk((f32x2){v1[2], v1[3]});
                        v0 = (f32x4){a.x, a.y, b.x, b.y}; v1 = (f32x4){c.x, c.y, d.x, d.y}; }
                    v0 = v0 * sc; v1 = v1 * sc; u32x4 w; w.x = cvt_pk_bf16(v0[0], v0[1]); w.y = cvt_pk_bf16(v0[2], v0[3]); w.z = cvt_pk_bf16(v1[0], v1[1]); w.w = cvt_pk_bf16(v1[2], v1[3]);
                    *(u32x4*)(rowp + bj * HALF) = w; } }
    }
};

typedef unsigned u32x2 __attribute__((ext_vector_type(2)));
struct EpiResF32 {
    static constexpr bool PERM = false, AFTER_DRAIN = false;
    const float* base; float* out; int ldc;
    __device__ __forceinline__ void operator()(const f32x4 (&acc)[2][2][4][2], const Unit& u, int wr, int wc, int fr, int fq) const {
        const int col0 = u.pn * BM + wc * 32 + 4 * fq;
#pragma unroll
        for (int ai = 0; ai < 2; ++ai)
#pragma unroll
            for (int m = 0; m < 4; ++m) { const size_t off = (size_t)(u.pm * BM + ai * HALF + wr * 64 + m * 16 + fr) * ldc + col0;
#pragma unroll
                for (int bj = 0; bj < 2; ++bj)
#pragma unroll
                    for (int n = 0; n < 2; ++n) { const f32x4 b = *(const f32x4*)(base + off + bj * HALF + n * 16); *(f32x4*)(out + off + bj * HALF + n * 16) = b + acc[ai][bj][m][n]; }
                asm volatile("" ::: "memory"); }
    }
};
template <int MODE> struct EpiLora {
    static constexpr bool PERM = false, AFTER_DRAIN = false;
    const float* vec; float* outf; bf16_t* outh;
    __device__ __forceinline__ void operator()(const f32x4 (&acc)[2][2][4][2], const Unit& u, int wr, int wc, int fr, int fq) const {
        const int col0 = u.pn * BM + wc * 32 + 4 * fq;
#pragma unroll
        for (int bj = 0; bj < 2; ++bj)
#pragma unroll
            for (int n = 0; n < 2; ++n) { const int col = col0 + bj * HALF + n * 16;
                f32x4 p = (f32x4){0.f, 0.f, 0.f, 0.f}; if (vec) p = *(const f32x4*)(vec + col);
#pragma unroll
                for (int ai = 0; ai < 2; ++ai)
#pragma unroll
                    for (int m = 0; m < 4; ++m) { const size_t off = (size_t)(u.pm * BM + ai * HALF + wr * 64 + m * 16 + fr) * 1024 + col;
                        const f32x4 z = acc[ai][bj][m][n] + p;
                        if (MODE == 0) *(f32x4*)(outf + off) = z;
                        else { u32x2 w; w.x = cvt_pk_bf16(z[0], z[1]); w.y = cvt_pk_bf16(z[2], z[3]); *(u32x2*)(outh + off) = w; } } }
    }
};
template <class Epi, class Sched, bool ALIGN_EPI = false, bool SP2 = false>
__device__ __forceinline__ void gemm_phase(PG8_LAS unsigned char* lds, const Gemm g, const Sched& S, const Epi& E, int tid_in) {
    int tid_ = tid_in; asm volatile("" : "+v"(tid_));
    const int tid = tid_, wid = __builtin_amdgcn_readfirstlane(tid >> 6), lane = tid & 63, wr = wid >> 2, wc = wid & 3, fr = lane & 15, fq = lane >> 4;
    const int K = g.K, nt = K / BK;
    unsigned voffA[2], voffB[2];
#pragma unroll
    for (int i = 0; i < 2; ++i) { int R, C; stage_rc(tid * 16 + i * 8192, R, C); const int Rb = Epi::PERM ? ((R & ~31) + perm32(R & 31)) : R;
        voffA[i] = (unsigned)(R * K + C) * 2u; voffB[i] = (unsigned)(Rb * K + C) * 2u; }
    const size_t kstep = (size_t)(BK * 2);
    const size_t hstep = (size_t)HALF * K * 2;
    const size_t tstep = 2 * hstep;
    const unsigned ldsw = (unsigned)wid * 1024u;
    const int aoff = lds_byte(wr * 64 + fr, fq * 8), boff = lds_byte(wc * 32 + fr, fq * 8);
#define PG8_SA(b, h) (((b) * 2 + (h)) * HTB)
#define PG8_SB(b, h) ((4 + (b) * 2 + (h)) * HTB)
#define PG8_STAGE(bufoff, gbase, voff) do { _Pragma("unroll") for (int _i = 0; _i < 2; ++_i) \
        __builtin_amdgcn_global_load_lds((const unsigned*)((const char*)(gbase) + (voff)[_i]), (PG8_LAS unsigned*)(lds + (bufoff) + ldsw + _i * 8192), 16, 0, 0); } while (0)
#define PG8_LDA(dst, b, h) do { _Pragma("unroll") for (int m = 0; m < 4; ++m) _Pragma("unroll") for (int k = 0; k < 2; ++k) dst[m][k] = *(const PG8_LAS bf16x8*)(lds + PG8_SA(b, h) + aoff + m * 2048 + k * 1024); } while (0)
#define PG8_LDB(dst, b, h) do { _Pragma("unroll") for (int n = 0; n < 2; ++n) _Pragma("unroll") for (int k = 0; k < 2; ++k) dst[n][k] = *(const PG8_LAS bf16x8*)(lds + PG8_SB(b, h) + boff + n * 2048 + k * 1024); } while (0)
#define PG8_MMA(ai, bj, At, Bt) do { __builtin_amdgcn_s_setprio(1); _Pragma("unroll") for (int m = 0; m < 4; ++m) _Pragma("unroll") for (int n = 0; n < 2; ++n) _Pragma("unroll") for (int k = 0; k < 2; ++k) \
        acc[ai][bj][m][n] = __builtin_amdgcn_mfma_f32_16x16x32_bf16(Bt[n][k], At[m][k], acc[ai][bj][m][n], 0, 0, 0); __builtin_amdgcn_s_setprio(0); } while (0)
#define PG8_WAIT_V(n) asm volatile("s_waitcnt vmcnt(" #n ")" ::: "memory")
#define PG8_WAIT_L(n) asm volatile("s_waitcnt lgkmcnt(" #n ")" ::: "memory")
#define PG8_BAR __builtin_amdgcn_s_barrier()
#define PG8_SCHED __builtin_amdgcn_sched_barrier(0)
    Unit cur, nxt; int ui = 0;
    if (!S.next(0, cur)) return;
    f32x4 acc[2][2][4][2];
#pragma unroll
    for (int a = 0; a < 2; ++a)
#pragma unroll
        for (int b = 0; b < 2; ++b)
#pragma unroll
            for (int m = 0; m < 4; ++m)
#pragma unroll
                for (int n = 0; n < 2; ++n) acc[a][b][m][n] = (f32x4){0.f, 0.f, 0.f, 0.f};
    bf16x8 At[4][2], B0[2][2], B1[2][2];
    const char* cA = (const char*)g.A + (size_t)cur.pm * tstep; const char* cB = (const char*)g.Bt + (size_t)cur.pn * tstep;
    S.a_ready(cur);
    if constexpr (SP2) {
        PG8_STAGE(PG8_SB(0, 0), cB, voffB); PG8_STAGE(PG8_SB(0, 1), cB + hstep, voffB); PG8_STAGE(PG8_SA(0, 0), cA, voffA); PG8_STAGE(PG8_SA(0, 1), cA + hstep, voffA);
        if (wr == 1) PG8_BAR;
        PG8_WAIT_V(2); PG8_BAR;
        PG8_STAGE(PG8_SB(1, 0), cB + kstep, voffB); PG8_STAGE(PG8_SA(1, 0), cA + kstep, voffA); PG8_STAGE(PG8_SB(1, 1), cB + hstep + kstep, voffB);
        PG8_WAIT_V(6); PG8_BAR;
    } else {
        PG8_STAGE(PG8_SB(0, 0), cB, voffB); PG8_STAGE(PG8_SA(0, 0), cA, voffA); PG8_STAGE(PG8_SB(0, 1), cB + hstep, voffB); PG8_STAGE(PG8_SA(0, 1), cA + hstep, voffA);
        if (wr == 1) PG8_BAR;
        PG8_WAIT_V(4); PG8_BAR;
        PG8_STAGE(PG8_SB(1, 0), cB + kstep, voffB); PG8_STAGE(PG8_SA(1, 0), cA + kstep, voffA); PG8_STAGE(PG8_SB(1, 1), cB + hstep + kstep, voffB);
        PG8_WAIT_V(6); PG8_BAR;
    }
    for (;;) {
        const bool has_next = S.next(ui + 1, nxt);
        const char* nA = has_next ? (const char*)g.A + (size_t)nxt.pm * tstep : cA; const char* nB = has_next ? (const char*)g.Bt + (size_t)nxt.pn * tstep : cB;
        for (int t = 0; t < nt; t += 2) {
            const bool last = (t == nt - 2);
            const char* a1 = cA + (size_t)(t + 1) * kstep;
            const char* a2 = last ? nA : cA + (size_t)(t + 2) * kstep; const char* b2 = last ? nB : cB + (size_t)(t + 2) * kstep;
            const char* a3 = a2 + kstep; const char* b3 = b2 + kstep;
            if (last && has_next) S.a_ready(nxt);
            if constexpr (SP2) {
            PG8_LDB(B0, 0, 0); PG8_LDB(B1, 0, 1); PG8_SCHED; PG8_LDA(At, 0, 0); PG8_STAGE(PG8_SA(1, 1), a1 + hstep, voffA);
            PG8_WAIT_V(8); PG8_WAIT_L(0); PG8_BAR; PG8_MMA(0, 0, At, B0); PG8_MMA(0, 1, At, B1); PG8_BAR; PG8_SCHED;
            PG8_LDA(At, 0, 1); PG8_STAGE(PG8_SB(0, 0), b2, voffB); PG8_STAGE(PG8_SB(0, 1), b2 + hstep, voffB); PG8_STAGE(PG8_SA(0, 0), a2, voffA);
            PG8_WAIT_V(8); PG8_WAIT_L(0); PG8_BAR; PG8_MMA(1, 0, At, B0); PG8_MMA(1, 1, At, B1); PG8_BAR; PG8_SCHED;
            PG8_LDB(B0, 1, 0); PG8_LDB(B1, 1, 1); PG8_SCHED; PG8_LDA(At, 1, 0); PG8_STAGE(PG8_SA(0, 1), a2 + hstep, voffA);
            PG8_WAIT_V(8); PG8_WAIT_L(0); PG8_BAR; PG8_MMA(0, 0, At, B0); PG8_MMA(0, 1, At, B1); PG8_BAR; PG8_SCHED;
            PG8_LDA(At, 1, 1); PG8_STAGE(PG8_SB(1, 0), b3, voffB); PG8_STAGE(PG8_SB(1, 1), b3 + hstep, voffB); PG8_STAGE(PG8_SA(1, 0), a3, voffA);
            PG8_WAIT_V(8); PG8_WAIT_L(0); PG8_BAR; PG8_MMA(1, 0, At, B0); PG8_MMA(1, 1, At, B1); PG8_BAR; PG8_SCHED;
            } else {
            PG8_LDB(B0, 0, 0); PG8_SCHED; PG8_LDA(At, 0, 0); PG8_STAGE(PG8_SA(1, 1), a1 + hstep, voffA);
            PG8_WAIT_L(8); PG8_BAR; PG8_WAIT_L(0); PG8_MMA(0, 0, At, B0); PG8_BAR; PG8_SCHED;
            PG8_LDB(B1, 0, 1); PG8_STAGE(PG8_SB(0, 0), b2, voffB);
            PG8_BAR; PG8_WAIT_L(0); PG8_MMA(0, 1, At, B1); PG8_BAR;
            PG8_LDA(At, 0, 1); PG8_STAGE(PG8_SA(0, 0), a2, voffA);
            PG8_BAR; PG8_WAIT_L(0); PG8_MMA(1, 0, At, B0); PG8_BAR; PG8_SCHED;
            PG8_STAGE(PG8_SB(0, 1), b2 + hstep, voffB);
            PG8_WAIT_V(6); PG8_BAR; PG8_MMA(1, 1, At, B1); PG8_BAR;
            PG8_LDB(B0, 1, 0); PG8_SCHED; PG8_LDA(At, 1, 0); PG8_STAGE(PG8_SA(0, 1), a2 + hstep, voffA);
            PG8_WAIT_L(8); PG8_BAR; PG8_WAIT_L(0); PG8_MMA(0, 0, At, B0); PG8_BAR; PG8_SCHED;
            PG8_LDB(B1, 1, 1); PG8_STAGE(PG8_SB(1, 0), b3, voffB);
            PG8_BAR; PG8_WAIT_L(0); PG8_MMA(0, 1, At, B1); PG8_BAR;
            PG8_LDA(At, 1, 1); PG8_STAGE(PG8_SA(1, 0), a3, voffA);
            PG8_BAR; PG8_WAIT_L(0); PG8_MMA(1, 0, At, B0); PG8_BAR; PG8_SCHED;
            PG8_STAGE(PG8_SB(1, 1), b3 + hstep, voffB);
            PG8_WAIT_V(6); PG8_BAR; PG8_MMA(1, 1, At, B1); PG8_BAR;
            }
        }
        if constexpr (ALIGN_EPI) { if (wr == 0) PG8_BAR; }
        if constexpr (!Epi::AFTER_DRAIN) { E(acc, cur, wr, wc, fr, fq); S.done(cur); }
        if (!has_next) break;
#pragma unroll
        for (int a = 0; a < 2; ++a)
#pragma unroll
            for (int b = 0; b < 2; ++b)
#pragma unroll
                for (int m = 0; m < 4; ++m)
#pragma unroll
                    for (int n = 0; n < 2; ++n) acc[a][b][m][n] = (f32x4){0.f, 0.f, 0.f, 0.f};
        cur = nxt; cA = nA; cB = nB; ++ui;
        if constexpr (ALIGN_EPI) { if (wr == 1) PG8_BAR; }
    }
    PG8_WAIT_V(0);
    if constexpr (!ALIGN_EPI) { if (wr == 0) PG8_BAR; }
    PG8_BAR;
    if constexpr (Epi::AFTER_DRAIN) { E.fused(acc, cur, wr, wc, fr, fq, lds, wid, lane); S.done(cur); }
#undef PG8_SA
#undef PG8_SB
#undef PG8_STAGE
#undef PG8_LDA
#undef PG8_LDB
#undef PG8_MMA
#undef PG8_WAIT_V
#undef PG8_WAIT_L
#undef PG8_BAR
#undef PG8_SCHED
}
}

#ifndef PG8_SP2
#define PG8_SP2 true
#endif
#ifndef PG8_ALIGN
#define PG8_ALIGN true
#endif
#include <hip/hip_bf16.h>
#include <cmath>
namespace attn_body {
using bf16=__hip_bfloat16;
using bf16x8=__attribute__((ext_vector_type(8)))short;
using s16x4=__attribute__((ext_vector_type(4)))short;
using f32x16=__attribute__((ext_vector_type(16)))float;
using u32x4=__attribute__((ext_vector_type(4)))unsigned;
constexpr int BATCH=2,NHEAD=16,SEQ=8192,D=64,DM=6656,DMO=2048;
constexpr int NW=8,QBLK=32,QB=QBLK*NW,KVBLK=64,NQB=SEQ/QB;
constexpr int ATTN_UNIT_ROWS=QB;
__device__ __forceinline__ int crow(int r,int hi){return (r&3)+8*(r>>2)+4*hi;}
#define SBAR() __builtin_amdgcn_sched_barrier(0)
__device__ __forceinline__ void cmask(f32x16&p0,f32x16&p1,int jb,int qrel,int hi){
  const float NEG=-INFINITY; int kb=64*jb+4*hi;
  #pragma unroll
  for(int r=0;r<16;++r){int kv=kb+(r&3)+8*(r>>2); if(kv>qrel)p0[r]=NEG; if(kv+32>qrel)p1[r]=NEG;}
}

constexpr int NSLOT=3, SLOTB=8192;
constexpr int LDS_K=0, LDS_V=NSLOT*SLOTB, LDS_WS=2*NSLOT*SLOTB, LDS_OST=LDS_WS+NW*64*4, LDS_CK=LDS_OST+NW*4096, LDS_BYTES=LDS_CK+SEQ*4;
constexpr float C2=0.125f*1.4426950408889634f;
__device__ __forceinline__ void glds16(const void*gsrc,unsigned lds_dst){unsigned keep;
  asm volatile("s_mov_b32 %0, m0\n\ts_mov_b32 m0, %2\n\ts_nop 0\n\tglobal_load_lds_dwordx4 %1, off\n\ts_mov_b32 m0, %0":"=&s"(keep):"v"(gsrc),"s"(lds_dst):"memory");}
__device__ __forceinline__ void glds16s(const void*sbase,unsigned voff,unsigned lds_dst){unsigned keep;
  asm volatile("s_mov_b32 %0, m0\n\ts_mov_b32 m0, %3\n\ts_nop 0\n\tglobal_load_lds_dwordx4 %1, %2\n\ts_mov_b32 m0, %0":"=&s"(keep):"v"(voff),"s"(sbase),"s"(lds_dst):"memory");}
__device__ __forceinline__ float max3f(float a,float b,float c){float r;asm("v_max3_f32 %0, %1, %2, %3":"=v"(r):"v"(a),"v"(b),"v"(c));return r;}
__device__ __forceinline__ float max2f(float a,float b){float r;asm("v_max_f32_e32 %0, %1, %2":"=v"(r):"v"(a),"v"(b));return r;}
__device__ __forceinline__ float fadd_s(float a,float b){float r;asm("v_add_f32_e32 %0, %1, %2":"=v"(r):"v"(a),"v"(b));return r;}
__device__ __forceinline__ float fsub_s(float a,float b){float r;asm("v_sub_f32_e32 %0, %1, %2":"=v"(r):"v"(a),"v"(b));return r;}
typedef float f32x2_t __attribute__((ext_vector_type(2))); typedef __bf16 bf16x2_t __attribute__((ext_vector_type(2)));
__device__ __forceinline__ unsigned cvtpk_s(float lo,float hi){f32x2_t v={lo,hi};bf16x2_t b=__builtin_convertvector(v,bf16x2_t);return __builtin_bit_cast(unsigned,b);}
#define WAIT_BAR(N) asm volatile("s_waitcnt vmcnt(" #N ") lgkmcnt(0)\n\ts_barrier":::"memory")

__device__ __forceinline__ void qkt(f32x16&p0,f32x16&p1,const char*Kslot,const bf16x8*qr,int r32,int hi){
  const char*kb=Kslot+hi*1024+r32*16;
  #pragma unroll
  for(int d0=0;d0<4;++d0){
    const bf16x8 b0=*reinterpret_cast<const bf16x8*>(kb+d0*2048);
    const bf16x8 b1=*reinterpret_cast<const bf16x8*>(kb+d0*2048+512);
    p0=__builtin_amdgcn_mfma_f32_32x32x16_bf16(b0,qr[d0],p0,0,0,0);p1=__builtin_amdgcn_mfma_f32_32x32x16_bf16(b1,qr[d0],p1,0,0,0);}
}
typedef __attribute__((address_space(3))) const char* lds_cptr;
typedef short v4i16_t __attribute__((ext_vector_type(4)));
__device__ __forceinline__ void kload8(bf16x8*kf,lds_cptr kp){
  kf[0]=*(const __attribute__((address_space(3))) bf16x8*)(kp);      kf[1]=*(const __attribute__((address_space(3))) bf16x8*)(kp+512);
  kf[2]=*(const __attribute__((address_space(3))) bf16x8*)(kp+2048); kf[3]=*(const __attribute__((address_space(3))) bf16x8*)(kp+2560);
  kf[4]=*(const __attribute__((address_space(3))) bf16x8*)(kp+4096); kf[5]=*(const __attribute__((address_space(3))) bf16x8*)(kp+4608);
  kf[6]=*(const __attribute__((address_space(3))) bf16x8*)(kp+6144); kf[7]=*(const __attribute__((address_space(3))) bf16x8*)(kp+6656);
}
__device__ __forceinline__ void kload2(bf16x8*kf,lds_cptr kp,int j){ kf[2*j]=*(const __attribute__((address_space(3))) bf16x8*)(kp+j*2048); kf[2*j+1]=*(const __attribute__((address_space(3))) bf16x8*)(kp+j*2048+512); }
__device__ __forceinline__ s16x4 vtr(lds_cptr p){ return __builtin_bit_cast(s16x4,__builtin_amdgcn_ds_read_tr16_b64_v4i16((__attribute__((address_space(3))) v4i16_t*)p)); }
typedef float f32x4c __attribute__((ext_vector_type(4)));
__device__ __forceinline__ void ldck(f32x16&c0,f32x16&c1,lds_cptr ckt){
  #pragma unroll
  for(int g=0;g<4;++g){ const f32x4c a=*(const __attribute__((address_space(3))) f32x4c*)(ckt+32*g); const f32x4c b=*(const __attribute__((address_space(3))) f32x4c*)(ckt+128+32*g);
    c0[4*g]=a[0];c0[4*g+1]=a[1];c0[4*g+2]=a[2];c0[4*g+3]=a[3]; c1[4*g]=b[0];c1[4*g+1]=b[1];c1[4*g+2]=b[2];c1[4*g+3]=b[3]; }
}
__device__ __forceinline__ float rowmax(const f32x16&p0,const f32x16&p1){
  float a=max3f(p0[0],p0[1],p1[0]),b=max3f(p0[2],p0[3],p1[1]);a=max3f(a,p1[2],p1[3]);
  #pragma unroll
  for(int r=4;r<16;r+=4){a=max3f(a,p0[r],p0[r+1]);b=max3f(b,p0[r+2],p0[r+3]);a=max3f(a,p1[r],p1[r+1]);b=max3f(b,p1[r+2],p1[r+3]);}
  const float m=max2f(a,b);
  auto rr=__builtin_amdgcn_permlane32_swap(__float_as_uint(m),__float_as_uint(m),false,false);
  return max2f(__uint_as_float(rr[0]),__uint_as_float(rr[1]));
}
__device__ __forceinline__ void pv(f32x16*o,int vb,bf16x8 pa0,bf16x8 pa1,bf16x8 pa2,bf16x8 pa3){
  #pragma unroll
  for(int d0=0;d0<2;++d0){s16x4 lo[4],hi[4];
    #pragma unroll
    for(int ks=0;ks<4;++ks){
      asm volatile("ds_read_b64_tr_b16 %0,%1 offset:%c2":"=&v"(lo[ks]):"v"(vb),"i"(d0*4096+ks*1024):"memory");
      asm volatile("ds_read_b64_tr_b16 %0,%1 offset:%c2":"=&v"(hi[ks]):"v"(vb),"i"(d0*4096+ks*1024+512):"memory");}
    asm volatile("s_waitcnt lgkmcnt(0)":::"memory");SBAR();
    #define PK(k) (bf16x8){lo[k][0],lo[k][1],lo[k][2],lo[k][3],hi[k][0],hi[k][1],hi[k][2],hi[k][3]}
    o[d0]=__builtin_amdgcn_mfma_f32_32x32x16_bf16(pa0,PK(0),o[d0],0,0,0);
    o[d0]=__builtin_amdgcn_mfma_f32_32x32x16_bf16(pa1,PK(1),o[d0],0,0,0);
    o[d0]=__builtin_amdgcn_mfma_f32_32x32x16_bf16(pa2,PK(2),o[d0],0,0,0);
    o[d0]=__builtin_amdgcn_mfma_f32_32x32x16_bf16(pa3,PK(3),o[d0],0,0,0);
    #undef PK
  }
}

#ifndef ATTN_STORE16
#define ATTN_STORE16(p,v) (*(u32x4*)(p)=(v))
#endif
template<int THRL> __device__ __forceinline__ void attn_unit(int b,int h,int qb,const bf16*Q,const bf16*K,const bf16*V,bf16*O,const float*C2G,char*shm,int tid_in){
  int tid_=tid_in; asm volatile("":"+v"(tid_)); const int tid=tid_,lane=tid&63,r32=lane&31,hi=lane>>5; const int wid=__builtin_amdgcn_readfirstlane(tid>>6);
  const long rowbase=(long)b*SEQ; const int q0=qb*QB;
  const bf16*Qw=Q+(rowbase+q0+wid*QBLK)*DM+h*D;
  const bf16*Kh=K+rowbase*DM+h*D,*Vh=V+rowbase*DM+h*D;
  const unsigned lds0=(unsigned)(uintptr_t)shm;
  float*wsf=(float*)(shm+LDS_WS)+wid*64;
  const unsigned koff=(unsigned)(lane*DM+wid*8)*2u;
  const unsigned voff=(unsigned)((16*(wid&3)+(lane>>2))*DM+(wid>>2)*32+(lane&3)*8)*2u;
  const unsigned kdst=lds0+LDS_K+wid*1024, vdst=lds0+LDS_V+wid*1024;
  #define DMA_K(t,slot) glds16s(Kh+(long)(t)*KVBLK*DM,koff,(unsigned)__builtin_amdgcn_readfirstlane(kdst+(slot)))
  #define DMA_V(t,slot) glds16s(Vh+(long)(t)*KVBLK*DM,voff,(unsigned)__builtin_amdgcn_readfirstlane(vdst+(slot)))
  const int vb0=(int)(lds0+LDS_V)+((lane>>4)&1)*32+(lane&3)*8+(4*hi+((lane&15)>>2))*64;
  const char*Kbase=shm+LDS_K; bf16x8 kf[8];
  const lds_cptr shm3=(lds_cptr)shm; const lds_cptr kp0=shm3+LDS_K+hi*1024+r32*16; const lds_cptr vp0=shm3+LDS_V+((lane>>4)&1)*32+(lane&3)*8+(4*hi+((lane&15)>>2))*64;
  const int NT=(q0+QB)/KVBLK;
  { const float*csrc=C2G+(long)(b*NHEAD+h)*SEQ; const int n4=(q0+QB)/4;
    for(int i4=tid;i4<n4;i4+=NW*64){ const f32x4c v=*(const f32x4c*)(csrc+4*i4); *(__attribute__((address_space(3))) f32x4c*)(shm3+LDS_CK+16*i4)=v; } }
  asm volatile("s_waitcnt vmcnt(0) lgkmcnt(0)\n\ts_barrier":::"memory");
  const float cq2=*(const __attribute__((address_space(3))) float*)(shm3+LDS_CK+4*(q0+wid*QBLK+r32));
  const lds_cptr ckp0=shm3+LDS_CK+16*hi;
  DMA_K(0,0);DMA_V(0,0);DMA_K(1,SLOTB);
  bf16x8 qr[4];
  #pragma unroll
  for(int d0=0;d0<4;++d0)qr[d0]=*reinterpret_cast<const bf16x8*>(&Qw[(long)r32*DM+d0*16+hi*8]);
  float l_reg=0.f;f32x16 o[2];o[0]=f32x16{};o[1]=f32x16{};
  const int qrel=wid*QBLK+r32;
  #define CMASK(P0,P1,t) do{int jb_=(t)-(NT-4); if(jb_>=0)cmask(P0,P1,jb_,qrel,hi);}while(0)
  #define CINIT(X) do{ _Pragma("unroll") for(int r=0;r<16;++r)X[r]=cq2-X[r]; }while(0)
  f32x16 pA0,pA1,pB0,pB1;
  int sl_prev=0,sl_cur=0,sl_next=SLOTB;
  #define ROT() do{sl_prev=sl_cur;sl_cur=sl_next;sl_next=(sl_next==(NSLOT-1)*SLOTB)?0:sl_next+SLOTB;}while(0)
  DMA_K(2,2*SLOTB);
  WAIT_BAR(3);
  ldck(pA0,pA1,ckp0); CINIT(pA0); CINIT(pA1);
  qkt(pA0,pA1,Kbase,qr,r32,hi);asm volatile("s_nop 15\n\ts_nop 7":"+v"(pA0),"+v"(pA1));CMASK(pA0,pA1,0);
  _Pragma("unroll") for(int r=0;r<16;++r){pA0[r]=__builtin_amdgcn_exp2f(pA0[r]);pA1[r]=__builtin_amdgcn_exp2f(pA1[r]);}
  ldck(pB0,pB1,ckp0+256);
  WAIT_BAR(0);
  DMA_K(3,0);DMA_V(1,SLOTB);
  ROT();
  kload8(kf,kp0+sl_cur);
  WAIT_BAR(2);
  s16x4 vlo[8],vhi[8]; u32x4 pw0,pw1,pw2,pw3;
  #define PKW(P,B) cvtpk_s(P[B],P[B+1])
  #define PAF(k) __builtin_bit_cast(bf16x8,pw##k)
  #define VFR(i) (bf16x8){vlo[i][0],vlo[i][1],vlo[i][2],vlo[i][3],vhi[i][0],vhi[i][1],vhi[i][2],vhi[i][3]}
  #define PIN(x) asm volatile("":"+v"(x))
  #define MX3(a,b,c) __builtin_fmaxf(__builtin_fmaxf((a),(b)),(c))
  #define GAPA(MF,A0,A1,A2,A3,W0,W1,PW) do{ MF; sacc+=A0; sacc+=A1; sacc+=A2; sacc+=A3; PIN(sacc); W0; W1; PIN(PW); SBAR(); }while(0)
  #define EX(v) __builtin_amdgcn_exp2f(v)
  #define GAPB(MF,X,B) do{ MF; X[B]=EX(X[B]); X[B+1]=EX(X[B+1]); X[B+2]=EX(X[B+2]); X[B+3]=EX(X[B+3]); PIN(X); SBAR(); }while(0)
  #define VRD(i) do{ vlo[i]=vtr(vp_+(((i)>>2)*4096+((i)&3)*1024)); vhi[i]=vtr(vp_+(((i)>>2)*4096+((i)&3)*1024+512)); }while(0)
  #define KRD(G,j) do{ if(G){ kload2(kf,kp0+sl_next,j); SBAR(); } }while(0)
  #define STEP(C0,C1,P0,P1,t,GK,GV,GL,GC) do{ SBAR(); \
    const lds_cptr vp_=vp0+sl_prev; \
    CINIT(C0); CINIT(C1); SBAR(); \
    VRD(0); SBAR(); float sacc=(P0[0]+P0[1]); \
    GAPA(C0=__builtin_amdgcn_mfma_f32_32x32x16_bf16(kf[0],qr[0],C0,0,0,0), P0[2],P0[3],P0[4],P0[5],     pw0[0]=PKW(P0,0), pw0[1]=PKW(P0,2), pw0); \
    VRD(4); SBAR(); GAPA(C1=__builtin_amdgcn_mfma_f32_32x32x16_bf16(kf[1],qr[0],C1,0,0,0), P0[6],P0[7],P0[8],P0[9],     pw0[2]=PKW(P0,4), pw0[3]=PKW(P0,6), pw0); \
    VRD(1); SBAR(); GAPA(C0=__builtin_amdgcn_mfma_f32_32x32x16_bf16(kf[2],qr[1],C0,0,0,0),   P0[10],P0[11],P0[12],P0[13], pw1[0]=PKW(P0,8), pw1[1]=PKW(P0,10), pw1); \
    VRD(5); SBAR(); GAPA(C1=__builtin_amdgcn_mfma_f32_32x32x16_bf16(kf[3],qr[1],C1,0,0,0),   P0[14],P0[15],P1[0],P1[1],   pw1[2]=PKW(P0,12),pw1[3]=PKW(P0,14), pw1); \
    VRD(2); SBAR(); GAPA(C0=__builtin_amdgcn_mfma_f32_32x32x16_bf16(kf[4],qr[2],C0,0,0,0),   P1[2],P1[3],P1[4],P1[5],     pw2[0]=PKW(P1,0), pw2[1]=PKW(P1,2), pw2); \
    VRD(6); SBAR(); GAPA(C1=__builtin_amdgcn_mfma_f32_32x32x16_bf16(kf[5],qr[2],C1,0,0,0),   P1[6],P1[7],P1[8],P1[9],     pw2[2]=PKW(P1,4), pw2[3]=PKW(P1,6), pw2); \
    VRD(3); SBAR(); GAPA(C0=__builtin_amdgcn_mfma_f32_32x32x16_bf16(kf[6],qr[3],C0,0,0,0),   P1[10],P1[11],P1[12],P1[13], pw3[0]=PKW(P1,8), pw3[1]=PKW(P1,10), pw3); \
    VRD(7); SBAR(); GAPA(C1=__builtin_amdgcn_mfma_f32_32x32x16_bf16(kf[7],qr[3],C1,0,0,0),   P1[14],P1[15],0.f,0.f,       pw3[2]=PKW(P1,12),pw3[3]=PKW(P1,14), pw3); \
    l_reg+=sacc; \
    if(GK){DMA_K((t)+3,sl_cur);} if(GV){DMA_V((t)+1,sl_next);} \
    CMASK(C0,C1,t); \
    SBAR(); \
    GAPB(o[0]=__builtin_amdgcn_mfma_f32_32x32x16_bf16(PAF(0),VFR(0),o[0],0,0,0), C0,0); \
    GAPB(o[1]=__builtin_amdgcn_mfma_f32_32x32x16_bf16(PAF(0),VFR(4),o[1],0,0,0), C0,4); \
    KRD(GL,0); GAPB(o[0]=__builtin_amdgcn_mfma_f32_32x32x16_bf16(PAF(1),VFR(1),o[0],0,0,0), C0,8); \
    KRD(GL,1); GAPB(o[1]=__builtin_amdgcn_mfma_f32_32x32x16_bf16(PAF(1),VFR(5),o[1],0,0,0), C0,12); \
    KRD(GL,2); GAPB(o[0]=__builtin_amdgcn_mfma_f32_32x32x16_bf16(PAF(2),VFR(2),o[0],0,0,0), C1,0); \
    KRD(GL,3); GAPB(o[1]=__builtin_amdgcn_mfma_f32_32x32x16_bf16(PAF(2),VFR(6),o[1],0,0,0), C1,4); \
    GAPB(o[0]=__builtin_amdgcn_mfma_f32_32x32x16_bf16(PAF(3),VFR(3),o[0],0,0,0), C1,8); \
    GAPB(o[1]=__builtin_amdgcn_mfma_f32_32x32x16_bf16(PAF(3),VFR(7),o[1],0,0,0), C1,12); \
    if(GC){ ldck(P0,P1,ckp0+((t)+1)*256); } \
    }while(0)
  int t=1;
  #undef CMASK
  #define CMASK(P0,P1,t) do{}while(0)
  for(;t+5<NT;t+=2){
    STEP(pB0,pB1,pA0,pA1,t,true,true,true,true);     WAIT_BAR(2); ROT();
    STEP(pA0,pA1,pB0,pB1,t+1,true,true,true,true);   WAIT_BAR(2); ROT();
  }
  #undef CMASK
  #define CMASK(P0,P1,t) do{int jb_=(t)-(NT-4); if(jb_>=0)cmask(P0,P1,jb_,qrel,hi);}while(0)
  #define ENDW(tt) do{ if((tt)+3<NT){WAIT_BAR(2);} else if((tt)+2<NT){WAIT_BAR(1);} else {WAIT_BAR(0);} }while(0)
  for(;t+1<NT;t+=2){
    STEP(pB0,pB1,pA0,pA1,t,(t+3<NT),(t+1<NT),(t+1<NT),(t+1<NT));       ENDW(t);   ROT();
    STEP(pA0,pA1,pB0,pB1,t+1,(t+4<NT),(t+2<NT),(t+2<NT),(t+2<NT));     ENDW(t+1); ROT();
  }
  STEP(pB0,pB1,pA0,pA1,NT-1,false,false,false,false);
  { float sacc=pB0[0]+pB0[1]; _Pragma("unroll") for(int r=2;r<16;++r)sacc+=pB0[r]; _Pragma("unroll") for(int r=0;r<16;++r)sacc+=pB1[r]; l_reg+=sacc;
    pw0=(u32x4){PKW(pB0,0),PKW(pB0,2),PKW(pB0,4),PKW(pB0,6)};pw1=(u32x4){PKW(pB0,8),PKW(pB0,10),PKW(pB0,12),PKW(pB0,14)};pw2=(u32x4){PKW(pB1,0),PKW(pB1,2),PKW(pB1,4),PKW(pB1,6)};pw3=(u32x4){PKW(pB1,8),PKW(pB1,10),PKW(pB1,12),PKW(pB1,14)};
    SBAR(); pv(o,vb0+sl_cur,PAF(0),PAF(1),PAF(2),PAF(3)); }
  #undef PKW
  #undef PAF
  #undef VFR
  #undef PIN
  #undef MX3
  #undef GAPA
  #undef GAPB
  #undef EX
  #undef VRD
  #undef KRD
  #undef STEP
  #undef ENDW
  {auto rr=__builtin_amdgcn_permlane32_swap(__float_as_uint(l_reg),__float_as_uint(l_reg),false,false);l_reg=__uint_as_float(rr[0])+__uint_as_float(rr[1]);}
  if(hi==0)wsf[32+r32]=l_reg;asm volatile("s_waitcnt lgkmcnt(0)":::"memory");
  float rli[16];
  #pragma unroll
  for(int r=0;r<16;++r)rli[r]=__builtin_amdgcn_rcpf(wsf[32+crow(r,hi)]);
  bf16*Ow=O+(rowbase+q0+wid*QBLK)*DMO+h*D;
  { bf16*stg=(bf16*)(shm+LDS_OST)+wid*2048;
    #pragma unroll
    for(int r=0;r<16;++r){const int orow=crow(r,hi);
      #pragma unroll
      for(int d0=0;d0<2;++d0)stg[orow*64+d0*32+r32]=__float2bfloat16(o[d0][r]*rli[r]);}
    asm volatile("s_waitcnt lgkmcnt(0)":::"memory");
    #pragma unroll
    for(int i=0;i<4;++i){const int row=i*8+(lane>>3),ch=lane&7; const u32x4 v=*(const u32x4*)(stg+row*64+ch*8); ATTN_STORE16(Ow+(long)row*DMO+ch*8,v);} }
  asm volatile("s_waitcnt lgkmcnt(0)\n\ts_barrier":::"memory");
  #undef DMA_K
  #undef DMA_V
  #undef CMASK
  #undef CINIT
  #undef ROT
}
constexpr int ATTN_LDS_BYTES=LDS_BYTES;
struct AttnTensors { const bf16* Q; const bf16* K; const bf16* V; bf16* O; const float* C2G; };
struct AttnUnit { int bh; int qb; };
struct StaticOrder {
  int vcu;
  __device__ __forceinline__ explicit StaticOrder(int grid,int block):vcu((block%8)*(grid/8)+block/8){}
  __device__ __forceinline__ bool next(int i,AttnUnit&u)const{ if(i>=4)return false; const int s=vcu&7; u.bh=vcu>>3; u.qb=(i==0)?s:(i==1)?15-s:(i==2)?16+s:31-s; return true; }
  __device__ __forceinline__ void a_ready(const AttnUnit&)const{}
  __device__ __forceinline__ void done(const AttnUnit&)const{}
};
template<class Sched,int THRL=8> __device__ __forceinline__ void attn_phase(char*lds,const AttnTensors&T,const Sched&S,int tid_in){
  AttnUnit u;
  for(int i=0;S.next(i,u);++i){ S.a_ready(u); attn_unit<THRL>(u.bh/NHEAD,u.bh%NHEAD,u.qb,T.Q,T.K,T.V,T.O,T.C2G,lds,tid_in); S.done(u); }
}
#undef SBAR
#undef WAIT_BAR
}
constexpr int NWAVES = 8;
constexpr int SEQ = 8192, NB = 2, M = NB * SEQ, DMODEL = 2048;
constexpr int PJ = 6656;
constexpr int NIN = 6416;
constexpr int C_R = 0, C_K = 1024, C_V = 2048, C_WD = 3072, C_AD = 3136, C_GD = 3200;
constexpr int C_FQ = 3328, C_FK = 4352, C_FV = 5376, C_FF = 6400;
constexpr int NEXP = 16384;
constexpr float C2Q = 0.125f * 1.4426950408889634f;
constexpr float LOG2E = 1.4426950408889634f;

constexpr size_t MiB = 1u << 20;
constexpr size_t WS_CTL = 0, CTL_ZERO_BYTES = 1 * MiB;
constexpr size_t WS_WQT = 1 * MiB;
constexpr size_t WS_LWT = 5 * MiB;
constexpr size_t WS_C2 = 6 * MiB;
constexpr size_t WS_BON = 7 * MiB;
constexpr size_t WS_WOT = 8 * MiB;
constexpr size_t WS_WINT = 16 * MiB;
constexpr size_t WS_LA = 42 * MiB;
constexpr size_t WS_XN = 64 * MiB;
constexpr size_t WS_PROJ = 128 * MiB;
constexpr size_t WS_MIXED = 336 * MiB;
constexpr size_t WS_KP = 400 * MiB, WS_AV = 432 * MiB, WS_BV = 464 * MiB;
constexpr size_t WS_END = 496 * MiB;
constexpr size_t WS_GATE = 128 * MiB;
constexpr size_t WS_IDX = 136 * MiB;
constexpr size_t WS_QP = 140 * MiB;
constexpr size_t WS_U8 = 172 * MiB, WS_V8 = 204 * MiB;
constexpr size_t WS_USC = 236 * MiB, WS_VSC = 236 * MiB + 65536;
constexpr size_t OUT_DEC = 0, OUT_G = 64 * MiB, OUT_AIC = 96 * MiB;
constexpr int CW_TMO = 0, CW_BAR = 4096, CW_QUEUE = 16384;

constexpr int RING_OFF = 0, RING_BYTES = 131072;
constexpr int LDSCTL_OFF = RING_BYTES, MISC_OFF = LDSCTL_OFF + 320;
constexpr int LDS_BYTES = 147456;

#define GAS __attribute__((address_space(1)))
#define LAS __attribute__((address_space(3)))
typedef unsigned short bf16;
typedef unsigned v4u __attribute__((ext_vector_type(4)));
typedef float f32x4 __attribute__((ext_vector_type(4)));
typedef short bf16x8 __attribute__((ext_vector_type(8)));
typedef GAS unsigned gu32;
typedef GAS unsigned long long gu64;
#define RLX_AGENT __ATOMIC_RELAXED, __HIP_MEMORY_SCOPE_AGENT
#define LDS_WAIT() asm volatile("s_waitcnt lgkmcnt(0)" ::: "memory")
#define VM_WAIT() asm volatile("s_waitcnt vmcnt(0)" ::: "memory")
__device__ __forceinline__ unsigned long long rt() { return __builtin_amdgcn_s_memrealtime(); }
__device__ __forceinline__ unsigned f2bf(float f) { unsigned u = __builtin_bit_cast(unsigned, f); return (u + 0x7fffu + ((u >> 16) & 1u)) >> 16; }
__device__ __forceinline__ unsigned pk2(float lo, float hi) { return f2bf(lo) | (f2bf(hi) << 16); }

#define XB_TMO      128
#define XB_XCNT(j)  (256  + 64 * (j))
#define XB_XSUB(j)  (1280 + 64 * (j))
#define XB_XGEN(j)  (2304 + 64 * (j))
#define XB_TOP      3328
#define XB_TOPGEN   3392
#define XCD_BAR_WORDS 3456
#define XB_SPIN_CAP (1u << 18)

__device__ __forceinline__ unsigned xb_ld(unsigned* p)              { return __hip_atomic_load(p, __ATOMIC_RELAXED, __HIP_MEMORY_SCOPE_AGENT); }
__device__ __forceinline__ unsigned xb_add(unsigned* p, unsigned v) { return __hip_atomic_fetch_add(p, v, __ATOMIC_RELAXED, __HIP_MEMORY_SCOPE_AGENT); }
__device__ __forceinline__ unsigned xb_xcc_id() { return (unsigned)__builtin_amdgcn_s_getreg((3 << 11) | 20) & 0xFu; }
#define XB_SPIN(cond, bar) do { unsigned _sp = 0; while (cond) { __builtin_amdgcn_s_sleep(1); \
    if ((++_sp & 255u) == 0u) { if (xb_ld(&(bar)[XB_TMO])) break; if (_sp > XB_SPIN_CAP) { atomicAdd(&(bar)[XB_TMO], 1u); break; } } } } while (0)

struct XcdBarrier {
    unsigned* bar; unsigned x;
    volatile LAS unsigned* st;
};

__device__ __forceinline__ XcdBarrier xcd_barrier_post(unsigned* bar, volatile LAS unsigned* st, int tid) {
    XcdBarrier b; b.bar = bar; b.x = xb_xcc_id(); b.st = st;
    if (tid == 0) (void)xb_add(&bar[XB_XCNT(b.x)], 1u);
    return b;
}
__device__ __forceinline__ void xcd_barrier_complete(unsigned* bar, unsigned x, unsigned& nloc, unsigned& nx) {
    const unsigned G = gridDim.x * gridDim.y * gridDim.z;
    unsigned sum, cnt, mine, sp = 0u;
    for (;;) {
        sum = 0u; cnt = 0u; mine = 0u;
#pragma unroll
        for (unsigned j = 0; j < 16; ++j) { const unsigned c = xb_ld(&bar[XB_XCNT(j)]); sum += c; cnt += (c > 0u) ? 1u : 0u; mine = (j == x) ? c : mine; }
        if (sum == G) break;
        __builtin_amdgcn_s_sleep(1);
        if ((++sp & 255u) == 0u) { if (xb_ld(&bar[XB_TMO])) break; if (sp > XB_SPIN_CAP) { atomicAdd(&bar[XB_TMO], 1u); break; } }
    }
    nloc = mine > 0u ? mine : 1u; nx = cnt > 0u ? cnt : 1u;
}

__device__ __forceinline__ void xcd_barrier(const XcdBarrier& b, int tid) {
    asm volatile("s_waitcnt vmcnt(0)" ::: "memory");
    __syncthreads();
    if (tid == 0) {
        unsigned* bar = b.bar;
        __builtin_amdgcn_s_waitcnt(0);
        unsigned nloc = b.st[0], nx = b.st[1];
        if (nloc == 0u) { xcd_barrier_complete(bar, b.x, nloc, nx); b.st[0] = nloc; b.st[1] = nx; }
        const unsigned old = xb_add(&bar[XB_XSUB(b.x)], 1u);
        const unsigned gen = old / nloc;
        if (old + 1u == (gen + 1u) * nloc) {
            __builtin_amdgcn_fence(__ATOMIC_RELEASE, "agent");
            asm volatile("s_waitcnt vmcnt(0)" ::: "memory");
            const unsigned og = xb_add(&bar[XB_TOP], 1u);
            const unsigned tg = og / nx;
            if (og + 1u == (tg + 1u) * nx) xb_add(&bar[XB_TOPGEN], 1u);
            else XB_SPIN(xb_ld(&bar[XB_TOPGEN]) == tg, bar);
            __builtin_amdgcn_fence(__ATOMIC_ACQUIRE, "agent");
            xb_add(&bar[XB_XGEN(b.x)], 1u);
            asm volatile("s_waitcnt vmcnt(0)" ::: "memory");
        } else {
            XB_SPIN(xb_ld(&bar[XB_XGEN(b.x)]) == gen, bar);
            __builtin_amdgcn_fence(__ATOMIC_ACQUIRE, "agent");
            asm volatile("s_waitcnt vmcnt(0)" ::: "memory");
        }
    }
    __syncthreads();
}


struct Frame {
    LAS unsigned char* lds;
    volatile LAS unsigned* MISC;
    gu32* ctl;
    int tid, lane, wave, vcu, G;
};
__device__ __forceinline__ float wave_sum(float v) {
#pragma unroll
    for (int o = 1; o < 64; o <<= 1) v += __shfl_xor(v, o);
    return v;
}
__device__ __forceinline__ float wave_max(float v) {
#pragma unroll
    for (int o = 1; o < 64; o <<= 1) v = fmaxf(v, __shfl_xor(v, o));
    return v;
}
__device__ __forceinline__ float bflo(unsigned u) { return __uint_as_float(u << 16); }
__device__ __forceinline__ float bfhi(unsigned u) { return __uint_as_float(u & 0xffff0000u); }
__device__ __forceinline__ float bf1(const bf16* p) { return __uint_as_float((unsigned)(*p) << 16); }
__device__ __forceinline__ void ld16bf(const bf16* p, float (&x)[16]) {
    const v4u a = *(const v4u*)p, b = *(const v4u*)(p + 8);
    x[0] = bflo(a.x); x[1] = bfhi(a.x); x[2] = bflo(a.y); x[3] = bfhi(a.y); x[4] = bflo(a.z); x[5] = bfhi(a.z); x[6] = bflo(a.w); x[7] = bfhi(a.w);
    x[8] = bflo(b.x); x[9] = bfhi(b.x); x[10] = bflo(b.y); x[11] = bfhi(b.y); x[12] = bflo(b.z); x[13] = bfhi(b.z); x[14] = bflo(b.w); x[15] = bfhi(b.w);
}
__device__ __forceinline__ void st16bf(bf16* p, const float (&x)[16]) {
    v4u a, b;
    a.x = pk2(x[0], x[1]); a.y = pk2(x[2], x[3]); a.z = pk2(x[4], x[5]); a.w = pk2(x[6], x[7]);
    b.x = pk2(x[8], x[9]); b.y = pk2(x[10], x[11]); b.z = pk2(x[12], x[13]); b.w = pk2(x[14], x[15]);
    *(v4u*)p = a; *(v4u*)(p + 8) = b;
}
__device__ __forceinline__ void ld16f(const float* p, float (&x)[16]) {
#pragma unroll
    for (int j = 0; j < 4; ++j) { const f32x4 v = *(const f32x4*)(p + 4 * j); x[4 * j] = v.x; x[4 * j + 1] = v.y; x[4 * j + 2] = v.z; x[4 * j + 3] = v.w; }
}
__device__ __forceinline__ void shift16(const bf16* row, bool has_prev, int col, const float* mu, float (&x)[16]) {
    float p[16], q[16], m[16];
    ld16bf(row + col, p); ld16f(mu + col, m);
    if (has_prev) ld16bf(row - PJ + col, q); else {
#pragma unroll
        for (int i = 0; i < 16; ++i) q[i] = 0.f; }
#pragma unroll
    for (int i = 0; i < 16; ++i) x[i] = p[i] + m[i] * (q[i] - p[i]);
}

__device__ __forceinline__ void p0_transpose_item(const float* W, int Ks, int Ns, bf16* WT, int Kd, LAS float* scr, int kb, int nb, int lane) {
    const int k0 = 64 * kb, n0 = 32 * nb;
#pragma unroll 8
    for (int i = 0; i < 32; ++i) { const int kk = 2 * i + (lane >> 5), k = k0 + kk, n = n0 + (lane & 31);
        scr[kk * 33 + (lane & 31)] = (k < Ks && n < Ns) ? W[(size_t)k * Ns + n] : 0.f; }
    LDS_WAIT(); asm volatile("" ::: "memory");
    const int c = lane & 7;
#pragma unroll
    for (int j = 0; j < 4; ++j) { const int n = (lane >> 3) + 8 * j; const LAS float* s = scr + (8 * c) * 33 + n;
        v4u o; o.x = pk2(s[0 * 33], s[1 * 33]); o.y = pk2(s[2 * 33], s[3 * 33]); o.z = pk2(s[4 * 33], s[5 * 33]); o.w = pk2(s[6 * 33], s[7 * 33]);
        *(GAS v4u*)(WT + (size_t)(n0 + n) * Kd + k0 + 8 * c) = o; }
    LDS_WAIT(); asm volatile("" ::: "memory");
}
__device__ __forceinline__ void rms_row_to_bf16(const float* xrow, const float* g, bf16* orow, int lane) {
    const GAS f32x4* xr = (const GAS f32x4*)xrow + lane; const GAS f32x4* gr = (const GAS f32x4*)g + lane;
    f32x4 v[8]; float s = 0.f;
#pragma unroll
    for (int j = 0; j < 8; ++j) { v[j] = xr[64 * j]; s += (v[j].x * v[j].x + v[j].y * v[j].y) + (v[j].z * v[j].z + v[j].w * v[j].w); }
    const float rs = 1.0f / sqrtf(wave_sum(s) * (1.f / DMODEL) + 1e-6f);
    GAS unsigned long long* o8 = (GAS unsigned long long*)orow + lane;
#pragma unroll
    for (int j = 0; j < 8; ++j) { const f32x4 gg = gr[64 * j];
        o8[64 * j] = (unsigned long long)pk2(v[j].x * rs * gg.x, v[j].y * rs * gg.y) | ((unsigned long long)pk2(v[j].z * rs * gg.z, v[j].w * rs * gg.w) << 32); }
}
struct Ptrs {
    const float *x, *norm1_g, *w_in, *mu, *w_decay_up, *w0, *w_iclr_up, *a0, *w_gate_up, *k_k, *k_a, *r_k, *lnx_g, *lnx_b, *fox_b_f, *q_norm_g, *k_norm_g, *w_out, *norm2_g, *w_q, *sub_keys, *peer_u, *peer_v;
    float* out;
    bf16 *WQT, *LWT, *WOT, *WINT, *LA, *XN, *PROJ, *MIXED, *KP, *AV, *BV, *QP, *G, *AIC;
    float *C2, *BON, *Y, *DEC, *GATE, *USC, *VSC;
    unsigned short* IDX; unsigned char *U8, *V8;
};
__device__ __forceinline__ void prepA_token(const Ptrs& P, int m, int lane) {
    bf16* row = P.PROJ + (size_t)m * PJ;
    const bool has_prev = (m % SEQ) != 0;
#pragma unroll
    for (int which = 0; which < 2; ++which) {
        bf16* p = row + (which == 0 ? C_FQ : C_FK) + lane * 16;
        float x[16], g[16]; ld16bf(p, x); ld16f((which == 0 ? P.q_norm_g : P.k_norm_g) + (lane & 3) * 16, g);
        float ss = 0.f;
#pragma unroll
        for (int i = 0; i < 16; ++i) ss += x[i] * x[i];
        ss += __shfl_xor(ss, 1); ss += __shfl_xor(ss, 2);
        const float rs = (1.0f / sqrtf(ss * (1.f / 64.f) + 1e-6f)) * (which == 0 ? C2Q : 1.f);
#pragma unroll
        for (int i = 0; i < 16; ++i) x[i] = x[i] * rs * g[i];
        st16bf(p, x);
    }
    {
        const bf16* prow = row - PJ;
        auto sh = [&](int col) -> float { const float p = bf1(row + col); const float q = has_prev ? bf1(prow + col) : 0.f; return p + P.mu[col] * (q - p); };
        bf16* la0 = P.LA + (size_t)m * 128; bf16* la1 = P.LA + (size_t)M * 128 + (size_t)m * 128; bf16* la2 = P.LA + (size_t)2 * M * 128 + (size_t)m * 128;
        const float wd = sh(C_WD + lane), ad = sh(C_AD + lane), g0 = sh(C_GD + lane), g1 = sh(C_GD + 64 + lane);
        la0[lane] = (bf16)f2bf(tanhf(wd)); la0[64 + lane] = 0;
        la1[lane] = (bf16)f2bf(ad); la1[64 + lane] = 0;
        la2[lane] = (bf16)f2bf(1.0f / (1.0f + __expf(-g0))); la2[64 + lane] = (bf16)f2bf(1.0f / (1.0f + __expf(-g1)));
    }
}
__device__ __forceinline__ void fox_cumsum(const Ptrs& P, int bh, LAS float* scr, int tid) {
    const int b = bh >> 4, h = bh & 15; const float bf_ = P.fox_b_f[h];
    const bf16* src = P.PROJ + (size_t)(b * SEQ + tid * 16) * PJ + C_FF + h;
    float v[16]; float run = 0.f;
#pragma unroll
    for (int i = 0; i < 16; ++i) { const float x = bf1(src + (size_t)i * PJ) + bf_;
        const float ls = (x >= 0.f) ? -log1pf(__expf(-x)) : (x - log1pf(__expf(x))); run += ls; v[i] = run; }
    float inc = run; const int lane = tid & 63, w = tid >> 6;
#pragma unroll
    for (int o = 1; o < 64; o <<= 1) { const float t = __shfl_up(inc, o); if (lane >= o) inc += t; }
    if (lane == 63) scr[w] = inc;
    __syncthreads();
    float off = inc - run;
    for (int j = 0; j < w; ++j) off += scr[j];
    float* dst = P.C2 + (size_t)bh * SEQ + tid * 16;
#pragma unroll
    for (int i = 0; i < 16; i += 4) *(f32x4*)(dst + i) = (f32x4){(off + v[i]) * LOG2E, (off + v[i + 1]) * LOG2E, (off + v[i + 2]) * LOG2E, (off + v[i + 3]) * LOG2E};
    __syncthreads();
}

__device__ __forceinline__ void prepC_token(const Ptrs& P, int m, int lane) {
    const bf16* row = P.PROJ + (size_t)m * PJ;
    const bool has_prev = (m % SEQ) != 0;
    const int c = lane * 16, h = lane >> 2;
    float ks[16], t0[16], t1[16], a[16], kp[16], av[16], bv[16];
    shift16(row, has_prev, C_K + c, P.mu, ks);
    ld16f(P.k_k + c, t0);
    float n2 = 0.f;
#pragma unroll
    for (int i = 0; i < 16; ++i) { av[i] = ks[i] * t0[i]; n2 += av[i] * av[i]; }
    n2 += __shfl_xor(n2, 1); n2 += __shfl_xor(n2, 2);
    const float inv = 1.0f / fmaxf(sqrtf(n2), 1e-12f);
    ld16bf(P.AIC + (size_t)m * 1024 + c, a); ld16f(P.k_a + c, t1);
#pragma unroll
    for (int i = 0; i < 16; ++i) a[i] = 1.0f / (1.0f + __expf(-a[i]));
#pragma unroll
    for (int i = 0; i < 16; ++i) { const float kk = av[i] * inv; kp[i] = ks[i] * (1.0f + (a[i] - 1.0f) * t1[i]); av[i] = -kk; bv[i] = kk * a[i]; }
    st16bf(P.KP + (size_t)m * 1024 + c, kp); st16bf(P.AV + (size_t)m * 1024 + c, av); st16bf(P.BV + (size_t)m * 1024 + c, bv);
    shift16(row, has_prev, C_R + c, P.mu, t0);
    ld16f(P.r_k + c, t1);
    float bon = 0.f;
#pragma unroll
    for (int i = 0; i < 16; ++i) bon += t0[i] * kp[i] * t1[i];
    bon += __shfl_xor(bon, 1); bon += __shfl_xor(bon, 2);
    if ((lane & 3) == 0) P.BON[(size_t)m * 16 + h] = bon;
    { float* dp = P.DEC + (size_t)m * 1024 + c; ld16f(dp, t0);
#pragma unroll
      for (int i = 0; i < 16; ++i) { const float wraw = -log1pf(__expf(-t0[i])) - 0.5f; t0[i] = __expf(-__expf(wraw)); }
#pragma unroll
      for (int i = 0; i < 16; i += 4) *(f32x4*)(dp + i) = (f32x4){t0[i], t0[i + 1], t0[i + 2], t0[i + 3]}; }
}

constexpr int SC_A = 0, SC_B = 8192, SC_K = 16384, SC_R = 24576, SC_W = 40960, SC_V = 57344, SC_Y = 73728, SC_BYTES = 90112;
__device__ __forceinline__ void rwkv_scan(const Ptrs& P, int bh, LAS unsigned char* lds, int tid) {
    const int b = bh >> 4, h = bh & 15;
    const int i = tid >> 3, seg = tid & 7;
    const int tt = tid >> 3, sg = tid & 7;
    float s[8];
#pragma unroll
    for (int j = 0; j < 8; ++j) s[j] = 0.f;
    const int cb = h * 64 + sg * 8;
    float mur[8], muv[8];
#pragma unroll
    for (int j = 0; j < 8; ++j) { mur[j] = P.mu[C_R + cb + j]; muv[j] = P.mu[C_V + cb + j]; }
    v4u ra, rb, rk, rr, rrp, rv, rvp; f32x4 rw0, rw1;
#define SC_LOAD(chunk) do { const int t_ = (chunk) * 64 + tt; const size_t m_ = (size_t)b * SEQ + t_; \
        ra = *(const v4u*)(P.AV + m_ * 1024 + cb); rb = *(const v4u*)(P.BV + m_ * 1024 + cb); rk = *(const v4u*)(P.KP + m_ * 1024 + cb); \
        rw0 = *(const f32x4*)(P.DEC + m_ * 1024 + cb); rw1 = *(const f32x4*)(P.DEC + m_ * 1024 + cb + 4); \
        rr = *(const v4u*)(P.PROJ + m_ * PJ + C_R + cb); rv = *(const v4u*)(P.PROJ + m_ * PJ + C_V + cb); \
        if (t_ > 0) { rrp = *(const v4u*)(P.PROJ + (m_ - 1) * PJ + C_R + cb); rvp = *(const v4u*)(P.PROJ + (m_ - 1) * PJ + C_V + cb); } else { rrp = (v4u){0u, 0u, 0u, 0u}; rvp = (v4u){0u, 0u, 0u, 0u}; } } while (0)
    SC_LOAD(0);
    for (int chunk = 0; chunk < SEQ / 64; ++chunk) {
        __syncthreads();
        {
            *(LAS v4u*)(lds + SC_A + tt * 128 + sg * 16) = ra; *(LAS v4u*)(lds + SC_B + tt * 128 + sg * 16) = rb; *(LAS v4u*)(lds + SC_K + tt * 128 + sg * 16) = rk;
            *(LAS f32x4*)(lds + SC_W + tt * 256 + sg * 32) = rw0; *(LAS f32x4*)(lds + SC_W + tt * 256 + sg * 32 + 16) = rw1;
            const unsigned rw_[4] = {rr.x, rr.y, rr.z, rr.w}, rp_[4] = {rrp.x, rrp.y, rrp.z, rrp.w}, vw_[4] = {rv.x, rv.y, rv.z, rv.w}, vp_[4] = {rvp.x, rvp.y, rvp.z, rvp.w};
            float rs_[8], vs_[8];
#pragma unroll
            for (int q = 0; q < 4; ++q) {
                const float r0 = bflo(rw_[q]), r1 = bfhi(rw_[q]), p0 = bflo(rp_[q]), p1 = bfhi(rp_[q]);
                rs_[2 * q] = r0 + mur[2 * q] * (p0 - r0); rs_[2 * q + 1] = r1 + mur[2 * q + 1] * (p1 - r1);
                const float v0 = bflo(vw_[q]), v1 = bfhi(vw_[q]), q0 = bflo(vp_[q]), q1 = bfhi(vp_[q]);
                vs_[2 * q] = v0 + muv[2 * q] * (q0 - v0); vs_[2 * q + 1] = v1 + muv[2 * q + 1] * (q1 - v1); }
            *(LAS f32x4*)(lds + SC_R + tt * 256 + sg * 32) = (f32x4){rs_[0], rs_[1], rs_[2], rs_[3]}; *(LAS f32x4*)(lds + SC_R + tt * 256 + sg * 32 + 16) = (f32x4){rs_[4], rs_[5], rs_[6], rs_[7]};
            *(LAS f32x4*)(lds + SC_V + tt * 256 + sg * 32) = (f32x4){vs_[0], vs_[1], vs_[2], vs_[3]}; *(LAS f32x4*)(lds + SC_V + tt * 256 + sg * 32 + 16) = (f32x4){vs_[4], vs_[5], vs_[6], vs_[7]};
        }
        __syncthreads();
        if (chunk + 1 < SEQ / 64) SC_LOAD(chunk + 1);
#pragma unroll 2
        for (int st = 0; st < 64; ++st) {
            const v4u a4 = *(const LAS v4u*)(lds + SC_A + st * 128 + seg * 16), b4 = *(const LAS v4u*)(lds + SC_B + st * 128 + seg * 16), k4 = *(const LAS v4u*)(lds + SC_K + st * 128 + seg * 16);
            const f32x4 w0 = *(const LAS f32x4*)(lds + SC_W + st * 256 + seg * 32), w1 = *(const LAS f32x4*)(lds + SC_W + st * 256 + seg * 32 + 16);
            const f32x4 r0 = *(const LAS f32x4*)(lds + SC_R + st * 256 + seg * 32), r1 = *(const LAS f32x4*)(lds + SC_R + st * 256 + seg * 32 + 16);
            const float vi = *(const LAS float*)(lds + SC_V + st * 256 + i * 4);
            const float a_[8] = {bflo(a4.x), bfhi(a4.x), bflo(a4.y), bfhi(a4.y), bflo(a4.z), bfhi(a4.z), bflo(a4.w), bfhi(a4.w)};
            const float b_[8] = {bflo(b4.x), bfhi(b4.x), bflo(b4.y), bfhi(b4.y), bflo(b4.z), bfhi(b4.z), bflo(b4.w), bfhi(b4.w)};
            const float k_[8] = {bflo(k4.x), bfhi(k4.x), bflo(k4.y), bfhi(k4.y), bflo(k4.z), bfhi(k4.z), bflo(k4.w), bfhi(k4.w)};
            const float w_[8] = {w0.x, w0.y, w0.z, w0.w, w1.x, w1.y, w1.z, w1.w};
            const float r_[8] = {r0.x, r0.y, r0.z, r0.w, r1.x, r1.y, r1.z, r1.w};
            float sa = 0.f;
#pragma unroll
            for (int j = 0; j < 8; ++j) sa += s[j] * a_[j];
            sa += __shfl_xor(sa, 1); sa += __shfl_xor(sa, 2); sa += __shfl_xor(sa, 4);
            float y = 0.f;
#pragma unroll
            for (int j = 0; j < 8; ++j) { s[j] = s[j] * w_[j] + (sa * b_[j] + vi * k_[j]); y += s[j] * r_[j]; }
            y += __shfl_xor(y, 1); y += __shfl_xor(y, 2); y += __shfl_xor(y, 4);
            if (seg == 0) *(LAS float*)(lds + SC_Y + st * 256 + i * 4) = y;
        }
        __syncthreads();
        {
            const f32x4 y0 = *(const LAS f32x4*)(lds + SC_Y + tt * 256 + sg * 32), y1 = *(const LAS f32x4*)(lds + SC_Y + tt * 256 + sg * 32 + 16);
            float* dst = P.Y + ((size_t)b * SEQ + chunk * 64 + tt) * 1024 + cb;
            *(f32x4*)dst = y0; *(f32x4*)(dst + 4) = y1;
        }
    }
#undef SC_LOAD
}

__device__ __forceinline__ void post_token(const Ptrs& P, int m, int lane) {
    const bf16* row = P.PROJ + (size_t)m * PJ;
    const bool has_prev = (m % SEQ) != 0;
    const int c = lane * 16, h = lane >> 2;
    float y[16], vs[16], g[16], lg[16], lb[16];
    ld16f(P.Y + (size_t)m * 1024 + c, y);
    float s = 0.f;
#pragma unroll
    for (int i = 0; i < 16; ++i) s += y[i];
    s += __shfl_xor(s, 1); s += __shfl_xor(s, 2);
    const float mean = s * (1.f / 64.f);
    float q = 0.f;
#pragma unroll
    for (int i = 0; i < 16; ++i) { y[i] -= mean; q += y[i] * y[i]; }
    q += __shfl_xor(q, 1); q += __shfl_xor(q, 2);
    const float rstd = 1.0f / sqrtf(q * (1.f / 64.f) + 64e-5f);
    shift16(row, has_prev, C_V + c, P.mu, vs);
    ld16bf(P.G + (size_t)m * 1024 + c, g); ld16f(P.lnx_g + c, lg); ld16f(P.lnx_b + c, lb);
    const float bon = P.BON[(size_t)m * 16 + h];
#pragma unroll
    for (int i = 0; i < 16; ++i) y[i] = (y[i] * rstd * lg[i] + lb[i] + bon * vs[i]) * g[i];
    st16bf(P.MIXED + (size_t)m * 2048 + c, y);
}
__device__ __forceinline__ unsigned pack_fp8x4(float a, float b, float c, float d) {
    int w = __builtin_amdgcn_cvt_pk_fp8_f32(a, b, 0, false);
    w = __builtin_amdgcn_cvt_pk_fp8_f32(c, d, w, true);
    return (unsigned)w;
}
__device__ __forceinline__ void fp8_row(const float* src, unsigned char* dst, float* mult, int lane) {
    const GAS f32x4* xr = (const GAS f32x4*)src + lane;
    f32x4 v[8]; float am = 0.f;
#pragma unroll
    for (int j = 0; j < 8; ++j) { v[j] = xr[64 * j]; am = fmaxf(am, fmaxf(fmaxf(fabsf(v[j].x), fabsf(v[j].y)), fmaxf(fabsf(v[j].z), fabsf(v[j].w)))); }
    am = wave_max(am);
    const float sc = am > 0.f ? 224.0f / am : 1.0f;
    GAS unsigned* o = (GAS unsigned*)dst + lane;
#pragma unroll
    for (int j = 0; j < 8; ++j) o[64 * j] = pack_fp8x4(v[j].x * sc, v[j].y * sc, v[j].z * sc, v[j].w * sc);
    if (lane == 0) *mult = am > 0.f ? am * (1.0f / 224.0f) : 1.0f;
}
__device__ __forceinline__ unsigned enc_key(float s) { const unsigned b = __float_as_uint(s); return b ^ ((b >> 31) ? 0xFFFFFFFFu : 0x80000000u); }
__device__ __forceinline__ float dec_key(unsigned u) { const unsigned b = (u & 0x80000000u) ? (u ^ 0x80000000u) : ~u; return __uint_as_float(b); }
__device__ __forceinline__ void ins16(unsigned (&L)[16], unsigned x) {
#pragma unroll
    for (int i = 0; i < 16; ++i) { const unsigned hi = max(L[i], x); x = min(L[i], x); L[i] = hi; }
}
__device__ __forceinline__ void peer_topk(const Ptrs& P, int h, int tok0, LAS unsigned char* lds, int tid) {
    const int lane = tid & 63, w = tid >> 6;
    { const f32x4* src = (const f32x4*)(P.sub_keys + (size_t)h * 2 * 128 * 64);
      for (int i = tid; i < 4096; i += 512) *(LAS f32x4*)(lds + 16 * i) = src[i]; }
    __syncthreads();
    const int t = tok0 + w * 64 + lane;
    unsigned L[2][16];
#pragma unroll
    for (int p = 0; p < 2; ++p) {
#pragma unroll
        for (int i = 0; i < 16; ++i) L[p][i] = 0u;
        float q[64];
        { const bf16* qp = P.QP + (size_t)t * 1024 + h * 128 + p * 64;
#pragma unroll
          for (int j = 0; j < 4; ++j) { float x[16]; ld16bf(qp + 16 * j, x);
#pragma unroll
              for (int i = 0; i < 16; ++i) q[16 * j + i] = x[i]; } }
        for (int n = 0; n < 128; ++n) {
            const LAS f32x4* kp = (const LAS f32x4*)(lds + (size_t)(p * 128 + n) * 256);
            float s0 = 0.f, s1 = 0.f, s2 = 0.f, s3 = 0.f;
#pragma unroll
            for (int d = 0; d < 16; ++d) { const f32x4 k = kp[d]; s0 += q[4 * d] * k.x; s1 += q[4 * d + 1] * k.y; s2 += q[4 * d + 2] * k.z; s3 += q[4 * d + 3] * k.w; }
            const float s = (s0 + s1) + (s2 + s3);
            ins16(L[p], (enc_key(s) & ~0x7Fu) | (unsigned)(127 - n));
        }
    }
    unsigned F[16];
#pragma unroll
    for (int i = 0; i < 16; ++i) F[i] = 0u;
    float v1[16], v2[16];
#pragma unroll
    for (int i = 0; i < 16; ++i) { v1[i] = dec_key((L[0][i] & ~0x7Fu) | 0x40u); v2[i] = dec_key((L[1][i] & ~0x7Fu) | 0x40u); }
#pragma unroll
    for (int a = 0; a < 16; ++a)
#pragma unroll
        for (int b = 0; b < 16; ++b)
            if ((a + 1) * (b + 1) <= 16) ins16(F, (enc_key(v1[a] + v2[b]) & ~0xFFu) | (unsigned)(255 - (16 * a + b)));
    float sv[16]; unsigned id[16];
#pragma unroll
    for (int i = 0; i < 16; ++i) {
        sv[i] = dec_key((F[i] & ~0xFFu) | 0x80u);
        const unsigned ab = 255u - (F[i] & 0xFFu), a = ab >> 4, b = ab & 15u;
        unsigned la = 0u, lb = 0u;
#pragma unroll
        for (int j = 0; j < 16; ++j) { la = (a == (unsigned)j) ? L[0][j] : la; lb = (b == (unsigned)j) ? L[1][j] : lb; }
        id[i] = (127u - (la & 0x7Fu)) * 128u + (127u - (lb & 0x7Fu));
    }
    float z = 0.f;
#pragma unroll
    for (int i = 0; i < 16; ++i) { sv[i] = __expf(sv[i] - sv[0]); z += sv[i]; }
    const float rz = 1.0f / z;
    float* gdst = P.GATE + (size_t)t * 128 + h * 16;
#pragma unroll
    for (int i = 0; i < 16; i += 4) *(f32x4*)(gdst + i) = (f32x4){sv[i] * rz, sv[i + 1] * rz, sv[i + 2] * rz, sv[i + 3] * rz};
    unsigned short* idst = P.IDX + (size_t)t * 128 + h * 16;
    *(v4u*)idst = (v4u){id[0] | (id[1] << 16), id[2] | (id[3] << 16), id[4] | (id[5] << 16), id[6] | (id[7] << 16)};
    *(v4u*)(idst + 8) = (v4u){id[8] | (id[9] << 16), id[10] | (id[11] << 16), id[12] | (id[13] << 16), id[14] | (id[15] << 16)};
    __syncthreads();
}

typedef float f32x2v __attribute__((ext_vector_type(2)));
__device__ __forceinline__ float gelu_erf(float x) { return 0.5f * x * (1.0f + erff(x * 0.70710678118654752f)); }
__device__ __forceinline__ void peer_token(const Ptrs& P, int t, int lane) {
    float x2[32];
    { const bf16* xr = P.XN + (size_t)t * 2048 + lane * 16;
      float a[16]; ld16bf(xr, a);
#pragma unroll
      for (int i = 0; i < 16; ++i) x2[i] = a[i];
      ld16bf(xr + 1024, a);
#pragma unroll
      for (int i = 0; i < 16; ++i) x2[16 + i] = a[i]; }
    unsigned idxv[2]; float wv[2];
#pragma unroll
    for (int kb = 0; kb < 2; ++kb) {
        idxv[kb] = P.IDX[(size_t)t * 128 + kb * 64 + lane];
        float p[64];
#pragma unroll
        for (int i = 0; i < 64; ++i) {
            const unsigned e = (unsigned)__builtin_amdgcn_readlane((int)idxv[kb], i);
            const unsigned char* ur = P.U8 + (size_t)e * 2048 + lane * 16;
            const v4u u0 = *(const v4u*)ur, u1 = *(const v4u*)(ur + 1024);
            const unsigned uw[8] = {u0.x, u0.y, u0.z, u0.w, u1.x, u1.y, u1.z, u1.w};
            float a0 = 0.f, a1 = 0.f;
#pragma unroll
            for (int q = 0; q < 8; ++q) { const f32x2v lo = __builtin_amdgcn_cvt_pk_f32_fp8((int)uw[q], false), hi = __builtin_amdgcn_cvt_pk_f32_fp8((int)uw[q], true);
                a0 += lo.x * x2[4 * q] + hi.x * x2[4 * q + 2]; a1 += lo.y * x2[4 * q + 1] + hi.y * x2[4 * q + 3]; }
            p[i] = a0 + a1;
        }
#pragma unroll
        for (int o = 32, n = 64; o >= 1; o >>= 1, n >>= 1) {
            const bool up = (lane & o) != 0;
#pragma unroll
            for (int i = 0; i < n / 2; ++i) { const float keep = up ? p[i + n / 2] : p[i], send = up ? p[i] : p[i + n / 2]; p[i] = keep + __shfl_xor(send, o); }
        }
        const unsigned e = idxv[kb];
        const float hk = gelu_erf(p[0] * P.USC[e]);
        wv[kb] = P.GATE[(size_t)t * 128 + kb * 64 + lane] * hk * P.VSC[e];
    }
    float acc[32];
#pragma unroll
    for (int i = 0; i < 32; ++i) acc[i] = 0.f;
#pragma unroll
    for (int kb = 0; kb < 2; ++kb) {
#pragma unroll 8
        for (int i = 0; i < 64; ++i) {
            const unsigned e = (unsigned)__builtin_amdgcn_readlane((int)idxv[kb], i);
            const float wk = __uint_as_float((unsigned)__builtin_amdgcn_readlane((int)__float_as_uint(wv[kb]), i));
            const unsigned char* vr = P.V8 + (size_t)e * 2048 + lane * 16;
            const v4u u0 = *(const v4u*)vr, u1 = *(const v4u*)(vr + 1024);
            const unsigned uw[8] = {u0.x, u0.y, u0.z, u0.w, u1.x, u1.y, u1.z, u1.w};
#pragma unroll
            for (int q = 0; q < 8; ++q) { const f32x2v lo = __builtin_amdgcn_cvt_pk_f32_fp8((int)uw[q], false), hi = __builtin_amdgcn_cvt_pk_f32_fp8((int)uw[q], true);
                acc[4 * q] += wk * lo.x; acc[4 * q + 1] += wk * lo.y; acc[4 * q + 2] += wk * hi.x; acc[4 * q + 3] += wk * hi.y; }
        }
    }
    float* orow = P.out + (size_t)t * 2048 + lane * 16;
#pragma unroll
    for (int j = 0; j < 2; ++j)
#pragma unroll
        for (int q = 0; q < 4; ++q) { f32x4* o = (f32x4*)(orow + j * 1024 + 4 * q); f32x4 v = *o;
            v.x += acc[16 * j + 4 * q]; v.y += acc[16 * j + 4 * q + 1]; v.z += acc[16 * j + 4 * q + 2]; v.w += acc[16 * j + 4 * q + 3]; *o = v; }
}
struct AttnQueue {
    gu32* ctr; volatile LAS unsigned* slot; int tid;
    __device__ __forceinline__ bool next(int i, attn_body::AttnUnit& u) const {
        if (tid == 0) slot[i & 1] = __hip_atomic_fetch_add(ctr, 1u, RLX_AGENT);
        __syncthreads();
        const unsigned v = (unsigned)__builtin_amdgcn_readfirstlane((int)slot[i & 1]);
        if (v >= 1024u) return false;
        u.qb = 31 - (int)(v >> 5); u.bh = (int)(v & 31u); return true;
    }
    __device__ __forceinline__ void a_ready(const attn_body::AttnUnit&) const {}
    __device__ __forceinline__ void done(const attn_body::AttnUnit&) const {}
};

struct Args { const float* in[23]; float* out; unsigned char* ws; };

__device__ __forceinline__ int lane_id_fresh() { int l; asm volatile("v_mbcnt_lo_u32_b32 %0, -1, 0\n\tv_mbcnt_hi_u32_b32 %0, -1, %0" : "=v"(l)); return l; }
__device__ __forceinline__ Frame make_frame(unsigned char* lds, int wv) {
    Frame F; F.lds = (LAS unsigned char*)lds; F.MISC = (volatile LAS unsigned*)(F.lds + MISC_OFF); F.ctl = nullptr;
    F.lane = lane_id_fresh(); F.wave = wv; F.tid = wv * 64 + F.lane;
    F.G = gridDim.x; { const int bx = blockIdx.x; F.vcu = (F.G % 8 == 0) ? (bx % 8) * (F.G / 8) + bx / 8 : bx; }
    return F;
}
typedef __attribute__((address_space(4))) const unsigned long long kau64;
__device__ __forceinline__ Ptrs make_ptrs(kau64* ka) {
    Ptrs P; struct { const float* in[23]; } args;
#pragma unroll
    for (int i = 0; i < 23; ++i) args.in[i] = (const float*)(GAS const float*)ka[i];
    float* outp = (float*)(GAS float*)ka[23]; unsigned char* ws = (unsigned char*)(GAS unsigned char*)ka[24];
    P.x = args.in[0]; P.norm1_g = args.in[1]; P.w_in = args.in[2]; P.mu = args.in[3]; P.w_decay_up = args.in[4]; P.w0 = args.in[5]; P.w_iclr_up = args.in[6]; P.a0 = args.in[7];
    P.w_gate_up = args.in[8]; P.k_k = args.in[9]; P.k_a = args.in[10]; P.r_k = args.in[11]; P.lnx_g = args.in[12]; P.lnx_b = args.in[13]; P.fox_b_f = args.in[14];
    P.q_norm_g = args.in[15]; P.k_norm_g = args.in[16]; P.w_out = args.in[17]; P.norm2_g = args.in[18]; P.w_q = args.in[19]; P.sub_keys = args.in[20]; P.peer_u = args.in[21]; P.peer_v = args.in[22];
    P.out = outp;
    P.WQT = (bf16*)(ws + WS_WQT); P.LWT = (bf16*)(ws + WS_LWT); P.WOT = (bf16*)(ws + WS_WOT); P.WINT = (bf16*)(ws + WS_WINT); P.LA = (bf16*)(ws + WS_LA);
    P.XN = (bf16*)(ws + WS_XN); P.PROJ = (bf16*)(ws + WS_PROJ); P.MIXED = (bf16*)(ws + WS_MIXED); P.KP = (bf16*)(ws + WS_KP); P.AV = (bf16*)(ws + WS_AV); P.BV = (bf16*)(ws + WS_BV);
    P.QP = (bf16*)(ws + WS_QP); P.G = (bf16*)((unsigned char*)outp + OUT_G); P.AIC = (bf16*)((unsigned char*)outp + OUT_AIC);
    P.C2 = (float*)(ws + WS_C2); P.BON = (float*)(ws + WS_BON); P.Y = (float*)(ws + WS_XN); P.DEC = (float*)((unsigned char*)outp + OUT_DEC);
    P.GATE = (float*)(ws + WS_GATE); P.USC = (float*)(ws + WS_USC); P.VSC = (float*)(ws + WS_VSC);
    P.IDX = (unsigned short*)(ws + WS_IDX); P.U8 = ws + WS_U8; P.V8 = ws + WS_V8;
    return P;
}
#define PHASE_BEGIN() Frame F = make_frame(lds, wv_); const int gw = F.vcu * NWAVES + F.wave, NGW = F.G * NWAVES; (void)gw; (void)NGW; kau64* ka_ = (kau64*)__builtin_amdgcn_kernarg_segment_ptr(); asm volatile("" : "+s"(ka_)); \
    const Ptrs P = make_ptrs(ka_); unsigned char* ws_ = (unsigned char*)(GAS unsigned char*)ka_[24]; (void)ws_; \
    const int lane = F.lane, tid = F.tid; (void)lane; (void)tid
__global__ void __launch_bounds__(NWAVES * 64, 2) hymba_fwd(Args args) {
    extern __shared__ __attribute__((aligned(16))) unsigned char lds[];
    const int wv_ = __builtin_amdgcn_readfirstlane((int)threadIdx.x >> 6);
    { Frame F = make_frame(lds, wv_);
    for (int u = F.tid; u < (LDS_BYTES - LDSCTL_OFF) / 4; u += NWAVES * 64) ((LAS unsigned*)(F.lds + LDSCTL_OFF))[u] = 0u;
    __syncthreads();
    { kau64* kb_ = (kau64*)__builtin_amdgcn_kernarg_segment_ptr(); F.ctl = (gu32*)((GAS unsigned char*)kb_[24] + WS_CTL); }
    (void)xcd_barrier_post((unsigned*)(F.ctl + CW_BAR), F.MISC + 8, F.tid); }
#define GRID_BAR() do { kau64* kb_ = (kau64*)__builtin_amdgcn_kernarg_segment_ptr(); asm volatile("" : "+s"(kb_)); XcdBarrier b_; b_.bar = (unsigned*)((gu32*)((GAS unsigned char*)kb_[24] + WS_CTL) + CW_BAR); b_.x = xb_xcc_id(); b_.st = (volatile LAS unsigned*)((LAS unsigned char*)lds + MISC_OFF) + 8; xcd_barrier(b_, wv_ * 64 + lane_id_fresh()); } while (0)

    { PHASE_BEGIN();
        LAS float* scr = (LAS float*)(F.lds + RING_OFF + F.wave * 16384);
        constexpr int I_IN = 32 * 208, I_O = 32 * 64, I_Q = 32 * 32, I_L = 2 * 32;
        constexpr int NITEMS = I_IN + I_O + I_Q + 3 * I_L;
        for (int it = gw; it < NITEMS; it += NGW) {
            int r = it;
            if (r < I_IN) { p0_transpose_item(P.w_in, 2048, NIN, P.WINT, 2048, scr, r / 208, r % 208, lane); continue; } r -= I_IN;
            if (r < I_O) { p0_transpose_item(P.w_out, 2048, 2048, P.WOT, 2048, scr, r / 64, r % 64, lane); continue; } r -= I_O;
            if (r < I_Q) { p0_transpose_item(P.w_q, 2048, 1024, P.WQT, 2048, scr, r / 32, r % 32, lane); continue; } r -= I_Q;
            if (r < I_L) { p0_transpose_item(P.w_decay_up, 64, 1024, P.LWT, 128, scr, r / 32, r % 32, lane); continue; } r -= I_L;
            if (r < I_L) { p0_transpose_item(P.w_iclr_up, 64, 1024, P.LWT + 1024 * 128, 128, scr, r / 32, r % 32, lane); continue; } r -= I_L;
            p0_transpose_item(P.w_gate_up, 128, 1024, P.LWT + 2 * 1024 * 128, 128, scr, r / 32, r % 32, lane);
        }
        for (int m = gw; m < M; m += NGW) rms_row_to_bf16(P.x + (size_t)m * DMODEL, P.norm1_g, P.XN + (size_t)m * DMODEL, lane);
    }
    GRID_BAR();
    { PHASE_BEGIN();
        pg8::Gemm g{P.XN, P.WINT, M, PJ, DMODEL}; pg8::StaticOrder S; S.init(M, PJ, F.G, (int)blockIdx.x);
        pg8::EpiBf16<0> E{P.PROJ, PJ, nullptr, 0, 0, 1.f};
        pg8::gemm_phase<pg8::EpiBf16<0>, pg8::StaticOrder, PG8_ALIGN, PG8_SP2>(F.lds + RING_OFF, g, S, E, tid);
    }
    GRID_BAR();
    { PHASE_BEGIN();
        if (blockIdx.x < 32) fox_cumsum(P, (int)blockIdx.x, (LAS float*)(F.lds + RING_OFF), tid);
        for (int m = gw; m < M; m += NGW) prepA_token(P, m, lane);
    }
    GRID_BAR();
    { PHASE_BEGIN();
        { pg8::Gemm g{P.LA, P.LWT, M, 1024, 128}; pg8::StaticOrder S; S.init(M, 1024, F.G, (int)blockIdx.x);
          pg8::EpiLora<0> E{P.w0, P.DEC, nullptr};
          pg8::gemm_phase<pg8::EpiLora<0>, pg8::StaticOrder, PG8_ALIGN, PG8_SP2>(F.lds + RING_OFF, g, S, E, tid); }
        { pg8::Gemm g{P.LA + (size_t)M * 128, P.LWT + 1024 * 128, M, 1024, 128}; pg8::StaticOrder S; S.init(M, 1024, F.G, (int)blockIdx.x);
          pg8::EpiLora<1> E{P.a0, nullptr, P.AIC};
          pg8::gemm_phase<pg8::EpiLora<1>, pg8::StaticOrder, PG8_ALIGN, PG8_SP2>(F.lds + RING_OFF, g, S, E, tid); }
        { pg8::Gemm g{P.LA + (size_t)2 * M * 128, P.LWT + 2 * 1024 * 128, M, 1024, 128}; pg8::StaticOrder S; S.init(M, 1024, F.G, (int)blockIdx.x);
          pg8::EpiLora<1> E{nullptr, nullptr, P.G};
          pg8::gemm_phase<pg8::EpiLora<1>, pg8::StaticOrder, PG8_ALIGN, PG8_SP2>(F.lds + RING_OFF, g, S, E, tid); }
    }
    GRID_BAR();
    { PHASE_BEGIN(); for (int m = gw; m < M; m += NGW) prepC_token(P, m, lane); }
    GRID_BAR();
    { PHASE_BEGIN();
        if (blockIdx.x < 32) rwkv_scan(P, (int)blockIdx.x, F.lds + RING_OFF, tid);
        else {
            static_assert(attn_body::ATTN_LDS_BYTES <= RING_BYTES, "attention LDS");
            const attn_body::AttnTensors AT{(const attn_body::bf16*)(P.PROJ + C_FQ), (const attn_body::bf16*)(P.PROJ + C_FK), (const attn_body::bf16*)(P.PROJ + C_FV), (attn_body::bf16*)(P.MIXED + 1024), P.C2};
            const AttnQueue S{(gu32*)(ws_ + WS_CTL) + CW_QUEUE, F.MISC + 16, tid};
            attn_body::attn_phase<AttnQueue>((char*)lds + RING_OFF, AT, S, tid);
        }
    }
    GRID_BAR();
    { PHASE_BEGIN();
        for (int m = gw; m < M; m += NGW) post_token(P, m, lane);
        for (int e = gw; e < 2 * NEXP; e += NGW) {
            if (e < NEXP) fp8_row(P.peer_u + (size_t)e * 2048, P.U8 + (size_t)e * 2048, P.USC + e, lane);
            else fp8_row(P.peer_v + (size_t)(e - NEXP) * 2048, P.V8 + (size_t)(e - NEXP) * 2048, P.VSC + (e - NEXP), lane);
        }
    }
    GRID_BAR();
    { PHASE_BEGIN();
        pg8::Gemm g{P.MIXED, P.WOT, M, DMODEL, DMODEL}; pg8::StaticOrder S; S.init(M, DMODEL, F.G, (int)blockIdx.x);
        pg8::EpiResF32 E{P.x, P.out, DMODEL};
        pg8::gemm_phase<pg8::EpiResF32, pg8::StaticOrder, PG8_ALIGN, PG8_SP2>(F.lds + RING_OFF, g, S, E, tid);
    }
    GRID_BAR();
    { PHASE_BEGIN(); for (int m = gw; m < M; m += NGW) rms_row_to_bf16(P.out + (size_t)m * DMODEL, P.norm2_g, P.XN + (size_t)m * DMODEL, lane); }
    GRID_BAR();
    { PHASE_BEGIN();
        pg8::Gemm g{P.XN, P.WQT, M, 1024, DMODEL}; pg8::StaticOrder S; S.init(M, 1024, F.G, (int)blockIdx.x);
        pg8::EpiBf16<0> E{P.QP, 1024, nullptr, 0, 0, 1.f};
        pg8::gemm_phase<pg8::EpiBf16<0>, pg8::StaticOrder, PG8_ALIGN, PG8_SP2>(F.lds + RING_OFF, g, S, E, tid);
    }
    GRID_BAR();
    { PHASE_BEGIN(); for (int it = (int)blockIdx.x; it < 8 * (M / 512); it += F.G) peer_topk(P, it & 7, (it >> 3) * 512, F.lds + RING_OFF, tid); }
    GRID_BAR();
    { PHASE_BEGIN(); for (int t = gw; t < M; t += NGW) peer_token(P, t, lane); }
}

extern "C" void kernel_launch(void* const* d_in, const int* in_sizes, int n_in, void* d_out, int out_size, void* d_ws, size_t ws_size, hipStream_t stream) {
    static int grid = 0;
    if (grid == 0) {
        if (n_in != 23 || out_size != M * DMODEL || ws_size < WS_END) { fprintf(stderr, "kernel_launch: unexpected shapes (n_in %d, out %d, ws %zu); nothing launched\n", n_in, out_size, ws_size); grid = -1; return; }
        int dev = 0, cus = 0;
        if (hipGetDevice(&dev) != hipSuccess || hipDeviceGetAttribute(&cus, hipDeviceAttributeMultiprocessorCount, dev) != hipSuccess) { grid = -1; return; }
        if (hipFuncSetAttribute((const void*)hymba_fwd, hipFuncAttributeMaxDynamicSharedMemorySize, LDS_BYTES) != hipSuccess) { fprintf(stderr, "kernel_launch: hipFuncSetAttribute failed\n"); grid = -1; return; }
        int per_cu = 0;
        if (hipOccupancyMaxActiveBlocksPerMultiprocessor(&per_cu, (const void*)hymba_fwd, NWAVES * 64, LDS_BYTES) != hipSuccess || per_cu < 1) fprintf(stderr, "kernel_launch: occupancy query reports %d\n", per_cu);
        (void)hipGetLastError();
        grid = cus;
    }
    if (grid < 0) return;
    if (hipMemsetAsync((char*)d_ws + WS_CTL, 0, CTL_ZERO_BYTES, stream) != hipSuccess) return;
    Args a{};
    for (int i = 0; i < 23; ++i) a.in[i] = (const float*)d_in[i];
    a.out = (float*)d_out; a.ws = (unsigned char*)d_ws;
    hipLaunchKernelGGL(hymba_fwd, dim3(grid), dim3(NWAVES * 64), LDS_BYTES, stream, a);
}
```

```cpp
#include <hip/hip_runtime.h>
#include <cstdio>
#include <cstdint>
namespace pg8 {
#define PG8_LAS __attribute__((address_space(3)))
typedef unsigned short bf16_t;
typedef short bf16x8 __attribute__((ext_vector_type(8)));
typedef float f32x4 __attribute__((ext_vector_type(4)));
typedef unsigned u32x4 __attribute__((ext_vector_type(4)));
constexpr int BM = 256, BK = 64, HALF = 128, HTB = HALF * BK * 2  , STAGE_BYTES = 8 * HTB, NXCD = 8, WGM = 8;

__host__ __device__ __forceinline__ int lds_byte(int r, int c) { const int st = (r >> 4) * 2 + (c >> 5), rr = r & 15, cc = c & 31, ob = rr * 64 + cc * 2; return st * 1024 + (ob ^ (((ob >> 9) & 1) << 5)); }
__host__ __device__ __forceinline__ void stage_rc(int b, int& R, int& C) { const int st = b / 1024, sb = b % 1024, swz = sb ^ (((sb >> 9) & 1) << 5); R = (st >> 1) * 16 + swz / 64; C = (st & 1) * 32 + (swz % 64) / 2; }
__host__ __device__ __forceinline__ int perm32(int rho) { const int n = rho >> 4, i = rho & 15; return 8 * (i >> 2) + 4 * n + (i & 3); }

struct Unit { int pm, pn; };
struct Gemm { const bf16_t* A; const bf16_t* Bt; int M, N, K; int adiv = 1 << 20; size_t astride = 0; };

struct StaticOrder {
    int nM, nN, nwg, G, c;
    __host__ __device__ void init(int M, int N, int G_, int c_) { nM = M / BM; nN = N / BM; nwg = nM * nN; G = G_; c = c_; }
    __host__ __device__ bool next(int i, Unit& u) const {
        const long L = (long)i * G + c; if (L >= nwg) return false;
        int wgid = (int)L; { const int q = nwg / NXCD, r = nwg % NXCD, xcd = wgid % NXCD, off = wgid / NXCD; wgid = (xcd < r ? xcd * (q + 1) : r * (q + 1) + (xcd - r) * q) + off; }
        const int nig = WGM * nN, gid = wgid / nig, fm = gid * WGM, gsz = (nM - fm) < WGM ? (nM - fm) : WGM;
        u.pm = fm + ((wgid % nig) % gsz); u.pn = (wgid % nig) / gsz; return true;
    }
    __device__ __forceinline__ void a_ready(const Unit&) const {}
    __device__ __forceinline__ void done(const Unit&) const {}
};

__device__ __forceinline__ unsigned cvt_pk_bf16(float lo, float hi) { unsigned r; asm volatile("v_cvt_pk_bf16_f32 %0, %1, %2" : "=v"(r) : "v"(lo), "v"(hi)); return r; }
typedef float f32x2 __attribute__((ext_vector_type(2)));
__device__ __forceinline__ f32x2 gelu_pk(f32x2 v) {
    const f32x2 av = __builtin_elementwise_abs(v), d = av * 0.2316418882f + 1.0f;
    f32x2 t; t.x = __builtin_amdgcn_rcpf(d.x); t.y = __builtin_amdgcn_rcpf(d.y);
    f32x2 q = t * 0.5307027145f + (-0.7265760135f); q = q * t + 0.7107068705f; q = q * t + (-0.142248368f); q = q * t + 0.127414796f; q = q * t;
    const f32x2 s = (v * v) * (-0.72134752044f);
    f32x2 e; e.x = __builtin_amdgcn_exp2f(s.x); e.y = __builtin_amdgcn_exp2f(s.y);
    const f32x2 m = v * (q * e), r = v - m;
    f32x2 o; o.x = v.x < 0.f ? m.x : r.x; o.y = v.y < 0.f ? m.y : r.y; return o;
}

template <int ACT  > struct EpiBf16 {
    static constexpr bool PERM = true, AFTER_DRAIN = false; static_assert(ACT == 0 || ACT == 1, "EpiBf16: ACT is 0 (none) or 1 (gelu_pk)");
    bf16_t* O; int ldc; const float* bias; int split_cols; size_t split_stride; float scale0;
    __device__ __forceinline__ void operator()(const f32x4 (&acc)[2][2][4][2], const Unit& u, int wr, int wc, int fr, int fq) const {
        const int row0 = u.pm * BM + wr * 64 + fr; int colt = u.pn * BM; bf16_t* base = O;
        float sc = 1.f; if (split_cols) { const int t = colt / split_cols; base += (size_t)t * split_stride; colt -= t * split_cols; if (t == 0) sc = scale0; }
        const int col0 = colt + wc * 32 + 8 * fq, bcol0 = u.pn * BM + wc * 32 + 8 * fq;
        f32x4 bv[2][2];
#pragma unroll
        for (int bj = 0; bj < 2; ++bj)
#pragma unroll
            for (int n = 0; n < 2; ++n) bv[bj][n] = bias ? *(const f32x4*)(bias + bcol0 + bj * HALF + 4 * n) : (f32x4){0.f, 0.f, 0.f, 0.f};
#pragma unroll
        for (int ai = 0; ai < 2; ++ai)
#pragma unroll
            for (int m = 0; m < 4; ++m) { bf16_t* rowp = base + (size_t)(row0 + ai * HALF + m * 16) * ldc + col0;
#pragma unroll
                for (int bj = 0; bj < 2; ++bj) { f32x4 v0 = acc[ai][bj][m][0] + bv[bj][0], v1 = acc[ai][bj][m][1] + bv[bj][1];
                    if (ACT == 1) { f32x2 a = gelu_pk((f32x2){v0[0], v0[1]}), b = gelu_pk((f32x2){v0[2], v0[3]}), c = gelu_pk((f32x2){v1[0], v1[1]}), d = gelu_pk((f32x2){v1[2], v1[3]});
                        v0 = (f32x4){a.x, a.y, b.x, b.y}; v1 = (f32x4){c.x, c.y, d.x, d.y}; }
                    v0 = v0 * sc; v1 = v1 * sc; u32x4 w; w.x = cvt_pk_bf16(v0[0], v0[1]); w.y = cvt_pk_bf16(v0[2], v0[3]); w.z = cvt_pk_bf16(v1[0], v1[1]); w.w = cvt_pk_bf16(v1[2], v1[3]);
                    *(u32x4*)(rowp + bj * HALF) = w; } }
    }
};

typedef unsigned u32x2 __attribute__((ext_vector_type(2)));
struct EpiResF32 {
    static constexpr bool PERM = false, AFTER_DRAIN = false;
    const float* base; float* out; int ldc;
    __device__ __forceinline__ void operator()(const f32x4 (&acc)[2][2][4][2], const Unit& u, int wr, int wc, int fr, int fq) const {
        const int col0 = u.pn * BM + wc * 32 + 4 * fq;
#pragma unroll
        for (int ai = 0; ai < 2; ++ai)
#pragma unroll
            for (int m = 0; m < 4; ++m) { const size_t off = (size_t)(u.pm * BM + ai * HALF + wr * 64 + m * 16 + fr) * ldc + col0;
#pragma unroll
                for (int bj = 0; bj < 2; ++bj)
#pragma unroll
                    for (int n = 0; n < 2; ++n) { const f32x4 b = *(const f32x4*)(base + off + bj * HALF + n * 16); *(f32x4*)(out + off + bj * HALF + n * 16) = b + acc[ai][bj][m][n]; }
                asm volatile("" ::: "memory"); }
    }
};
struct EpiLora3 {
    static constexpr bool PERM = false, AFTER_DRAIN = false;
    const float* w0; const float* a0; float* dec; bf16_t* aic; bf16_t* gg;
    __device__ __forceinline__ void operator()(const f32x4 (&acc)[2][2][4][2], const Unit& u, int wr, int wc, int fr, int fq) const {
        const int br = u.pn >> 2; const int col0 = (u.pn & 3) * BM + wc * 32 + 4 * fq;
        const float* vec = (br == 0) ? w0 : (br == 1) ? a0 : nullptr; bf16_t* outh = (br == 1) ? aic : gg;
#pragma unroll
        for (int bj = 0; bj < 2; ++bj)
#pragma unroll
            for (int n = 0; n < 2; ++n) { const int col = col0 + bj * HALF + n * 16;
                f32x4 p = (f32x4){0.f, 0.f, 0.f, 0.f}; if (vec) p = *(const f32x4*)(vec + col);
#pragma unroll
                for (int ai = 0; ai < 2; ++ai)
#pragma unroll
                    for (int m = 0; m < 4; ++m) { const size_t off = (size_t)(u.pm * BM + ai * HALF + wr * 64 + m * 16 + fr) * 1024 + col;
                        const f32x4 z = acc[ai][bj][m][n] + p;
                        if (br == 0) *(f32x4*)(dec + off) = z;
                        else { u32x2 w; w.x = cvt_pk_bf16(z[0], z[1]); w.y = cvt_pk_bf16(z[2], z[3]); *(u32x2*)(outh + off) = w; } } }
    }
};
struct EpiResNorm {
    static constexpr bool PERM = false, AFTER_DRAIN = false;
    const float* base; float* out; bf16_t* hb; const float* g; float* ssq; int ldc;
    __device__ __forceinline__ void operator()(const f32x4 (&acc)[2][2][4][2], const Unit& u, int wr, int wc, int fr, int fq) const {
        const int col0 = u.pn * BM + wc * 32 + 4 * fq;
        f32x4 gv[2][2];
#pragma unroll
        for (int bj = 0; bj < 2; ++bj)
#pragma unroll
            for (int n = 0; n < 2; ++n) gv[bj][n] = *(const f32x4*)(g + col0 + bj * HALF + n * 16);
#pragma unroll
        for (int ai = 0; ai < 2; ++ai)
#pragma unroll
            for (int m = 0; m < 4; ++m) { const int row = u.pm * BM + ai * HALF + wr * 64 + m * 16 + fr; const size_t off = (size_t)row * ldc + col0; float sq = 0.f;
#pragma unroll
                for (int bj = 0; bj < 2; ++bj)
#pragma unroll
                    for (int n = 0; n < 2; ++n) { const f32x4 hv = *(const f32x4*)(base + off + bj * HALF + n * 16) + acc[ai][bj][m][n]; *(f32x4*)(out + off + bj * HALF + n * 16) = hv;
                        sq += (hv[0] * hv[0] + hv[1] * hv[1]) + (hv[2] * hv[2] + hv[3] * hv[3]);
                        const f32x4 hg = hv * gv[bj][n]; u32x2 w; w.x = cvt_pk_bf16(hg[0], hg[1]); w.y = cvt_pk_bf16(hg[2], hg[3]); *(u32x2*)(hb + off + bj * HALF + n * 16) = w; }
                sq += __shfl_xor(sq, 16); sq += __shfl_xor(sq, 32);
                if (fq == 0) ssq[(size_t)row * 32 + u.pn * 4 + wc] = sq;
                asm volatile("" ::: "memory"); }
    }
};
struct EpiBf16RowNorm {
    static constexpr bool PERM = true, AFTER_DRAIN = false;
    bf16_t* O; int ldc; const float* ssq; float inv_n, eps;
    __device__ __forceinline__ void operator()(const f32x4 (&acc)[2][2][4][2], const Unit& u, int wr, int wc, int fr, int fq) const {
        const int row0 = u.pm * BM + wr * 64 + fr, col0 = u.pn * BM + wc * 32 + 8 * fq;
#pragma unroll
        for (int ai = 0; ai < 2; ++ai)
#pragma unroll
            for (int m = 0; m < 4; ++m) { const int row = row0 + ai * HALF + m * 16; const f32x4 s0 = *(const f32x4*)(ssq + (size_t)row * 32 + fq * 8), s1 = *(const f32x4*)(ssq + (size_t)row * 32 + fq * 8 + 4); float ss = ((s0[0] + s0[1]) + (s0[2] + s0[3])) + ((s1[0] + s1[1]) + (s1[2] + s1[3]));
                ss += __shfl_xor(ss, 16); ss += __shfl_xor(ss, 32); const float rs = 1.0f / sqrtf(ss * inv_n + eps); bf16_t* rowp = O + (size_t)row * ldc + col0;
#pragma unroll
                for (int bj = 0; bj < 2; ++bj) { const f32x4 v0 = acc[ai][bj][m][0] * rs, v1 = acc[ai][bj][m][1] * rs;
                    u32x4 w; w.x = cvt_pk_bf16(v0[0], v0[1]); w.y = cvt_pk_bf16(v0[2], v0[3]); w.z = cvt_pk_bf16(v1[0], v1[1]); w.w = cvt_pk_bf16(v1[2], v1[3]);
                    *(u32x4*)(rowp + bj * HALF) = w; } }
    }
};
template <class Epi, class Sched, bool ALIGN_EPI = false, bool SP2 = false>
__device__ __forceinline__ void gemm_phase(PG8_LAS unsigned char* lds, const Gemm g, const Sched& S, const Epi& E, int tid_in) {
    int tid_ = tid_in; asm volatile("" : "+v"(tid_));
    const int tid = tid_, wid = __builtin_amdgcn_readfirstlane(tid >> 6), lane = tid & 63, wr = wid >> 2, wc = wid & 3, fr = lane & 15, fq = lane >> 4;
    const int K = g.K, nt = K / BK;
    unsigned voffA[2], voffB[2];
#pragma unroll
    for (int i = 0; i < 2; ++i) { int R, C; stage_rc(tid * 16 + i * 8192, R, C); const int Rb = Epi::PERM ? ((R & ~31) + perm32(R & 31)) : R;
        voffA[i] = (unsigned)(R * K + C) * 2u; voffB[i] = (unsigned)(Rb * K + C) * 2u; }
    const size_t kstep = (size_t)(BK * 2);
    const size_t hstep = (size_t)HALF * K * 2;
    const size_t tstep = 2 * hstep;
    const unsigned ldsw = (unsigned)wid * 1024u;
    const int aoff = lds_byte(wr * 64 + fr, fq * 8), boff = lds_byte(wc * 32 + fr, fq * 8);
#define PG8_SA(b, h) (((b) * 2 + (h)) * HTB)
#define PG8_SB(b, h) ((4 + (b) * 2 + (h)) * HTB)
#define PG8_STAGE(bufoff, gbase, voff) do { _Pragma("unroll") for (int _i = 0; _i < 2; ++_i) \
        __builtin_amdgcn_global_load_lds((const unsigned*)((const char*)(gbase) + (voff)[_i]), (PG8_LAS unsigned*)(lds + (bufoff) + ldsw + _i * 8192), 16, 0, 0); } while (0)
#define PG8_LDA(dst, b, h) do { _Pragma("unroll") for (int m = 0; m < 4; ++m) _Pragma("unroll") for (int k = 0; k < 2; ++k) dst[m][k] = *(const PG8_LAS bf16x8*)(lds + PG8_SA(b, h) + aoff + m * 2048 + k * 1024); } while (0)
#define PG8_LDB(dst, b, h) do { _Pragma("unroll") for (int n = 0; n < 2; ++n) _Pragma("unroll") for (int k = 0; k < 2; ++k) dst[n][k] = *(const PG8_LAS bf16x8*)(lds + PG8_SB(b, h) + boff + n * 2048 + k * 1024); } while (0)
#define PG8_MMA(ai, bj, At, Bt) do { __builtin_amdgcn_s_setprio(1); _Pragma("unroll") for (int m = 0; m < 4; ++m) _Pragma("unroll") for (int n = 0; n < 2; ++n) _Pragma("unroll") for (int k = 0; k < 2; ++k) \
        acc[ai][bj][m][n] = __builtin_amdgcn_mfma_f32_16x16x32_bf16(Bt[n][k], At[m][k], acc[ai][bj][m][n], 0, 0, 0); __builtin_amdgcn_s_setprio(0); } while (0)
#define PG8_WAIT_V(n) asm volatile("s_waitcnt vmcnt(" #n ")" ::: "memory")
#define PG8_WAIT_L(n) asm volatile("s_waitcnt lgkmcnt(" #n ")" ::: "memory")
#define PG8_BAR __builtin_amdgcn_s_barrier()
#define PG8_SCHED __builtin_amdgcn_sched_barrier(0)
    Unit cur, nxt; int ui = 0;
    if (!S.next(0, cur)) return;
    f32x4 acc[2][2][4][2];
#pragma unroll
    for (int a = 0; a < 2; ++a)
#pragma unroll
        for (int b = 0; b < 2; ++b)
#pragma unroll
            for (int m = 0; m < 4; ++m)
#pragma unroll
                for (int n = 0; n < 2; ++n) acc[a][b][m][n] = (f32x4){0.f, 0.f, 0.f, 0.f};
    bf16x8 At[4][2], B0[2][2], B1[2][2];
    const char* cA = (const char*)g.A + (size_t)cur.pm * tstep + (size_t)(cur.pn / g.adiv) * g.astride; const char* cB = (const char*)g.Bt + (size_t)cur.pn * tstep;
    S.a_ready(cur);
    if constexpr (SP2) {
        PG8_STAGE(PG8_SB(0, 0), cB, voffB); PG8_STAGE(PG8_SB(0, 1), cB + hstep, voffB); PG8_STAGE(PG8_SA(0, 0), cA, voffA); PG8_STAGE(PG8_SA(0, 1), cA + hstep, voffA);
        if (wr == 1) PG8_BAR;
        PG8_WAIT_V(2); PG8_BAR;
        PG8_STAGE(PG8_SB(1, 0), cB + kstep, voffB); PG8_STAGE(PG8_SA(1, 0), cA + kstep, voffA); PG8_STAGE(PG8_SB(1, 1), cB + hstep + kstep, voffB);
        PG8_WAIT_V(6); PG8_BAR;
    } else {
        PG8_STAGE(PG8_SB(0, 0), cB, voffB); PG8_STAGE(PG8_SA(0, 0), cA, voffA); PG8_STAGE(PG8_SB(0, 1), cB + hstep, voffB); PG8_STAGE(PG8_SA(0, 1), cA + hstep, voffA);
        if (wr == 1) PG8_BAR;
        PG8_WAIT_V(4); PG8_BAR;
        PG8_STAGE(PG8_SB(1, 0), cB + kstep, voffB); PG8_STAGE(PG8_SA(1, 0), cA + kstep, voffA); PG8_STAGE(PG8_SB(1, 1), cB + hstep + kstep, voffB);
        PG8_WAIT_V(6); PG8_BAR;
    }
    for (;;) {
        const bool has_next = S.next(ui + 1, nxt);
        const char* nA = has_next ? (const char*)g.A + (size_t)nxt.pm * tstep + (size_t)(nxt.pn / g.adiv) * g.astride : cA; const char* nB = has_next ? (const char*)g.Bt + (size_t)nxt.pn * tstep : cB;
        for (int t = 0; t < nt; t += 2) {
            const bool last = (t == nt - 2);
            const char* a1 = cA + (size_t)(t + 1) * kstep;
            const char* a2 = last ? nA : cA + (size_t)(t + 2) * kstep; const char* b2 = last ? nB : cB + (size_t)(t + 2) * kstep;
            const char* a3 = a2 + kstep; const char* b3 = b2 + kstep;
            if (last && has_next) S.a_ready(nxt);
            if constexpr (SP2) {
            PG8_LDB(B0, 0, 0); PG8_LDB(B1, 0, 1); PG8_SCHED; PG8_LDA(At, 0, 0); PG8_STAGE(PG8_SA(1, 1), a1 + hstep, voffA);
            PG8_WAIT_V(8); PG8_WAIT_L(0); PG8_BAR; PG8_MMA(0, 0, At, B0); PG8_MMA(0, 1, At, B1); PG8_BAR; PG8_SCHED;
            PG8_LDA(At, 0, 1); PG8_STAGE(PG8_SB(0, 0), b2, voffB); PG8_STAGE(PG8_SB(0, 1), b2 + hstep, voffB); PG8_STAGE(PG8_SA(0, 0), a2, voffA);
            PG8_WAIT_V(8); PG8_WAIT_L(0); PG8_BAR; PG8_MMA(1, 0, At, B0); PG8_MMA(1, 1, At, B1); PG8_BAR; PG8_SCHED;
            PG8_LDB(B0, 1, 0); PG8_LDB(B1, 1, 1); PG8_SCHED; PG8_LDA(At, 1, 0); PG8_STAGE(PG8_SA(0, 1), a2 + hstep, voffA);
            PG8_WAIT_V(8); PG8_WAIT_L(0); PG8_BAR; PG8_MMA(0, 0, At, B0); PG8_MMA(0, 1, At, B1); PG8_BAR; PG8_SCHED;
            PG8_LDA(At, 1, 1); PG8_STAGE(PG8_SB(1, 0), b3, voffB); PG8_STAGE(PG8_SB(1, 1), b3 + hstep, voffB); PG8_STAGE(PG8_SA(1, 0), a3, voffA);
            PG8_WAIT_V(8); PG8_WAIT_L(0); PG8_BAR; PG8_MMA(1, 0, At, B0); PG8_MMA(1, 1, At, B1); PG8_BAR; PG8_SCHED;
            } else {
            PG8_LDB(B0, 0, 0); PG8_SCHED; PG8_LDA(At, 0, 0); PG8_STAGE(PG8_SA(1, 1), a1 + hstep, voffA);
            PG8_WAIT_L(8); PG8_BAR; PG8_WAIT_L(0); PG8_MMA(0, 0, At, B0); PG8_BAR; PG8_SCHED;
            PG8_LDB(B1, 0, 1); PG8_STAGE(PG8_SB(0, 0), b2, voffB);
            PG8_BAR; PG8_WAIT_L(0); PG8_MMA(0, 1, At, B1); PG8_BAR;
            PG8_LDA(At, 0, 1); PG8_STAGE(PG8_SA(0, 0), a2, voffA);
            PG8_BAR; PG8_WAIT_L(0); PG8_MMA(1, 0, At, B0); PG8_BAR; PG8_SCHED;
            PG8_STAGE(PG8_SB(0, 1), b2 + hstep, voffB);
            PG8_WAIT_V(6); PG8_BAR; PG8_MMA(1, 1, At, B1); PG8_BAR;
            PG8_LDB(B0, 1, 0); PG8_SCHED; PG8_LDA(At, 1, 0); PG8_STAGE(PG8_SA(0, 1), a2 + hstep, voffA);
            PG8_WAIT_L(8); PG8_BAR; PG8_WAIT_L(0); PG8_MMA(0, 0, At, B0); PG8_BAR; PG8_SCHED;
            PG8_LDB(B1, 1, 1); PG8_STAGE(PG8_SB(1, 0), b3, voffB);
            PG8_BAR; PG8_WAIT_L(0); PG8_MMA(0, 1, At, B1); PG8_BAR;
            PG8_LDA(At, 1, 1); PG8_STAGE(PG8_SA(1, 0), a3, voffA);
            PG8_BAR; PG8_WAIT_L(0); PG8_MMA(1, 0, At, B0); PG8_BAR; PG8_SCHED;
            PG8_STAGE(PG8_SB(1, 1), b3 + hstep, voffB);
            PG8_WAIT_V(6); PG8_BAR; PG8_MMA(1, 1, At, B1); PG8_BAR;
            }
        }
        if constexpr (ALIGN_EPI) { if (wr == 0) PG8_BAR; }
        if constexpr (!Epi::AFTER_DRAIN) { E(acc, cur, wr, wc, fr, fq); S.done(cur); }
        if (!has_next) break;
#pragma unroll
        for (int a = 0; a < 2; ++a)
#pragma unroll
            for (int b = 0; b < 2; ++b)
#pragma unroll
                for (int m = 0; m < 4; ++m)
#pragma unroll
                    for (int n = 0; n < 2; ++n) acc[a][b][m][n] = (f32x4){0.f, 0.f, 0.f, 0.f};
        cur = nxt; cA = nA; cB = nB; ++ui;
        if constexpr (ALIGN_EPI) { if (wr == 1) PG8_BAR; }
    }
    PG8_WAIT_V(0);
    if constexpr (!ALIGN_EPI) { if (wr == 0) PG8_BAR; }
    PG8_BAR;
    if constexpr (Epi::AFTER_DRAIN) { E.fused(acc, cur, wr, wc, fr, fq, lds, wid, lane); S.done(cur); }
#undef PG8_SA
#undef PG8_SB
#undef PG8_STAGE
#undef PG8_LDA
#undef PG8_LDB
#undef PG8_MMA
#undef PG8_WAIT_V
#undef PG8_WAIT_L
#undef PG8_BAR
#undef PG8_SCHED
}
}

#ifndef PG8_SP2
#define PG8_SP2 true
#endif
#ifndef PG8_ALIGN
#define PG8_ALIGN true
#endif
#include <hip/hip_bf16.h>
#include <cmath>
namespace attn_body {
using bf16=__hip_bfloat16;
using bf16x8=__attribute__((ext_vector_type(8)))short;
using s16x4=__attribute__((ext_vector_type(4)))short;
using f32x16=__attribute__((ext_vector_type(16)))float;
using u32x4=__attribute__((ext_vector_type(4)))unsigned;
constexpr int BATCH=2,NHEAD=16,SEQ=8192,D=64,DM=6656,DMO=2048;
constexpr int NW=8,QBLK=32,QB=QBLK*NW,KVBLK=64,NQB=SEQ/QB;
constexpr int ATTN_UNIT_ROWS=QB;
__device__ __forceinline__ int crow(int r,int hi){return (r&3)+8*(r>>2)+4*hi;}
#define SBAR() __builtin_amdgcn_sched_barrier(0)
__device__ __forceinline__ void cmask(f32x16&p0,f32x16&p1,int jb,int qrel,int hi){
  const float NEG=-INFINITY; int kb=64*jb+4*hi;
  #pragma unroll
  for(int r=0;r<16;++r){int kv=kb+(r&3)+8*(r>>2); if(kv>qrel)p0[r]=NEG; if(kv+32>qrel)p1[r]=NEG;}
}

constexpr int NSLOT=3, SLOTB=8192;
constexpr int LDS_K=0, LDS_V=NSLOT*SLOTB, LDS_WS=2*NSLOT*SLOTB, LDS_OST=LDS_WS+NW*64*4, LDS_CK=LDS_OST+NW*4096, LDS_BYTES=LDS_CK+SEQ*4;
constexpr float C2=0.125f*1.4426950408889634f;
__device__ __forceinline__ void glds16(const void*gsrc,unsigned lds_dst){unsigned keep;
  asm volatile("s_mov_b32 %0, m0\n\ts_mov_b32 m0, %2\n\ts_nop 0\n\tglobal_load_lds_dwordx4 %1, off\n\ts_mov_b32 m0, %0":"=&s"(keep):"v"(gsrc),"s"(lds_dst):"memory");}
__device__ __forceinline__ void glds16s(const void*sbase,unsigned voff,unsigned lds_dst){unsigned keep;
  asm volatile("s_mov_b32 %0, m0\n\ts_mov_b32 m0, %3\n\ts_nop 0\n\tglobal_load_lds_dwordx4 %1, %2\n\ts_mov_b32 m0, %0":"=&s"(keep):"v"(voff),"s"(sbase),"s"(lds_dst):"memory");}
__device__ __forceinline__ float max3f(float a,float b,float c){float r;asm("v_max3_f32 %0, %1, %2, %3":"=v"(r):"v"(a),"v"(b),"v"(c));return r;}
__device__ __forceinline__ float max2f(float a,float b){float r;asm("v_max_f32_e32 %0, %1, %2":"=v"(r):"v"(a),"v"(b));return r;}
__device__ __forceinline__ float fadd_s(float a,float b){float r;asm("v_add_f32_e32 %0, %1, %2":"=v"(r):"v"(a),"v"(b));return r;}
__device__ __forceinline__ float fsub_s(float a,float b){float r;asm("v_sub_f32_e32 %0, %1, %2":"=v"(r):"v"(a),"v"(b));return r;}
typedef float f32x2_t __attribute__((ext_vector_type(2))); typedef __bf16 bf16x2_t __attribute__((ext_vector_type(2)));
__device__ __forceinline__ unsigned cvtpk_s(float lo,float hi){f32x2_t v={lo,hi};bf16x2_t b=__builtin_convertvector(v,bf16x2_t);return __builtin_bit_cast(unsigned,b);}
#define WAIT_BAR(N) asm volatile("s_waitcnt vmcnt(" #N ") lgkmcnt(0)\n\ts_barrier":::"memory")

__device__ __forceinline__ void qkt(f32x16&p0,f32x16&p1,const char*Kslot,const bf16x8*qr,int r32,int hi){
  const char*kb=Kslot+hi*1024+r32*16;
  #pragma unroll
  for(int d0=0;d0<4;++d0){
    const bf16x8 b0=*reinterpret_cast<const bf16x8*>(kb+d0*2048);
    const bf16x8 b1=*reinterpret_cast<const bf16x8*>(kb+d0*2048+512);
    p0=__builtin_amdgcn_mfma_f32_32x32x16_bf16(b0,qr[d0],p0,0,0,0);p1=__builtin_amdgcn_mfma_f32_32x32x16_bf16(b1,qr[d0],p1,0,0,0);}
}
typedef __attribute__((address_space(3))) const char* lds_cptr;
typedef short v4i16_t __attribute__((ext_vector_type(4)));
__device__ __forceinline__ void kload8(bf16x8*kf,lds_cptr kp){
  kf[0]=*(const __attribute__((address_space(3))) bf16x8*)(kp);      kf[1]=*(const __attribute__((address_space(3))) bf16x8*)(kp+512);
  kf[2]=*(const __attribute__((address_space(3))) bf16x8*)(kp+2048); kf[3]=*(const __attribute__((address_space(3))) bf16x8*)(kp+2560);
  kf[4]=*(const __attribute__((address_space(3))) bf16x8*)(kp+4096); kf[5]=*(const __attribute__((address_space(3))) bf16x8*)(kp+4608);
  kf[6]=*(const __attribute__((address_space(3))) bf16x8*)(kp+6144); kf[7]=*(const __attribute__((address_space(3))) bf16x8*)(kp+6656);
}
__device__ __forceinline__ void kload2(bf16x8*kf,lds_cptr kp,int j){ kf[2*j]=*(const __attribute__((address_space(3))) bf16x8*)(kp+j*2048); kf[2*j+1]=*(const __attribute__((address_space(3))) bf16x8*)(kp+j*2048+512); }
__device__ __forceinline__ s16x4 vtr(lds_cptr p){ return __builtin_bit_cast(s16x4,__builtin_amdgcn_ds_read_tr16_b64_v4i16((__attribute__((address_space(3))) v4i16_t*)p)); }
typedef float f32x4c __attribute__((ext_vector_type(4)));
__device__ __forceinline__ void ldck(f32x16&c0,f32x16&c1,lds_cptr ckt){
  #pragma unroll
  for(int g=0;g<4;++g){ const f32x4c a=*(const __attribute__((address_space(3))) f32x4c*)(ckt+32*g); const f32x4c b=*(const __attribute__((address_space(3))) f32x4c*)(ckt+128+32*g);
    c0[4*g]=a[0];c0[4*g+1]=a[1];c0[4*g+2]=a[2];c0[4*g+3]=a[3]; c1[4*g]=b[0];c1[4*g+1]=b[1];c1[4*g+2]=b[2];c1[4*g+3]=b[3]; }
}
__device__ __forceinline__ float rowmax(const f32x16&p0,const f32x16&p1){
  float a=max3f(p0[0],p0[1],p1[0]),b=max3f(p0[2],p0[3],p1[1]);a=max3f(a,p1[2],p1[3]);
  #pragma unroll
  for(int r=4;r<16;r+=4){a=max3f(a,p0[r],p0[r+1]);b=max3f(b,p0[r+2],p0[r+3]);a=max3f(a,p1[r],p1[r+1]);b=max3f(b,p1[r+2],p1[r+3]);}
  const float m=max2f(a,b);
  auto rr=__builtin_amdgcn_permlane32_swap(__float_as_uint(m),__float_as_uint(m),false,false);
  return max2f(__uint_as_float(rr[0]),__uint_as_float(rr[1]));
}
__device__ __forceinline__ void pv(f32x16*o,int vb,bf16x8 pa0,bf16x8 pa1,bf16x8 pa2,bf16x8 pa3){
  #pragma unroll
  for(int d0=0;d0<2;++d0){s16x4 lo[4],hi[4];
    #pragma unroll
    for(int ks=0;ks<4;++ks){
      asm volatile("ds_read_b64_tr_b16 %0,%1 offset:%c2":"=&v"(lo[ks]):"v"(vb),"i"(d0*4096+ks*1024):"memory");
      asm volatile("ds_read_b64_tr_b16 %0,%1 offset:%c2":"=&v"(hi[ks]):"v"(vb),"i"(d0*4096+ks*1024+512):"memory");}
    asm volatile("s_waitcnt lgkmcnt(0)":::"memory");SBAR();
    #define PK(k) (bf16x8){lo[k][0],lo[k][1],lo[k][2],lo[k][3],hi[k][0],hi[k][1],hi[k][2],hi[k][3]}
    o[d0]=__builtin_amdgcn_mfma_f32_32x32x16_bf16(pa0,PK(0),o[d0],0,0,0);
    o[d0]=__builtin_amdgcn_mfma_f32_32x32x16_bf16(pa1,PK(1),o[d0],0,0,0);
    o[d0]=__builtin_amdgcn_mfma_f32_32x32x16_bf16(pa2,PK(2),o[d0],0,0,0);
    o[d0]=__builtin_amdgcn_mfma_f32_32x32x16_bf16(pa3,PK(3),o[d0],0,0,0);
    #undef PK
  }
}

#ifndef ATTN_STORE16
#define ATTN_STORE16(p,v) (*(u32x4*)(p)=(v))
#endif
template<int THRL> __device__ __forceinline__ void attn_unit(int b,int h,int qb,const bf16*Q,const bf16*K,const bf16*V,bf16*O,const float*C2G,char*shm,int tid_in){
  int tid_=tid_in; asm volatile("":"+v"(tid_)); const int tid=tid_,lane=tid&63,r32=lane&31,hi=lane>>5; const int wid=__builtin_amdgcn_readfirstlane(tid>>6);
  const long rowbase=(long)b*SEQ; const int q0=qb*QB;
  const bf16*Qw=Q+(rowbase+q0+wid*QBLK)*DM+h*D;
  const bf16*Kh=K+rowbase*DM+h*D,*Vh=V+rowbase*DM+h*D;
  const unsigned lds0=(unsigned)(uintptr_t)shm;
  float*wsf=(float*)(shm+LDS_WS)+wid*64;
  const unsigned koff=(unsigned)(lane*DM+wid*8)*2u;
  const unsigned voff=(unsigned)((16*(wid&3)+(lane>>2))*DM+(wid>>2)*32+(lane&3)*8)*2u;
  const unsigned kdst=lds0+LDS_K+wid*1024, vdst=lds0+LDS_V+wid*1024;
  #define DMA_K(t,slot) glds16s(Kh+(long)(t)*KVBLK*DM,koff,(unsigned)__builtin_amdgcn_readfirstlane(kdst+(slot)))
  #define DMA_V(t,slot) glds16s(Vh+(long)(t)*KVBLK*DM,voff,(unsigned)__builtin_amdgcn_readfirstlane(vdst+(slot)))
  const int vb0=(int)(lds0+LDS_V)+((lane>>4)&1)*32+(lane&3)*8+(4*hi+((lane&15)>>2))*64;
  const char*Kbase=shm+LDS_K; bf16x8 kf[8];
  const lds_cptr shm3=(lds_cptr)shm; const lds_cptr kp0=shm3+LDS_K+hi*1024+r32*16; const lds_cptr vp0=shm3+LDS_V+((lane>>4)&1)*32+(lane&3)*8+(4*hi+((lane&15)>>2))*64;
  const int NT=(q0+QB)/KVBLK;
  { const float*csrc=C2G+(long)(b*NHEAD+h)*SEQ; const int n4=(q0+QB)/4;
    for(int i4=tid;i4<n4;i4+=NW*64){ const f32x4c v=*(const f32x4c*)(csrc+4*i4); *(__attribute__((address_space(3))) f32x4c*)(shm3+LDS_CK+16*i4)=v; } }
  asm volatile("s_waitcnt vmcnt(0) lgkmcnt(0)\n\ts_barrier":::"memory");
  const float cq2=*(const __attribute__((address_space(3))) float*)(shm3+LDS_CK+4*(q0+wid*QBLK+r32));
  const lds_cptr ckp0=shm3+LDS_CK+16*hi;
  DMA_K(0,0);DMA_V(0,0);DMA_K(1,SLOTB);
  bf16x8 qr[4];
  #pragma unroll
  for(int d0=0;d0<4;++d0)qr[d0]=*reinterpret_cast<const bf16x8*>(&Qw[(long)r32*DM+d0*16+hi*8]);
  float l_reg=0.f;f32x16 o[2];o[0]=f32x16{};o[1]=f32x16{};
  const int qrel=wid*QBLK+r32;
  #define CMASK(P0,P1,t) do{int jb_=(t)-(NT-4); if(jb_>=0)cmask(P0,P1,jb_,qrel,hi);}while(0)
  #define CINIT(X) do{ _Pragma("unroll") for(int r=0;r<16;++r)X[r]=cq2-X[r]; }while(0)
  f32x16 pA0,pA1,pB0,pB1;
  int sl_prev=0,sl_cur=0,sl_next=SLOTB;
  #define ROT() do{sl_prev=sl_cur;sl_cur=sl_next;sl_next=(sl_next==(NSLOT-1)*SLOTB)?0:sl_next+SLOTB;}while(0)
  DMA_K(2,2*SLOTB);
  WAIT_BAR(3);
  ldck(pA0,pA1,ckp0); CINIT(pA0); CINIT(pA1);
  qkt(pA0,pA1,Kbase,qr,r32,hi);asm volatile("s_nop 15\n\ts_nop 7":"+v"(pA0),"+v"(pA1));CMASK(pA0,pA1,0);
  _Pragma("unroll") for(int r=0;r<16;++r){pA0[r]=__builtin_amdgcn_exp2f(pA0[r]);pA1[r]=__builtin_amdgcn_exp2f(pA1[r]);}
  ldck(pB0,pB1,ckp0+256);
  WAIT_BAR(0);
  DMA_K(3,0);DMA_V(1,SLOTB);
  ROT();
  kload8(kf,kp0+sl_cur);
  WAIT_BAR(2);
  s16x4 vlo[8],vhi[8]; u32x4 pw0,pw1,pw2,pw3;
  #define PKW(P,B) cvtpk_s(P[B],P[B+1])
  #define PAF(k) __builtin_bit_cast(bf16x8,pw##k)
  #define VFR(i) (bf16x8){vlo[i][0],vlo[i][1],vlo[i][2],vlo[i][3],vhi[i][0],vhi[i][1],vhi[i][2],vhi[i][3]}
  #define PIN(x) asm volatile("":"+v"(x))
  #define MX3(a,b,c) __builtin_fmaxf(__builtin_fmaxf((a),(b)),(c))
  #define GAPA(MF,A0,A1,A2,A3,W0,W1,PW) do{ MF; sacc+=A0; sacc+=A1; sacc+=A2; sacc+=A3; PIN(sacc); W0; W1; PIN(PW); SBAR(); }while(0)
  #define EX(v) __builtin_amdgcn_exp2f(v)
  #define GAPB(MF,X,B) do{ MF; X[B]=EX(X[B]); X[B+1]=EX(X[B+1]); X[B+2]=EX(X[B+2]); X[B+3]=EX(X[B+3]); PIN(X); SBAR(); }while(0)
  #define VRD(i) do{ vlo[i]=vtr(vp_+(((i)>>2)*4096+((i)&3)*1024)); vhi[i]=vtr(vp_+(((i)>>2)*4096+((i)&3)*1024+512)); }while(0)
  #define KRD(G,j) do{ if(G){ kload2(kf,kp0+sl_next,j); SBAR(); } }while(0)
  #define STEP(C0,C1,P0,P1,t,GK,GV,GL,GC) do{ SBAR(); \
    const lds_cptr vp_=vp0+sl_prev; \
    CINIT(C0); CINIT(C1); SBAR(); \
    VRD(0); SBAR(); float sacc=(P0[0]+P0[1]); \
    GAPA(C0=__builtin_amdgcn_mfma_f32_32x32x16_bf16(kf[0],qr[0],C0,0,0,0), P0[2],P0[3],P0[4],P0[5],     pw0[0]=PKW(P0,0), pw0[1]=PKW(P0,2), pw0); \
    VRD(4); SBAR(); GAPA(C1=__builtin_amdgcn_mfma_f32_32x32x16_bf16(kf[1],qr[0],C1,0,0,0), P0[6],P0[7],P0[8],P0[9],     pw0[2]=PKW(P0,4), pw0[3]=PKW(P0,6), pw0); \
    VRD(1); SBAR(); GAPA(C0=__builtin_amdgcn_mfma_f32_32x32x16_bf16(kf[2],qr[1],C0,0,0,0),   P0[10],P0[11],P0[12],P0[13], pw1[0]=PKW(P0,8), pw1[1]=PKW(P0,10), pw1); \
    VRD(5); SBAR(); GAPA(C1=__builtin_amdgcn_mfma_f32_32x32x16_bf16(kf[3],qr[1],C1,0,0,0),   P0[14],P0[15],P1[0],P1[1],   pw1[2]=PKW(P0,12),pw1[3]=PKW(P0,14), pw1); \
    VRD(2); SBAR(); GAPA(C0=__builtin_amdgcn_mfma_f32_32x32x16_bf16(kf[4],qr[2],C0,0,0,0),   P1[2],P1[3],P1[4],P1[5],     pw2[0]=PKW(P1,0), pw2[1]=PKW(P1,2), pw2); \
    VRD(6); SBAR(); GAPA(C1=__builtin_amdgcn_mfma_f32_32x32x16_bf16(kf[5],qr[2],C1,0,0,0),   P1[6],P1[7],P1[8],P1[9],     pw2[2]=PKW(P1,4), pw2[3]=PKW(P1,6), pw2); \
    VRD(3); SBAR(); GAPA(C0=__builtin_amdgcn_mfma_f32_32x32x16_bf16(kf[6],qr[3],C0,0,0,0),   P1[10],P1[11],P1[12],P1[13], pw3[0]=PKW(P1,8), pw3[1]=PKW(P1,10), pw3); \
    VRD(7); SBAR(); GAPA(C1=__builtin_amdgcn_mfma_f32_32x32x16_bf16(kf[7],qr[3],C1,0,0,0),   P1[14],P1[15],0.f,0.f,       pw3[2]=PKW(P1,12),pw3[3]=PKW(P1,14), pw3); \
    l_reg+=sacc; \
    if(GK){DMA_K((t)+3,sl_cur);} if(GV){DMA_V((t)+1,sl_next);} \
    CMASK(C0,C1,t); \
    SBAR(); \
    GAPB(o[0]=__builtin_amdgcn_mfma_f32_32x32x16_bf16(PAF(0),VFR(0),o[0],0,0,0), C0,0); \
    GAPB(o[1]=__builtin_amdgcn_mfma_f32_32x32x16_bf16(PAF(0),VFR(4),o[1],0,0,0), C0,4); \
    KRD(GL,0); GAPB(o[0]=__builtin_amdgcn_mfma_f32_32x32x16_bf16(PAF(1),VFR(1),o[0],0,0,0), C0,8); \
    KRD(GL,1); GAPB(o[1]=__builtin_amdgcn_mfma_f32_32x32x16_bf16(PAF(1),VFR(5),o[1],0,0,0), C0,12); \
    KRD(GL,2); GAPB(o[0]=__builtin_amdgcn_mfma_f32_32x32x16_bf16(PAF(2),VFR(2),o[0],0,0,0), C1,0); \
    KRD(GL,3); GAPB(o[1]=__builtin_amdgcn_mfma_f32_32x32x16_bf16(PAF(2),VFR(6),o[1],0,0,0), C1,4); \
    GAPB(o[0]=__builtin_amdgcn_mfma_f32_32x32x16_bf16(PAF(3),VFR(3),o[0],0,0,0), C1,8); \
    GAPB(o[1]=__builtin_amdgcn_mfma_f32_32x32x16_bf16(PAF(3),VFR(7),o[1],0,0,0), C1,12); \
    if(GC){ ldck(P0,P1,ckp0+((t)+1)*256); } \
    }while(0)
  int t=1;
  #undef CMASK
  #define CMASK(P0,P1,t) do{}while(0)
  for(;t+5<NT;t+=2){
    STEP(pB0,pB1,pA0,pA1,t,true,true,true,true);     WAIT_BAR(2); ROT();
    STEP(pA0,pA1,pB0,pB1,t+1,true,true,true,true);   WAIT_BAR(2); ROT();
  }
  #undef CMASK
  #define CMASK(P0,P1,t) do{int jb_=(t)-(NT-4); if(jb_>=0)cmask(P0,P1,jb_,qrel,hi);}while(0)
  #define ENDW(tt) do{ if((tt)+3<NT){WAIT_BAR(2);} else if((tt)+2<NT){WAIT_BAR(1);} else {WAIT_BAR(0);} }while(0)
  for(;t+1<NT;t+=2){
    STEP(pB0,pB1,pA0,pA1,t,(t+3<NT),(t+1<NT),(t+1<NT),(t+1<NT));       ENDW(t);   ROT();
    STEP(pA0,pA1,pB0,pB1,t+1,(t+4<NT),(t+2<NT),(t+2<NT),(t+2<NT));     ENDW(t+1); ROT();
  }
  STEP(pB0,pB1,pA0,pA1,NT-1,false,false,false,false);
  { float sacc=pB0[0]+pB0[1]; _Pragma("unroll") for(int r=2;r<16;++r)sacc+=pB0[r]; _Pragma("unroll") for(int r=0;r<16;++r)sacc+=pB1[r]; l_reg+=sacc;
    pw0=(u32x4){PKW(pB0,0),PKW(pB0,2),PKW(pB0,4),PKW(pB0,6)};pw1=(u32x4){PKW(pB0,8),PKW(pB0,10),PKW(pB0,12),PKW(pB0,14)};pw2=(u32x4){PKW(pB1,0),PKW(pB1,2),PKW(pB1,4),PKW(pB1,6)};pw3=(u32x4){PKW(pB1,8),PKW(pB1,10),PKW(pB1,12),PKW(pB1,14)};
    SBAR(); pv(o,vb0+sl_cur,PAF(0),PAF(1),PAF(2),PAF(3)); }
  #undef PKW
  #undef PAF
  #undef VFR
  #undef PIN
  #undef MX3
  #undef GAPA
  #undef GAPB
  #undef EX
  #undef VRD
  #undef KRD
  #undef STEP
  #undef ENDW
  {auto rr=__builtin_amdgcn_permlane32_swap(__float_as_uint(l_reg),__float_as_uint(l_reg),false,false);l_reg=__uint_as_float(rr[0])+__uint_as_float(rr[1]);}
  if(hi==0)wsf[32+r32]=l_reg;asm volatile("s_waitcnt lgkmcnt(0)":::"memory");
  float rli[16];
  #pragma unroll
  for(int r=0;r<16;++r)rli[r]=__builtin_amdgcn_rcpf(wsf[32+crow(r,hi)]);
  bf16*Ow=O+(rowbase+q0+wid*QBLK)*DMO+h*D;
  { bf16*stg=(bf16*)(shm+LDS_OST)+wid*2048;
    #pragma unroll
    for(int r=0;r<16;++r){const int orow=crow(r,hi);
      #pragma unroll
      for(int d0=0;d0<2;++d0)stg[orow*64+d0*32+r32]=__float2bfloat16(o[d0][r]*rli[r]);}
    asm volatile("s_waitcnt lgkmcnt(0)":::"memory");
    #pragma unroll
    for(int i=0;i<4;++i){const int row=i*8+(lane>>3),ch=lane&7; const u32x4 v=*(const u32x4*)(stg+row*64+ch*8); ATTN_STORE16(Ow+(long)row*DMO+ch*8,v);} }
  asm volatile("s_waitcnt lgkmcnt(0)\n\ts_barrier":::"memory");
  #undef DMA_K
  #undef DMA_V
  #undef CMASK
  #undef CINIT
  #undef ROT
}
constexpr int ATTN_LDS_BYTES=LDS_BYTES;
struct AttnTensors { const bf16* Q; const bf16* K; const bf16* V; bf16* O; const float* C2G; };
struct AttnUnit { int bh; int qb; };
struct StaticOrder {
  int vcu;
  __device__ __forceinline__ explicit StaticOrder(int grid,int block):vcu((block%8)*(grid/8)+block/8){}
  __device__ __forceinline__ bool next(int i,AttnUnit&u)const{ if(i>=4)return false; const int s=vcu&7; u.bh=vcu>>3; u.qb=(i==0)?s:(i==1)?15-s:(i==2)?16+s:31-s; return true; }
  __device__ __forceinline__ void a_ready(const AttnUnit&)const{}
  __device__ __forceinline__ void done(const AttnUnit&)const{}
};
template<class Sched,int THRL=8> __device__ __forceinline__ void attn_phase(char*lds,const AttnTensors&T,const Sched&S,int tid_in){
  AttnUnit u;
  for(int i=0;S.next(i,u);++i){ S.a_ready(u); attn_unit<THRL>(u.bh/NHEAD,u.bh%NHEAD,u.qb,T.Q,T.K,T.V,T.O,T.C2G,lds,tid_in); S.done(u); }
}
#undef SBAR
#undef WAIT_BAR
}
constexpr int NWAVES = 8;
constexpr int SEQ = 8192, NB = 2, M = NB * SEQ, DMODEL = 2048;
constexpr int PJ = 6656;
constexpr int NIN = 6416;
constexpr int C_R = 0, C_K = 1024, C_V = 2048, C_WD = 3072, C_AD = 3136, C_GD = 3200;
constexpr int C_FQ = 3328, C_FK = 4352, C_FV = 5376, C_FF = 6400;
constexpr int NEXP = 16384;
constexpr float C2Q = 0.125f * 1.4426950408889634f;
constexpr float LOG2E = 1.4426950408889634f;

constexpr size_t MiB = 1u << 20;
constexpr size_t WS_CTL = 0, CTL_ZERO_BYTES = 1 * MiB;
constexpr size_t WS_SSQ = 42 * MiB;
constexpr size_t WS_WQT = 1 * MiB;
constexpr size_t WS_LWT = 5 * MiB;
constexpr size_t WS_C2 = 6 * MiB;
constexpr size_t WS_BON = 7 * MiB;
constexpr size_t WS_WOT = 8 * MiB;
constexpr size_t WS_WINT = 16 * MiB;
constexpr size_t WS_LA = 42 * MiB;
constexpr size_t WS_XN = 64 * MiB;
constexpr size_t WS_PROJ = 128 * MiB;
constexpr size_t WS_MIXED = 336 * MiB;
constexpr size_t WS_KP = 400 * MiB, WS_AV = 432 * MiB, WS_BV = 464 * MiB;
constexpr size_t WS_END = 497 * MiB;
constexpr size_t WS_GATE = 128 * MiB;
constexpr size_t WS_IDX = 136 * MiB;
constexpr size_t WS_QP = 140 * MiB;
constexpr size_t WS_U8 = 464 * MiB, WS_V8 = 480 * MiB;
constexpr size_t WS_USC = 496 * MiB, WS_VSC = 496 * MiB + 65536;
constexpr size_t OUT_DEC = 0, OUT_G = 64 * MiB, OUT_AIC = 96 * MiB;
constexpr int CW_TMO = 0, CW_BAR = 4096, CW_QUEUE = 16384, CW_QU = 32768, CW_QV = 36864;
constexpr size_t WS_W = 238 * MiB;

constexpr int RING_OFF = 0, RING_BYTES = 131072;
constexpr int LDSCTL_OFF = RING_BYTES, MISC_OFF = LDSCTL_OFF + 320;
constexpr int LDS_BYTES = 147456;

#define GAS __attribute__((address_space(1)))
#define LAS __attribute__((address_space(3)))
typedef unsigned short bf16;
typedef unsigned v4u __attribute__((ext_vector_type(4)));
typedef float f32x4 __attribute__((ext_vector_type(4)));
typedef short bf16x8 __attribute__((ext_vector_type(8)));
typedef GAS unsigned gu32;
typedef GAS unsigned long long gu64;
#define RLX_AGENT __ATOMIC_RELAXED, __HIP_MEMORY_SCOPE_AGENT
#define LDS_WAIT() asm volatile("s_waitcnt lgkmcnt(0)" ::: "memory")
#define VM_WAIT() asm volatile("s_waitcnt vmcnt(0)" ::: "memory")
__device__ __forceinline__ unsigned long long rt() { return __builtin_amdgcn_s_memrealtime(); }
__device__ __forceinline__ unsigned f2bf(float f) { unsigned u = __builtin_bit_cast(unsigned, f); return (u + 0x7fffu + ((u >> 16) & 1u)) >> 16; }
__device__ __forceinline__ unsigned pk2(float lo, float hi) { return f2bf(lo) | (f2bf(hi) << 16); }

#define XB_TMO      128
#define XB_XCNT(j)  (256  + 64 * (j))
#define XB_XSUB(j)  (1280 + 64 * (j))
#define XB_XGEN(j)  (2304 + 64 * (j))
#define XB_TOP      3328
#define XB_TOPGEN   3392
#define XCD_BAR_WORDS 3456
#define XB_SPIN_CAP (1u << 18)

__device__ __forceinline__ unsigned xb_ld(unsigned* p)              { return __hip_atomic_load(p, __ATOMIC_RELAXED, __HIP_MEMORY_SCOPE_AGENT); }
__device__ __forceinline__ unsigned xb_add(unsigned* p, unsigned v) { return __hip_atomic_fetch_add(p, v, __ATOMIC_RELAXED, __HIP_MEMORY_SCOPE_AGENT); }
__device__ __forceinline__ unsigned xb_xcc_id() { return (unsigned)__builtin_amdgcn_s_getreg((3 << 11) | 20) & 0xFu; }
#define XB_SPIN(cond, bar) do { unsigned _sp = 0; while (cond) { __builtin_amdgcn_s_sleep(1); \
    if ((++_sp & 255u) == 0u) { if (xb_ld(&(bar)[XB_TMO])) break; if (_sp > XB_SPIN_CAP) { atomicAdd(&(bar)[XB_TMO], 1u); break; } } } } while (0)

struct XcdBarrier {
    unsigned* bar; unsigned x;
    volatile LAS unsigned* st;
};

__device__ __forceinline__ XcdBarrier xcd_barrier_post(unsigned* bar, volatile LAS unsigned* st, int tid) {
    XcdBarrier b; b.bar = bar; b.x = xb_xcc_id(); b.st = st;
    if (tid == 0) (void)xb_add(&bar[XB_XCNT(b.x)], 1u);
    return b;
}
__device__ __forceinline__ void xcd_barrier_complete(unsigned* bar, unsigned x, unsigned& nloc, unsigned& nx) {
    const unsigned G = gridDim.x * gridDim.y * gridDim.z;
    unsigned sum, cnt, mine, sp = 0u;
    for (;;) {
        sum = 0u; cnt = 0u; mine = 0u;
#pragma unroll
        for (unsigned j = 0; j < 16; ++j) { const unsigned c = xb_ld(&bar[XB_XCNT(j)]); sum += c; cnt += (c > 0u) ? 1u : 0u; mine = (j == x) ? c : mine; }
        if (sum == G) break;
        __builtin_amdgcn_s_sleep(1);
        if ((++sp & 255u) == 0u) { if (xb_ld(&bar[XB_TMO])) break; if (sp > XB_SPIN_CAP) { atomicAdd(&bar[XB_TMO], 1u); break; } }
    }
    nloc = mine > 0u ? mine : 1u; nx = cnt > 0u ? cnt : 1u;
}

__device__ __forceinline__ void xcd_barrier(const XcdBarrier& b, int tid) {
    asm volatile("s_waitcnt vmcnt(0)" ::: "memory");
    __syncthreads();
    if (tid == 0) {
        unsigned* bar = b.bar;
        __builtin_amdgcn_s_waitcnt(0);
        unsigned nloc = b.st[0], nx = b.st[1];
        if (nloc == 0u) { xcd_barrier_complete(bar, b.x, nloc, nx); b.st[0] = nloc; b.st[1] = nx; }
        const unsigned old = xb_add(&bar[XB_XSUB(b.x)], 1u);
        const unsigned gen = old / nloc;
        if (old + 1u == (gen + 1u) * nloc) {
            __builtin_amdgcn_fence(__ATOMIC_RELEASE, "agent");
            asm volatile("s_waitcnt vmcnt(0)" ::: "memory");
            const unsigned og = xb_add(&bar[XB_TOP], 1u);
            const unsigned tg = og / nx;
            if (og + 1u == (tg + 1u) * nx) xb_add(&bar[XB_TOPGEN], 1u);
            else XB_SPIN(xb_ld(&bar[XB_TOPGEN]) == tg, bar);
            __builtin_amdgcn_fence(__ATOMIC_ACQUIRE, "agent");
            xb_add(&bar[XB_XGEN(b.x)], 1u);
            asm volatile("s_waitcnt vmcnt(0)" ::: "memory");
        } else {
            XB_SPIN(xb_ld(&bar[XB_XGEN(b.x)]) == gen, bar);
            __builtin_amdgcn_fence(__ATOMIC_ACQUIRE, "agent");
            asm volatile("s_waitcnt vmcnt(0)" ::: "memory");
        }
    }
    __syncthreads();
}


struct Frame {
    LAS unsigned char* lds;
    volatile LAS unsigned* MISC;
    gu32* ctl;
    int tid, lane, wave, vcu, G;
};
__device__ __forceinline__ float wave_sum(float v) {
#pragma unroll
    for (int o = 1; o < 64; o <<= 1) v += __shfl_xor(v, o);
    return v;
}
__device__ __forceinline__ float wave_max(float v) {
#pragma unroll
    for (int o = 1; o < 64; o <<= 1) v = fmaxf(v, __shfl_xor(v, o));
    return v;
}
__device__ __forceinline__ float bflo(unsigned u) { return __uint_as_float(u << 16); }
__device__ __forceinline__ float bfhi(unsigned u) { return __uint_as_float(u & 0xffff0000u); }
__device__ __forceinline__ float bf1(const bf16* p) { return __uint_as_float((unsigned)(*p) << 16); }
__device__ __forceinline__ void ld16bf(const bf16* p, float (&x)[16]) {
    const v4u a = *(const v4u*)p, b = *(const v4u*)(p + 8);
    x[0] = bflo(a.x); x[1] = bfhi(a.x); x[2] = bflo(a.y); x[3] = bfhi(a.y); x[4] = bflo(a.z); x[5] = bfhi(a.z); x[6] = bflo(a.w); x[7] = bfhi(a.w);
    x[8] = bflo(b.x); x[9] = bfhi(b.x); x[10] = bflo(b.y); x[11] = bfhi(b.y); x[12] = bflo(b.z); x[13] = bfhi(b.z); x[14] = bflo(b.w); x[15] = bfhi(b.w);
}
__device__ __forceinline__ void st16bf(bf16* p, const float (&x)[16]) {
    v4u a, b;
    a.x = pk2(x[0], x[1]); a.y = pk2(x[2], x[3]); a.z = pk2(x[4], x[5]); a.w = pk2(x[6], x[7]);
    b.x = pk2(x[8], x[9]); b.y = pk2(x[10], x[11]); b.z = pk2(x[12], x[13]); b.w = pk2(x[14], x[15]);
    *(v4u*)p = a; *(v4u*)(p + 8) = b;
}
__device__ __forceinline__ void ld16f(const float* p, float (&x)[16]) {
#pragma unroll
    for (int j = 0; j < 4; ++j) { const f32x4 v = *(const f32x4*)(p + 4 * j); x[4 * j] = v.x; x[4 * j + 1] = v.y; x[4 * j + 2] = v.z; x[4 * j + 3] = v.w; }
}
__device__ __forceinline__ void shift16(const bf16* row, bool has_prev, int col, const float* mu, float (&x)[16]) {
    float p[16], q[16], m[16];
    ld16bf(row + col, p); ld16f(mu + col, m);
    if (has_prev) ld16bf(row - PJ + col, q); else {
#pragma unroll
        for (int i = 0; i < 16; ++i) q[i] = 0.f; }
#pragma unroll
    for (int i = 0; i < 16; ++i) x[i] = p[i] + m[i] * (q[i] - p[i]);
}

__device__ __forceinline__ void p0_transpose_item(const float* W, int Ks, int Ns, bf16* WT, int Kd, LAS float* scr, int kb, int nb, int lane) {
    const int k0 = 64 * kb, n0 = 32 * nb;
    float wv_[32];
#pragma unroll
    for (int i = 0; i < 32; ++i) { const int kk = 2 * i + (lane >> 5), k = k0 + kk, n = n0 + (lane & 31); wv_[i] = (k < Ks && n < Ns) ? W[(size_t)k * Ns + n] : 0.f; }
#pragma unroll
    for (int i = 0; i < 32; ++i) { const int kk = 2 * i + (lane >> 5); scr[kk * 33 + (lane & 31)] = wv_[i]; }
    LDS_WAIT(); asm volatile("" ::: "memory");
    const int c = lane & 7;
#pragma unroll
    for (int j = 0; j < 4; ++j) { const int n = (lane >> 3) + 8 * j; const LAS float* s = scr + (8 * c) * 33 + n;
        v4u o; o.x = pk2(s[0 * 33], s[1 * 33]); o.y = pk2(s[2 * 33], s[3 * 33]); o.z = pk2(s[4 * 33], s[5 * 33]); o.w = pk2(s[6 * 33], s[7 * 33]);
        *(GAS v4u*)(WT + (size_t)(n0 + n) * Kd + k0 + 8 * c) = o; }
    LDS_WAIT(); asm volatile("" ::: "memory");
}
__device__ __forceinline__ void p0_transpose_block(const float* W, int Ks, int Ns, bf16* WT, int Kd, LAS float* scr, int kb, int nb, int tid) {
    const int k0 = 64 * kb, n0 = 256 * nb, r8 = tid >> 6, c = tid & 63, lane = tid & 63, w = tid >> 6;
    f32x4 v[8];
#pragma unroll
    for (int i = 0; i < 8; ++i) { const int k = k0 + r8 + 8 * i, n = n0 + 4 * c; v[i] = (k < Ks && n < Ns) ? *(const f32x4*)(W + (size_t)k * Ns + n) : (f32x4){0.f, 0.f, 0.f, 0.f}; }
#pragma unroll
    for (int i = 0; i < 8; ++i) { LAS float* d = scr + (r8 + 8 * i) * 257 + 4 * c; d[0] = v[i].x; d[1] = v[i].y; d[2] = v[i].z; d[3] = v[i].w; }
    __syncthreads();
    const int nl = lane >> 3, c8 = lane & 7;
#pragma unroll
    for (int jj = 0; jj < 4; ++jj) { const int n = 8 * (w * 4 + jj) + nl; const LAS float* s = scr + (8 * c8) * 257 + n;
        v4u o; o.x = pk2(s[0 * 257], s[1 * 257]); o.y = pk2(s[2 * 257], s[3 * 257]); o.z = pk2(s[4 * 257], s[5 * 257]); o.w = pk2(s[6 * 257], s[7 * 257]);
        *(GAS v4u*)(WT + (size_t)(n0 + n) * Kd + k0 + 8 * c8) = o; }
    __syncthreads();
}
__device__ __forceinline__ void rms_row_to_bf16(const float* xrow, const float* g, bf16* orow, int lane) {
    const GAS f32x4* xr = (const GAS f32x4*)xrow + lane; const GAS f32x4* gr = (const GAS f32x4*)g + lane;
    f32x4 v[8]; float s = 0.f;
#pragma unroll
    for (int j = 0; j < 8; ++j) { v[j] = xr[64 * j]; s += (v[j].x * v[j].x + v[j].y * v[j].y) + (v[j].z * v[j].z + v[j].w * v[j].w); }
    const float rs = 1.0f / sqrtf(wave_sum(s) * (1.f / DMODEL) + 1e-6f);
    GAS unsigned long long* o8 = (GAS unsigned long long*)orow + lane;
#pragma unroll
    for (int j = 0; j < 8; ++j) { const f32x4 gg = gr[64 * j];
        o8[64 * j] = (unsigned long long)pk2(v[j].x * rs * gg.x, v[j].y * rs * gg.y) | ((unsigned long long)pk2(v[j].z * rs * gg.z, v[j].w * rs * gg.w) << 32); }
}
struct Ptrs {
    const float *x, *norm1_g, *w_in, *mu, *w_decay_up, *w0, *w_iclr_up, *a0, *w_gate_up, *k_k, *k_a, *r_k, *lnx_g, *lnx_b, *fox_b_f, *q_norm_g, *k_norm_g, *w_out, *norm2_g, *w_q, *sub_keys, *peer_u, *peer_v;
    float* out;
    bf16 *WQT, *LWT, *WOT, *WINT, *LA, *XN, *PROJ, *MIXED, *KP, *AV, *BV, *QP, *G, *AIC;
    float *C2, *BON, *Y, *DEC, *GATE, *USC, *VSC, *SSQ;
    unsigned short* IDX; unsigned char *U8, *V8;
};
__device__ __forceinline__ void prepA_token(const Ptrs& P, int m, int lane) {
    bf16* row = P.PROJ + (size_t)m * PJ;
    const bool has_prev = (m % SEQ) != 0;
#pragma unroll
    for (int which = 0; which < 2; ++which) {
        bf16* p = row + (which == 0 ? C_FQ : C_FK) + lane * 16;
        float x[16], g[16]; ld16bf(p, x); ld16f((which == 0 ? P.q_norm_g : P.k_norm_g) + (lane & 3) * 16, g);
        float ss = 0.f;
#pragma unroll
        for (int i = 0; i < 16; ++i) ss += x[i] * x[i];
        ss += __shfl_xor(ss, 1); ss += __shfl_xor(ss, 2);
        const float rs = (1.0f / sqrtf(ss * (1.f / 64.f) + 1e-6f)) * (which == 0 ? C2Q : 1.f);
#pragma unroll
        for (int i = 0; i < 16; ++i) x[i] = x[i] * rs * g[i];
        st16bf(p, x);
    }
    {
        const bf16* prow = row - PJ;
        auto sh = [&](int col) -> float { const float p = bf1(row + col); const float q = has_prev ? bf1(prow + col) : 0.f; return p + P.mu[col] * (q - p); };
        bf16* la0 = P.LA + (size_t)m * 128; bf16* la1 = P.LA + (size_t)M * 128 + (size_t)m * 128; bf16* la2 = P.LA + (size_t)2 * M * 128 + (size_t)m * 128;
        const float wd = sh(C_WD + lane), ad = sh(C_AD + lane), g0 = sh(C_GD + lane), g1 = sh(C_GD + 64 + lane);
        la0[lane] = (bf16)f2bf(tanhf(wd)); la0[64 + lane] = 0;
        la1[lane] = (bf16)f2bf(ad); la1[64 + lane] = 0;
        la2[lane] = (bf16)f2bf(1.0f / (1.0f + __expf(-g0))); la2[64 + lane] = (bf16)f2bf(1.0f / (1.0f + __expf(-g1)));
    }
}
__device__ __forceinline__ void fox_cumsum(const Ptrs& P, int bh, LAS float* scr, int tid) {
    const int b = bh >> 4, h = bh & 15; const float bf_ = P.fox_b_f[h];
    const bf16* src = P.PROJ + (size_t)(b * SEQ + tid * 16) * PJ + C_FF + h;
    float v[16]; float run = 0.f;
#pragma unroll
    for (int i = 0; i < 16; ++i) { const float x = bf1(src + (size_t)i * PJ) + bf_;
        const float ls = (x >= 0.f) ? -log1pf(__expf(-x)) : (x - log1pf(__expf(x))); run += ls; v[i] = run; }
    float inc = run; const int lane = tid & 63, w = tid >> 6;
#pragma unroll
    for (int o = 1; o < 64; o <<= 1) { const float t = __shfl_up(inc, o); if (lane >= o) inc += t; }
    if (lane == 63) scr[w] = inc;
    __syncthreads();
    float off = inc - run;
    for (int j = 0; j < w; ++j) off += scr[j];
    float* dst = P.C2 + (size_t)bh * SEQ + tid * 16;
#pragma unroll
    for (int i = 0; i < 16; i += 4) *(f32x4*)(dst + i) = (f32x4){(off + v[i]) * LOG2E, (off + v[i + 1]) * LOG2E, (off + v[i + 2]) * LOG2E, (off + v[i + 3]) * LOG2E};
    __syncthreads();
}

#define DPP_ADD(x, ctrl) ((x) + __uint_as_float((unsigned)__builtin_amdgcn_update_dpp(0, (int)__float_as_uint(x), (ctrl), 0xf, 0xf, true)))
__device__ __forceinline__ float row16_sum(float x) {
    x = DPP_ADD(x, 0xB1);
    x = DPP_ADD(x, 0x4E);
    x = DPP_ADD(x, 0x141);
    x = DPP_ADD(x, 0x140);
    return x;
}
__device__ __forceinline__ void post_token(const Ptrs& P, int m, int lane) {
    const bf16* row = P.PROJ + (size_t)m * PJ;
    const bool has_prev = (m % SEQ) != 0;
    const int c = lane * 16, h = lane >> 2;
    float y[16], vs[16], g[16], lg[16], lb[16];
    ld16f(P.Y + (size_t)m * 1024 + c, y);
    float s = 0.f;
#pragma unroll
    for (int i = 0; i < 16; ++i) s += y[i];
    s += __shfl_xor(s, 1); s += __shfl_xor(s, 2);
    const float mean = s * (1.f / 64.f);
    float q = 0.f;
#pragma unroll
    for (int i = 0; i < 16; ++i) { y[i] -= mean; q += y[i] * y[i]; }
    q += __shfl_xor(q, 1); q += __shfl_xor(q, 2);
    const float rstd = 1.0f / sqrtf(q * (1.f / 64.f) + 64e-5f);
    shift16(row, has_prev, C_V + c, P.mu, vs);
    ld16bf(P.G + (size_t)m * 1024 + c, g); ld16f(P.lnx_g + c, lg); ld16f(P.lnx_b + c, lb);
    const float bon = P.BON[(size_t)m * 16 + h];
#pragma unroll
    for (int i = 0; i < 16; ++i) y[i] = (y[i] * rstd * lg[i] + lb[i] + bon * vs[i]) * g[i];
    st16bf(P.MIXED + (size_t)m * 2048 + c, y);
}
typedef float v16f __attribute__((ext_vector_type(16)));
typedef float v32f __attribute__((ext_vector_type(32)));
typedef unsigned v6u __attribute__((ext_vector_type(6)));
constexpr int ROW6 = 1024;
__device__ __forceinline__ void fp6_row(const float* src, unsigned char* dst, float* mult, int lane) {
    const GAS f32x4* xr = (const GAS f32x4*)src + lane;
    f32x4 v[8]; float am = 0.f;
#pragma unroll
    for (int j = 0; j < 8; ++j) { v[j] = xr[64 * j]; am = fmaxf(am, fmaxf(fmaxf(fabsf(v[j].x), fabsf(v[j].y)), fmaxf(fabsf(v[j].z), fabsf(v[j].w)))); }
    am = wave_max(am);
    const float sc = am > 0.f ? 6.0f / am : 1.0f;
    unsigned w[4];
#pragma unroll
    for (int d = 0; d < 4; ++d) { unsigned x = 0u;
        x = __builtin_amdgcn_cvt_scalef32_pk_fp4_f32(x, v[2 * d].x * sc, v[2 * d].y * sc, 1.0f, 0); x = __builtin_amdgcn_cvt_scalef32_pk_fp4_f32(x, v[2 * d].z * sc, v[2 * d].w * sc, 1.0f, 1);
        x = __builtin_amdgcn_cvt_scalef32_pk_fp4_f32(x, v[2 * d + 1].x * sc, v[2 * d + 1].y * sc, 1.0f, 2); x = __builtin_amdgcn_cvt_scalef32_pk_fp4_f32(x, v[2 * d + 1].z * sc, v[2 * d + 1].w * sc, 1.0f, 3);
        w[d] = x; }
    *(GAS v4u*)(dst + lane * 16) = (v4u){w[0], w[1], w[2], w[3]};
    if (lane == 0) *mult = am > 0.f ? am * (1.0f / 6.0f) : 1.0f;
}
namespace rk {
typedef float f32x16 __attribute__((ext_vector_type(16)));
constexpr int CS = 144;
constexpr int FS = 272;
constexpr int L_AT = 0, L_RT = 9216, L_BT = 18432, L_KT = 27648, L_PF = 18432, L_VT = 36864, L_BH = 46080, L_M1 = 55296, L_KH = 64512, L_Q1 = 55296,
              L_M3 = 73728, L_M4 = 82944, L_M2 = 92160, L_GL = 109568, L_WT = 109824, L_QF = 111872, L_M2B = 111872, L_PI = 121088, L_RTW = 36864, L_END = 129280;
__device__ __forceinline__ int crow(int r, int hi) { return (r & 3) + 8 * (r >> 2) + 4 * hi; }
typedef float f32x2c __attribute__((ext_vector_type(2))); typedef __bf16 bf16x2c __attribute__((ext_vector_type(2)));
__device__ __forceinline__ unsigned cvtpk_v(float lo, float hi) { const f32x2c v = {lo, hi}; const bf16x2c b = __builtin_convertvector(v, bf16x2c); return __builtin_bit_cast(unsigned, b); }
__device__ __forceinline__ int permcol(int j) { const int x = j & 15; return (j & ~15) + ((x >> 2) & 1) * 8 + (x >> 3) * 4 + (x & 3); }
__device__ __forceinline__ void mm32(f32x16& acc, const LAS unsigned char* A, const LAS unsigned char* Bt, int lane) {
    const int r = lane & 31, h = lane >> 5;
    const LAS unsigned char* pa = A + r * CS + h * 16; const LAS unsigned char* pb = Bt + r * CS + h * 16;
#pragma unroll
    for (int ks = 0; ks < 4; ++ks) { const bf16x8 a = *(const LAS bf16x8*)(pa + ks * 32), b = *(const LAS bf16x8*)(pb + ks * 32); acc = __builtin_amdgcn_mfma_f32_32x32x16_bf16(a, b, acc, 0, 0, 0); }
}
__device__ __forceinline__ void st_bf16(LAS unsigned char* p, float v) { *(LAS unsigned short*)p = (unsigned short)cvtpk_v(v, v); }

struct S1Regs { v4u rk, rkp, raic, rr, rrp, rv, rvp; f32x4 rw0, rw1; };
__device__ __forceinline__ void s1_load(const Ptrs& P, int unit, int tid, S1Regs& R) {
    const int c = unit >> 5, bh = unit & 31, b = bh >> 4, h = bh & 15, tt = tid >> 3, sg = tid & 7;
    const int t_ = c * 64 + tt; const size_t m_ = (size_t)b * SEQ + t_; const int cb = h * 64 + sg * 8;
    R.rk = *(const v4u*)(P.PROJ + m_ * PJ + C_K + cb); R.raic = *(const v4u*)(P.AIC + m_ * 1024 + cb);
    R.rw0 = *(const f32x4*)(P.DEC + m_ * 1024 + cb); R.rw1 = *(const f32x4*)(P.DEC + m_ * 1024 + cb + 4);
    R.rr = *(const v4u*)(P.PROJ + m_ * PJ + C_R + cb); R.rv = *(const v4u*)(P.PROJ + m_ * PJ + C_V + cb);
    if (t_ > 0) { R.rrp = *(const v4u*)(P.PROJ + (m_ - 1) * PJ + C_R + cb); R.rvp = *(const v4u*)(P.PROJ + (m_ - 1) * PJ + C_V + cb); R.rkp = *(const v4u*)(P.PROJ + (m_ - 1) * PJ + C_K + cb); }
    else { R.rrp = (v4u){0u, 0u, 0u, 0u}; R.rvp = (v4u){0u, 0u, 0u, 0u}; R.rkp = (v4u){0u, 0u, 0u, 0u}; }
}
__device__ __forceinline__ void unpk8(const v4u u, float (&x)[8]) { x[0] = bflo(u.x); x[1] = bfhi(u.x); x[2] = bflo(u.y); x[3] = bfhi(u.y); x[4] = bflo(u.z); x[5] = bfhi(u.z); x[6] = bflo(u.w); x[7] = bfhi(u.w); }
__device__ __forceinline__ v4u pk8(const float (&x)[8]) { v4u o; o.x = pk2(x[0], x[1]); o.y = pk2(x[2], x[3]); o.z = pk2(x[4], x[5]); o.w = pk2(x[6], x[7]); return o; }

#ifdef PROBE_MASK
#define S1T(k) do { if (blockIdx.x == 0 && wv == 0) { unsigned long long t_; __builtin_amdgcn_sched_barrier(0); asm volatile("s_memrealtime %0\n\ts_waitcnt lgkmcnt(0)" : "=s"(t_) :: "memory"); __builtin_amdgcn_sched_barrier(0); \
    volatile LAS unsigned* w_ = (volatile LAS unsigned*)(lds + MISC_OFF) + 80; if ((tid & 63) == 0) { w_[(k)] += (unsigned)t_ - w_[7]; w_[7] = (unsigned)t_; } } } while (0)
#else
#define S1T(k) do {} while (0)
#endif
__device__ __forceinline__ void s1_unit(const Ptrs& P, int unit, int next_unit, S1Regs& R, LAS unsigned char* lds, int tid_in, int wv) {
    int tid = tid_in; asm volatile("" : "+v"(tid));
    const int c = unit >> 5, bh = unit & 31, b = bh >> 4, h = bh & 15, tt = tid >> 3, sg = tid & 7, lane = tid & 63;
    const size_t m0 = (size_t)b * SEQ + c * 64;
    {
        float a8[8], b8[8], k8[8], r8[8], v8[8], p8[8], lw[8], cum[8];
        const int cb = h * 64 + sg * 8;
        float mu8[8], c8[8];
#define S1_LD8(dst, ptr) do { const f32x4 u0_ = *(const f32x4*)(ptr), u1_ = *(const f32x4*)((ptr) + 4); dst[0] = u0_.x; dst[1] = u0_.y; dst[2] = u0_.z; dst[3] = u0_.w; dst[4] = u1_.x; dst[5] = u1_.y; dst[6] = u1_.z; dst[7] = u1_.w; } while (0)
        unpk8(R.rk, k8); unpk8(R.rkp, p8); S1_LD8(mu8, P.mu + C_K + cb);
#pragma unroll
        for (int e = 0; e < 8; ++e) k8[e] = k8[e] + mu8[e] * (p8[e] - k8[e]);
        S1_LD8(c8, P.k_k + cb);
        float n2 = 0.f;
#pragma unroll
        for (int e = 0; e < 8; ++e) { a8[e] = k8[e] * c8[e]; n2 += a8[e] * a8[e]; }
        n2 = DPP_ADD(n2, 0xB1); n2 = DPP_ADD(n2, 0x4E); n2 = DPP_ADD(n2, 0x141);
        const float inv = 1.0f / fmaxf(sqrtf(n2), 1e-12f);
        unpk8(R.raic, b8); S1_LD8(c8, P.k_a + cb);
#pragma unroll
        for (int e = 0; e < 8; ++e) { const float ic = 1.0f / (1.0f + __expf(-b8[e])); const float kk = a8[e] * inv; k8[e] = k8[e] * (1.0f + (ic - 1.0f) * c8[e]); a8[e] = -kk; b8[e] = kk * ic; }
        unpk8(R.rr, r8); unpk8(R.rrp, p8); S1_LD8(mu8, P.mu + C_R + cb);
#pragma unroll
        for (int e = 0; e < 8; ++e) r8[e] = r8[e] + mu8[e] * (p8[e] - r8[e]);
        S1_LD8(c8, P.r_k + cb);
        float bon = 0.f;
#pragma unroll
        for (int e = 0; e < 8; ++e) bon += r8[e] * k8[e] * c8[e];
        bon = DPP_ADD(bon, 0xB1); bon = DPP_ADD(bon, 0x4E); bon = DPP_ADD(bon, 0x141);
        if (sg == 0) P.BON[(m0 + tt) * 16 + h] = bon;
        unpk8(R.rv, v8); unpk8(R.rvp, p8); S1_LD8(mu8, P.mu + C_V + cb);
#pragma unroll
        for (int e = 0; e < 8; ++e) v8[e] = v8[e] + mu8[e] * (p8[e] - v8[e]);
        const float z8[8] = {R.rw0.x, R.rw0.y, R.rw0.z, R.rw0.w, R.rw1.x, R.rw1.y, R.rw1.z, R.rw1.w};
#pragma unroll
        for (int e = 0; e < 8; ++e) { lw[e] = -__expf(-__logf(1.0f + __expf(-z8[e])) - 0.5f); cum[e] = lw[e]; }
#undef S1_LD8
#pragma unroll
        for (int o = 8; o < 64; o <<= 1)
#pragma unroll
            for (int e = 0; e < 8; ++e) { const float t = __shfl_up(cum[e], o); if (lane >= o) cum[e] += t; }
        LAS float* WT = (LAS float*)(lds + L_WT);
        if (lane >= 56) {
#pragma unroll
            for (int e = 0; e < 8; ++e) WT[wv * 64 + sg * 8 + e] = cum[e]; }
        __syncthreads(); S1T(0);
        float cL[8];
#pragma unroll
        for (int e = 0; e < 8; ++e) { float off = 0.f, tot = 0.f;
#pragma unroll
            for (int w2 = 0; w2 < 8; ++w2) { const float x = WT[w2 * 64 + sg * 8 + e]; tot += x; off += (w2 < wv) ? x : 0.f; }
            cum[e] += off; cL[e] = tot; }
        float o8[8];
#pragma unroll
        for (int e = 0; e < 8; ++e) o8[e] = a8[e] * __expf(cum[e] - lw[e]);
        *(LAS v4u*)(lds + L_AT + tt * CS + sg * 16) = pk8(o8);
#pragma unroll
        for (int e = 0; e < 8; ++e) o8[e] = r8[e] * __expf(cum[e]);
        *(LAS v4u*)(lds + L_RT + tt * CS + sg * 16) = pk8(o8);
        float gi[8];
#pragma unroll
        for (int e = 0; e < 8; ++e) { gi[e] = __expf(-cum[e]); o8[e] = b8[e] * gi[e]; }
        *(LAS v4u*)(lds + L_BT + tt * CS + sg * 16) = pk8(o8);
#pragma unroll
        for (int e = 0; e < 8; ++e) o8[e] = k8[e] * gi[e];
        *(LAS v4u*)(lds + L_KT + tt * CS + sg * 16) = pk8(o8);
#pragma unroll
        for (int e = 0; e < 8; ++e) { const float gl = __expf(cL[e] - cum[e]);
            st_bf16(lds + L_VT + (sg * 8 + e) * CS + tt * 2, v8[e]); st_bf16(lds + L_BH + (sg * 8 + e) * CS + tt * 2, b8[e] * gl); st_bf16(lds + L_KH + (sg * 8 + e) * CS + tt * 2, k8[e] * gl); }
        if (tt == 0) {
#pragma unroll
            for (int e = 0; e < 8; ++e) ((LAS float*)(lds + L_GL))[sg * 8 + e] = __expf(cL[e]); }
    }
    __syncthreads(); S1T(1);
    if (next_unit < 4096) s1_load(P, next_unit, tid, R);
    int lane2 = lane; asm volatile("" : "+v"(lane2));
    const int hl = lane2 >> 5, cl = lane2 & 31;
    {
        const int p = wv >> 1, mb = wv & 1;
        const LAS unsigned char* A = lds + ((p < 2) ? L_AT : L_RT) + mb * 32 * CS;
        const LAS unsigned char* B = lds + ((p == 0 || p == 3) ? L_KT : L_BT);
#pragma unroll
        for (int nb = 0; nb < 2; ++nb) {
            f32x16 acc = {}; mm32(acc, A, B + nb * 32 * CS, lane);
            const int col = nb * 32 + cl;
#pragma unroll
            for (int rg = 0; rg < 16; ++rg) { const int row = mb * 32 + crow(rg, hl);
                const bool keep = (p < 2) ? (col < row) : (col <= row); const float v = keep ? acc[rg] : 0.f;
                if (p == 1) { *(LAS float*)(lds + L_M2 + row * FS + col * 4) = v; st_bf16(lds + L_M2B + row * CS + col * 2, v); }
                else st_bf16(lds + ((p == 0) ? L_M1 : (p == 2) ? L_M3 : L_M4) + row * CS + col * 2, v); }
        }
    }
    __syncthreads(); S1T(2);
    f32x16 accQ = {}, accY = {};
    const int tb = (wv >> 1) & 1, ib = wv & 1;
    if (wv < 4) {
        f32x16 acc = {}; mm32(acc, lds + L_M1 + tb * 32 * CS, lds + L_VT + ib * 32 * CS, lane);
#pragma unroll
        for (int rg = 0; rg < 16; ++rg) *(LAS float*)(lds + L_PF + (ib * 32 + cl) * FS + (tb * 32 + crow(rg, hl)) * 4) = acc[rg];
        if (lane2 < 32) {
            const int I = wv; const LAS unsigned char* mdia = lds + L_M2 + I * 16 * FS + I * 64; LAS unsigned char* pib = lds + L_PI + I * 1024 + lane2 * 2;
            asm volatile("" : "+v"(mdia), "+v"(pib));
            float pc[16];
#pragma unroll
            for (int r2 = 0; r2 < 16; ++r2) {
                float s_ = (r2 == lane2) ? 1.0f : 0.0f;
#pragma unroll
                for (int g = 0; g < (r2 + 3) / 4; ++g) { const f32x4 m = *(const LAS f32x4*)(mdia + r2 * FS + g * 16);
                    s_ += m.x * pc[4 * g];
                    if (4 * g + 1 < r2) s_ += m.y * pc[4 * g + 1];
                    if (4 * g + 2 < r2) s_ += m.z * pc[4 * g + 2];
                    if (4 * g + 3 < r2) s_ += m.w * pc[4 * g + 3]; }
                pc[r2] = s_;
                st_bf16(pib + r2 * 64, s_);
            }
        }
    } else { mm32(accQ, lds + L_KH + tb * 32 * CS, lds + L_VT + ib * 32 * CS, lane); mm32(accY, lds + L_M4 + tb * 32 * CS, lds + L_VT + ib * 32 * CS, lane); }
    __syncthreads(); S1T(3);
    {
        typedef float f32x4m __attribute__((ext_vector_type(4)));
        const int c16 = lane2 & 15, kq = lane2 >> 4, n0 = wv * 16, n = n0 + c16;
        LAS unsigned char* q1w = lds + L_Q1 + n0 * CS;
        LAS unsigned char* rtw = lds + L_RTW + wv * 1024;
        {
            const v4u z = (v4u){0u, 0u, 0u, 0u};
            for (int o = lane2 * 16; o < 16 * CS; o += 1024) *(LAS v4u*)(q1w + o) = z;
            *(LAS v4u*)(rtw + lane2 * 16) = z;
        }
        const LAS unsigned char* a_m2 = lds + L_M2B + c16 * CS + kq * 16;
        const LAS unsigned char* b_q1 = q1w + c16 * CS + kq * 16;
        const LAS unsigned char* a_pi = lds + L_PI + c16 * 64 + kq * 16;
        const LAS unsigned char* b_rt = rtw + c16 * 64 + kq * 16;
        asm volatile("s_waitcnt lgkmcnt(0)" ::: "memory");
#pragma unroll
        for (int I = 0; I < 4; ++I) {
            f32x4m cacc;
            if (wv < 4) {
#pragma unroll
                for (int e = 0; e < 4; ++e) cacc[e] = __uint_as_float((unsigned)(*(const LAS unsigned short*)(lds + L_AT + (16 * I + 4 * kq + e) * CS + n * 2)) << 16);
            } else cacc = *(const LAS f32x4m*)(lds + L_PF + (n - 64) * FS + (16 * I + 4 * kq) * 4);
            if (I > 0) {
#pragma unroll
                for (int ks = 0; ks < 2; ++ks) { const bf16x8 a = *(const LAS bf16x8*)(a_m2 + I * 16 * CS + ks * 64), b2 = *(const LAS bf16x8*)(b_q1 + ks * 64);
                    cacc = __builtin_amdgcn_mfma_f32_16x16x32_bf16(a, b2, cacc, 0, 0, 0); }
            }
            { v4u w; w.x = cvtpk_v(cacc[0], cacc[1]); w.y = cvtpk_v(cacc[2], cacc[3]); *(LAS unsigned long long*)(rtw + c16 * 64 + kq * 8) = (unsigned long long)w.x | ((unsigned long long)w.y << 32); }
            asm volatile("s_waitcnt lgkmcnt(0)" ::: "memory");
            const bf16x8 pa = *(const LAS bf16x8*)(a_pi + I * 1024), rb = *(const LAS bf16x8*)(b_rt);
            f32x4m q = {0.f, 0.f, 0.f, 0.f};
            q = __builtin_amdgcn_mfma_f32_16x16x32_bf16(pa, rb, q, 0, 0, 0);
            { v4u w; w.x = cvtpk_v(q[0], q[1]); w.y = cvtpk_v(q[2], q[3]); *(LAS unsigned long long*)(q1w + c16 * CS + (16 * I + 4 * kq) * 2) = (unsigned long long)w.x | ((unsigned long long)w.y << 32); }
            asm volatile("s_waitcnt lgkmcnt(0)" ::: "memory");
        }
    }
    __syncthreads(); S1T(4);
    int lane3 = lane; asm volatile("" : "+v"(lane3));
    const int hl4 = lane3 >> 5, cl4 = lane3 & 31;
    if (wv < 4) {
        f32x16 aw = {}, as = {};
        mm32(aw, lds + L_M3 + tb * 32 * CS, lds + L_Q1 + ib * 32 * CS, lane3);
        mm32(as, lds + L_BH + tb * 32 * CS, lds + L_Q1 + ib * 32 * CS, lane3);
        const int j = ib * 32 + cl4; const float gl = ((const LAS float*)(lds + L_GL))[j]; const int pc = permcol(j);
#pragma unroll
        for (int rg = 0; rg < 16; ++rg) { const int row = tb * 32 + crow(rg, hl4);
            const float rt = __uint_as_float((unsigned)(*(const LAS unsigned short*)(lds + L_RT + row * CS + j * 2)) << 16);
            st_bf16(lds + L_PF + row * CS + pc * 2, aw[rg] + rt);
            st_bf16(lds + L_PF + 9216 + row * CS + pc * 2, as[rg] + ((row == j) ? gl : 0.f)); }
    } else {
        mm32(accY, lds + L_M3 + tb * 32 * CS, lds + L_Q1 + (64 + ib * 32) * CS, lane3);
        mm32(accQ, lds + L_BH + tb * 32 * CS, lds + L_Q1 + (64 + ib * 32) * CS, lane3);
        const size_t o0 = (m0 + tb * 32 + (lane3 >> 3)) * 1024 + h * 64 + ib * 32 + (lane3 & 7) * 4;
#pragma unroll
        for (int g = 0; g < 4; ++g) { *(f32x4*)(P.Y + o0 + (size_t)g * 8 * 1024) = (f32x4){accY[4 * g], accY[4 * g + 1], accY[4 * g + 2], accY[4 * g + 3]};
            *(f32x4*)(P.DEC + o0 + (size_t)g * 8 * 1024) = (f32x4){accQ[4 * g], accQ[4 * g + 1], accQ[4 * g + 2], accQ[4 * g + 3]}; }
    }
    __syncthreads(); S1T(5);
    { const int row = tid >> 3, pc8 = tid & 7;
      *(v4u*)(P.KP + (m0 + row) * 1024 + h * 64 + pc8 * 8) = *(const LAS v4u*)(lds + L_PF + row * CS + pc8 * 16);
      *(v4u*)(P.AV + (m0 + row) * 1024 + h * 64 + pc8 * 8) = *(const LAS v4u*)(lds + L_PF + 9216 + row * CS + pc8 * 16); }
    __syncthreads(); S1T(6);
}

constexpr int S2_WY = 0, S2_WS = 9216, S2_YI = 18432, S2_QS = 35840, S2_SLOT = 53248;
struct S2Set { v4u kp, av, y0, y1, d0, d1; };
__device__ __forceinline__ void s2_load(const Ptrs& P, int b, int h, int c, int tid, S2Set& G) {
    const size_t m0 = (size_t)b * SEQ + (size_t)c * 64; const int lr = tid >> 3, lp = tid & 7, yr = tid >> 4, yp = tid & 15;
    G.kp = *(const v4u*)(P.KP + (m0 + lr) * 1024 + h * 64 + lp * 8); G.av = *(const v4u*)(P.AV + (m0 + lr) * 1024 + h * 64 + lp * 8);
    G.y0 = *(const v4u*)(P.Y + (m0 + yr) * 1024 + h * 64 + yp * 4); G.y1 = *(const v4u*)(P.Y + (m0 + 32 + yr) * 1024 + h * 64 + yp * 4);
    G.d0 = *(const v4u*)(P.DEC + (m0 + yr) * 1024 + h * 64 + yp * 4); G.d1 = *(const v4u*)(P.DEC + (m0 + 32 + yr) * 1024 + h * 64 + yp * 4);
}
__device__ __forceinline__ void s2_write(LAS unsigned char* slot, int tid, const S2Set& G) {
    const int lr = tid >> 3, lp = tid & 7, yr = tid >> 4, yp = tid & 15;
    *(LAS v4u*)(slot + S2_WY + lr * CS + lp * 16) = G.kp; *(LAS v4u*)(slot + S2_WS + lr * CS + lp * 16) = G.av;
    *(LAS v4u*)(slot + S2_YI + yr * FS + yp * 16) = G.y0; *(LAS v4u*)(slot + S2_YI + (32 + yr) * FS + yp * 16) = G.y1;
    *(LAS v4u*)(slot + S2_QS + yr * FS + yp * 16) = G.d0; *(LAS v4u*)(slot + S2_QS + (32 + yr) * FS + yp * 16) = G.d1;
}
typedef float f32x8 __attribute__((ext_vector_type(8)));
#define S2_CAT(a, b, c2, d) __builtin_shufflevector(__builtin_shufflevector(a, b, 0, 1, 2, 3, 4, 5, 6, 7), __builtin_shufflevector(c2, d, 0, 1, 2, 3, 4, 5, 6, 7), 0, 1, 2, 3, 4, 5, 6, 7, 8, 9, 10, 11, 12, 13, 14, 15)
__device__ __forceinline__ void s2_compute(const Ptrs& P, int b, int h, int ib, int c, const LAS unsigned char* slot, int lane, f32x16& X0, f32x16& X1) {
    const int r = lane & 31, hl = lane >> 5;
    bf16x8 bf[2][2];
    {
        const f32x16* X[2] = {&X0, &X1};
#pragma unroll
        for (int jb = 0; jb < 2; ++jb)
#pragma unroll
            for (int ks = 0; ks < 2; ++ks) { const f32x16& x = *X[jb]; v4u w;
                w.x = cvtpk_v(x[8 * ks], x[8 * ks + 1]); w.y = cvtpk_v(x[8 * ks + 2], x[8 * ks + 3]); w.z = cvtpk_v(x[8 * ks + 4], x[8 * ks + 5]); w.w = cvtpk_v(x[8 * ks + 6], x[8 * ks + 7]);
                bf[jb][ks] = __builtin_bit_cast(bf16x8, w); }
    }
    const LAS unsigned char* pa = slot + r * CS + hl * 16;
    const LAS unsigned char* pc = slot + (lane >> 3) * FS + ib * 128 + (lane & 7) * 16;
#define S2_TILE(base, tb) S2_CAT(*(const LAS f32x4*)(pc + (base) + ((tb) * 32) * FS), *(const LAS f32x4*)(pc + (base) + ((tb) * 32 + 8) * FS), *(const LAS f32x4*)(pc + (base) + ((tb) * 32 + 16) * FS), *(const LAS f32x4*)(pc + (base) + ((tb) * 32 + 24) * FS))
#define S2_AF(base, rb, jb, ks) (*(const LAS bf16x8*)(pa + (base) + (rb) * 32 * CS + (jb) * 64 + (ks) * 32))
    f32x16 y0 = S2_TILE(S2_YI, 0), y1 = S2_TILE(S2_YI, 1);
#pragma unroll
    for (int jb = 0; jb < 2; ++jb)
#pragma unroll
        for (int ks = 0; ks < 2; ++ks) { y0 = __builtin_amdgcn_mfma_f32_32x32x16_bf16(S2_AF(S2_WY, 0, jb, ks), bf[jb][ks], y0, 0, 0, 0); y1 = __builtin_amdgcn_mfma_f32_32x32x16_bf16(S2_AF(S2_WY, 1, jb, ks), bf[jb][ks], y1, 0, 0, 0); }
    {
        float* cb_ = P.Y + ((size_t)b * SEQ + (size_t)c * 64) * 1024; const unsigned offY = (unsigned)((4 * hl) * 1024 + h * 64 + ib * 32 + r);
#pragma unroll
        for (int rg = 0; rg < 16; ++rg) { const int rr = (rg & 3) + 8 * (rg >> 2); float *pa_ = cb_ + rr * 1024, *pb_ = cb_ + (32 + rr) * 1024; asm volatile("" : "+s"(pa_), "+s"(pb_)); pa_[offY] = y0[rg]; pb_[offY] = y1[rg]; }
    }
    f32x16 q0 = S2_TILE(S2_QS, 0), q1 = S2_TILE(S2_QS, 1);
#pragma unroll
    for (int jb = 0; jb < 2; ++jb)
#pragma unroll
        for (int ks = 0; ks < 2; ++ks) { q0 = __builtin_amdgcn_mfma_f32_32x32x16_bf16(S2_AF(S2_WS, 0, jb, ks), bf[jb][ks], q0, 0, 0, 0); q1 = __builtin_amdgcn_mfma_f32_32x32x16_bf16(S2_AF(S2_WS, 1, jb, ks), bf[jb][ks], q1, 0, 0, 0); }
    X0 = q0; X1 = q1;
#undef S2_TILE
#undef S2_AF
}
__device__ __forceinline__ void s2_block(const Ptrs& P, int bh, LAS unsigned char* lds, int tid, int wv) {
    const int b = bh >> 4, h = bh & 15, lane = tid & 63;
    constexpr int NC = SEQ / 64;
    f32x16 X0 = {}, X1 = {};
    S2Set GA, GB;
    s2_load(P, b, h, 0, tid, GA); s2_load(P, b, h, 1, tid, GB);
    s2_write(lds, tid, GA);
    s2_load(P, b, h, 2, tid, GA);
    __syncthreads();
    for (int c = 0; c < NC; c += 2) {
        s2_write(lds + S2_SLOT, tid, GB);
        if (c + 3 < NC) s2_load(P, b, h, c + 3, tid, GB);
        if (wv < 2) s2_compute(P, b, h, wv, c, lds, lane, X0, X1);
        __syncthreads();
        if (c + 2 < NC) s2_write(lds, tid, GA);
        if (c + 4 < NC) s2_load(P, b, h, c + 4, tid, GA);
        if (wv < 2) s2_compute(P, b, h, wv, c + 1, lds + S2_SLOT, lane, X0, X1);
        __syncthreads();
    }
}
#undef S2_CAT
}
__device__ __forceinline__ unsigned enc_key(float s) { const unsigned b = __float_as_uint(s); return b ^ ((b >> 31) ? 0xFFFFFFFFu : 0x80000000u); }
__device__ __forceinline__ float dec_key(unsigned u) { const unsigned b = (u & 0x80000000u) ? (u ^ 0x80000000u) : ~u; return __uint_as_float(b); }
__device__ __forceinline__ void ins16(unsigned (&L)[16], unsigned x) {
#pragma unroll
    for (int i = 0; i < 16; ++i) { const unsigned hi = max(L[i], x); x = min(L[i], x); L[i] = hi; }
}
constexpr int TK_CS = 144, TK_LO = 36864;
__device__ __forceinline__ void topk_pass(const Ptrs& P, int h, int tok0, const LAS unsigned char* lds, const int p, int lane, int w, unsigned (&L0)[16], unsigned (&L1)[16]) {
    const int r = lane & 31, hi = lane >> 5;
#pragma unroll
    for (int i = 0; i < 16; ++i) { L0[i] = 0u; L1[i] = 0u; }
    bf16x8 qf[2][4];
#pragma unroll
    for (int tt = 0; tt < 2; ++tt)
#pragma unroll
        for (int ks = 0; ks < 4; ++ks) qf[tt][ks] = *(const bf16x8*)(P.QP + (size_t)(tok0 + w * 64 + tt * 32 + r) * 1024 + h * 128 + p * 64 + ks * 16 + hi * 8);
    const LAS unsigned char* ka = lds + (size_t)(p * 128 + r) * TK_CS + hi * 16;
#pragma unroll
    for (int nt = 0; nt < 4; ++nt) {
        bf16x8 ah[4], al[4];
#pragma unroll
        for (int ks = 0; ks < 4; ++ks) { ah[ks] = *(const LAS bf16x8*)(ka + nt * 32 * TK_CS + ks * 32); al[ks] = *(const LAS bf16x8*)(ka + TK_LO + nt * 32 * TK_CS + ks * 32); }
        rk::f32x16 acc0 = {}, acc1 = {};
#pragma unroll
        for (int ks = 0; ks < 4; ++ks) { acc0 = __builtin_amdgcn_mfma_f32_32x32x16_bf16(ah[ks], qf[0][ks], acc0, 0, 0, 0); acc0 = __builtin_amdgcn_mfma_f32_32x32x16_bf16(al[ks], qf[0][ks], acc0, 0, 0, 0);
            acc1 = __builtin_amdgcn_mfma_f32_32x32x16_bf16(ah[ks], qf[1][ks], acc1, 0, 0, 0); acc1 = __builtin_amdgcn_mfma_f32_32x32x16_bf16(al[ks], qf[1][ks], acc1, 0, 0, 0); }
#pragma unroll
        for (int rg = 0; rg < 16; ++rg) { const unsigned tag = (unsigned)(127 - (nt * 32 + (rg & 3) + 8 * (rg >> 2) + 4 * hi));
            ins16(L0, (enc_key(acc0[rg]) & ~0x7Fu) | tag); ins16(L1, (enc_key(acc1[rg]) & ~0x7Fu) | tag); }
    }
}
__device__ __forceinline__ void peer_topk(const Ptrs& P, int h, int tok0, LAS unsigned char* lds, int tid) {
    const int lane = tid & 63, w = tid >> 6, r = lane & 31, hi = lane >> 5;
    {
        const int row = tid >> 1, d0 = (tid & 1) * 32; const float* src = P.sub_keys + ((size_t)h * 256 + row) * 64 + d0;
#pragma unroll
        for (int j = 0; j < 4; ++j) { const f32x4 a = *(const f32x4*)(src + 8 * j), b = *(const f32x4*)(src + 8 * j + 4);
            const float x[8] = {a.x, a.y, a.z, a.w, b.x, b.y, b.z, b.w}; float lo[8]; v4u vh, vl;
#pragma unroll
            for (int e = 0; e < 8; ++e) { const float hb = __uint_as_float(f2bf(x[e]) << 16); lo[e] = x[e] - hb; }
            vh.x = pk2(x[0], x[1]); vh.y = pk2(x[2], x[3]); vh.z = pk2(x[4], x[5]); vh.w = pk2(x[6], x[7]);
            vl.x = pk2(lo[0], lo[1]); vl.y = pk2(lo[2], lo[3]); vl.z = pk2(lo[4], lo[5]); vl.w = pk2(lo[6], lo[7]);
            *(LAS v4u*)(lds + row * TK_CS + (d0 + 8 * j) * 2) = vh; *(LAS v4u*)(lds + TK_LO + row * TK_CS + (d0 + 8 * j) * 2) = vl; }
    }
    __syncthreads();
    unsigned L00[16], L01[16], L10[16], L11[16];
    topk_pass(P, h, tok0, lds, 0, lane, w, L00, L01);
    topk_pass(P, h, tok0, lds, 1, lane, w, L10, L11);
    unsigned M1[2][16];
#pragma unroll
    for (int i = 0; i < 16; ++i) { M1[0][i] = hi ? L01[i] : L00[i]; M1[1][i] = hi ? L11[i] : L10[i]; }
#pragma unroll
    for (int i = 0; i < 16; ++i) { const unsigned s0 = hi ? L00[i] : L01[i], s1 = hi ? L10[i] : L11[i]; ins16(M1[0], (unsigned)__shfl_xor((int)s0, 32)); ins16(M1[1], (unsigned)__shfl_xor((int)s1, 32)); }
    const int t = tok0 + w * 64 + hi * 32 + r;
    unsigned F[16];
#pragma unroll
    for (int i = 0; i < 16; ++i) F[i] = 0u;
    float v1[16], v2[16];
#pragma unroll
    for (int i = 0; i < 16; ++i) { v1[i] = dec_key((M1[0][i] & ~0x7Fu) | 0x40u); v2[i] = dec_key((M1[1][i] & ~0x7Fu) | 0x40u); }
#pragma unroll
    for (int a = 0; a < 16; ++a)
#pragma unroll
        for (int b = 0; b < 16; ++b)
            if ((a + 1) * (b + 1) <= 16) ins16(F, (enc_key(v1[a] + v2[b]) & ~0xFFu) | (unsigned)(255 - (16 * a + b)));
    float sv[16]; unsigned id[16];
#pragma unroll
    for (int i = 0; i < 16; ++i) {
        sv[i] = dec_key((F[i] & ~0xFFu) | 0x80u);
        const unsigned ab = 255u - (F[i] & 0xFFu), a = ab >> 4, b = ab & 15u;
        unsigned la = 0u, lb = 0u;
#pragma unroll
        for (int j = 0; j < 16; ++j) { la = (a == (unsigned)j) ? M1[0][j] : la; lb = (b == (unsigned)j) ? M1[1][j] : lb; }
        id[i] = (127u - (la & 0x7Fu)) * 128u + (127u - (lb & 0x7Fu));
    }
    float z = 0.f;
#pragma unroll
    for (int i = 0; i < 16; ++i) { sv[i] = __expf(sv[i] - sv[0]); z += sv[i]; }
    const float rz = 1.0f / z;
    float* gdst = P.GATE + (size_t)t * 128 + h * 16;
#pragma unroll
    for (int i = 0; i < 16; i += 4) *(f32x4*)(gdst + i) = (f32x4){sv[i] * rz, sv[i + 1] * rz, sv[i + 2] * rz, sv[i + 3] * rz};
    unsigned short* idst = P.IDX + (size_t)t * 128 + h * 16;
    *(v4u*)idst = (v4u){id[0] | (id[1] << 16), id[2] | (id[3] << 16), id[4] | (id[5] << 16), id[6] | (id[7] << 16)};
    *(v4u*)(idst + 8) = (v4u){id[8] | (id[9] << 16), id[10] | (id[11] << 16), id[12] | (id[13] << 16), id[14] | (id[15] << 16)};
    __syncthreads();
}

__device__ __forceinline__ float gelu_erf(float x) { return 0.5f * x * (1.0f + erff(x * 0.70710678118654752f)); }
typedef float f32x2v __attribute__((ext_vector_type(2)));
__device__ __forceinline__ void ld_row4(const unsigned char* row, int lane, float (&r)[32]) {
    const v4u u = *(const v4u*)(row + lane * 16); const unsigned w[4] = {u.x, u.y, u.z, u.w};
#pragma unroll
    for (int d = 0; d < 4; ++d) {
        const f32x2v a = __builtin_amdgcn_cvt_scalef32_pk_f32_fp4(w[d], 1.0f, 0), b = __builtin_amdgcn_cvt_scalef32_pk_f32_fp4(w[d], 1.0f, 1), c2 = __builtin_amdgcn_cvt_scalef32_pk_f32_fp4(w[d], 1.0f, 2), d2 = __builtin_amdgcn_cvt_scalef32_pk_f32_fp4(w[d], 1.0f, 3);
        r[8 * d] = a.x; r[8 * d + 1] = a.y; r[8 * d + 2] = b.x; r[8 * d + 3] = b.y; r[8 * d + 4] = c2.x; r[8 * d + 5] = c2.y; r[8 * d + 6] = d2.x; r[8 * d + 7] = d2.y; }
}
__device__ __forceinline__ void peer_token(const Ptrs& P, int t, int lane) {
    float x2[32];
    float ss_t = 0.f;
#pragma unroll
    for (int i = 0; i < 8; ++i) { const f32x4 s4 = *(const f32x4*)(P.SSQ + (size_t)t * 32 + 4 * i); ss_t += (s4.x + s4.y) + (s4.z + s4.w); }
    const float rs_t = 1.0f / sqrtf(ss_t * (1.0f / DMODEL) + 1e-6f);
    { const bf16* xr = P.XN + (size_t)t * 2048 + lane * 4;
#pragma unroll
      for (int j = 0; j < 8; ++j) { const unsigned long long u = *(const unsigned long long*)(xr + 256 * j); const unsigned lo = (unsigned)u, hi2 = (unsigned)(u >> 32);
          x2[4 * j] = bflo(lo) * rs_t; x2[4 * j + 1] = bfhi(lo) * rs_t; x2[4 * j + 2] = bflo(hi2) * rs_t; x2[4 * j + 3] = bfhi(hi2) * rs_t; } }
    unsigned idxv[2]; float wv[2];
#pragma unroll
    for (int kb = 0; kb < 2; ++kb) {
        idxv[kb] = P.IDX[(size_t)t * 128 + kb * 64 + lane];
        float p[64];
#pragma unroll
        for (int i = 0; i < 64; ++i) {
            const unsigned e = (unsigned)__builtin_amdgcn_readlane((int)idxv[kb], i);
            float r[32]; ld_row4(P.U8 + (size_t)e * ROW6, lane, r);
            float a0 = 0.f, a1 = 0.f, a2 = 0.f, a3 = 0.f;
#pragma unroll
            for (int q = 0; q < 8; ++q) { a0 += r[4 * q] * x2[4 * q]; a1 += r[4 * q + 1] * x2[4 * q + 1]; a2 += r[4 * q + 2] * x2[4 * q + 2]; a3 += r[4 * q + 3] * x2[4 * q + 3]; }
            p[i] = (a0 + a1) + (a2 + a3);
        }
#pragma unroll
        for (int o = 32, n = 64; o >= 1; o >>= 1, n >>= 1) {
            const bool up = (lane & o) != 0;
#pragma unroll
            for (int i = 0; i < n / 2; ++i) { const float keep = up ? p[i + n / 2] : p[i], send = up ? p[i] : p[i + n / 2]; p[i] = keep + __shfl_xor(send, o); }
        }
        const unsigned e = idxv[kb];
        const float hk = gelu_erf(p[0] * P.USC[e]);
        wv[kb] = P.GATE[(size_t)t * 128 + kb * 64 + lane] * hk * P.VSC[e];
    }
    float acc[32];
#pragma unroll
    for (int i = 0; i < 32; ++i) acc[i] = 0.f;
#pragma unroll
    for (int kb = 0; kb < 2; ++kb) {
#pragma unroll 16
        for (int i = 0; i < 64; ++i) {
            const unsigned e = (unsigned)__builtin_amdgcn_readlane((int)idxv[kb], i);
            const float wk = __uint_as_float((unsigned)__builtin_amdgcn_readlane((int)__float_as_uint(wv[kb]), i));
            float r[32]; ld_row4(P.V8 + (size_t)e * ROW6, lane, r);
#pragma unroll
            for (int q = 0; q < 32; ++q) acc[q] += wk * r[q];
        }
    }
    float* orow = P.out + (size_t)t * 2048 + lane * 4;
#pragma unroll
    for (int q = 0; q < 8; ++q) { f32x4* o = (f32x4*)(orow + 256 * q); f32x4 v = *o;
        v.x += acc[4 * q]; v.y += acc[4 * q + 1]; v.z += acc[4 * q + 2]; v.w += acc[4 * q + 3]; *o = v; }
}
struct AttnQueue {
    gu32* ctr; volatile LAS unsigned* slot; int tid; unsigned q0;
    __device__ __forceinline__ bool next(int i, attn_body::AttnUnit& u) const {
        if (tid == 0) {
            unsigned k = slot[2], v = 0xFFFFFFFFu;
            while (k < 8u) { const unsigned q = (q0 + k) & 7u; const unsigned t = __hip_atomic_fetch_add(ctr + 64 * q, 1u, RLX_AGENT); if (t < 128u) { v = (q << 16) | t; break; } ++k; }
            slot[2] = k; slot[i & 1] = v;
        }
        __syncthreads();
        const unsigned v = (unsigned)__builtin_amdgcn_readfirstlane((int)slot[i & 1]);
        if (v == 0xFFFFFFFFu) return false;
        const unsigned q = v >> 16, t = v & 0xFFFFu;
        u.qb = 31 - (int)(t >> 2); u.bh = (int)(q + 8u * (t & 3u)); return true;
    }
    __device__ __forceinline__ void a_ready(const attn_body::AttnUnit&) const {}
    __device__ __forceinline__ void done(const attn_body::AttnUnit&) const {}
};

struct Args { const float* in[23]; float* out; unsigned char* ws; };

__device__ __forceinline__ int lane_id_fresh() { int l; asm volatile("v_mbcnt_lo_u32_b32 %0, -1, 0\n\tv_mbcnt_hi_u32_b32 %0, -1, %0" : "=v"(l)); return l; }
__device__ __forceinline__ Frame make_frame(unsigned char* lds, int wv) {
    Frame F; F.lds = (LAS unsigned char*)lds; F.MISC = (volatile LAS unsigned*)(F.lds + MISC_OFF); F.ctl = nullptr;
    F.lane = lane_id_fresh(); F.wave = wv; F.tid = wv * 64 + F.lane;
    F.G = gridDim.x; { const int bx = blockIdx.x; F.vcu = (F.G % 8 == 0) ? (bx % 8) * (F.G / 8) + bx / 8 : bx; }
    return F;
}
typedef __attribute__((address_space(4))) const unsigned long long kau64;
__device__ __forceinline__ Ptrs make_ptrs(kau64* ka) {
    Ptrs P; struct { const float* in[23]; } args;
#pragma unroll
    for (int i = 0; i < 23; ++i) args.in[i] = (const float*)(GAS const float*)ka[i];
    float* outp = (float*)(GAS float*)ka[23]; unsigned char* ws = (unsigned char*)(GAS unsigned char*)ka[24];
    P.x = args.in[0]; P.norm1_g = args.in[1]; P.w_in = args.in[2]; P.mu = args.in[3]; P.w_decay_up = args.in[4]; P.w0 = args.in[5]; P.w_iclr_up = args.in[6]; P.a0 = args.in[7];
    P.w_gate_up = args.in[8]; P.k_k = args.in[9]; P.k_a = args.in[10]; P.r_k = args.in[11]; P.lnx_g = args.in[12]; P.lnx_b = args.in[13]; P.fox_b_f = args.in[14];
    P.q_norm_g = args.in[15]; P.k_norm_g = args.in[16]; P.w_out = args.in[17]; P.norm2_g = args.in[18]; P.w_q = args.in[19]; P.sub_keys = args.in[20]; P.peer_u = args.in[21]; P.peer_v = args.in[22];
    P.out = outp;
    P.WQT = (bf16*)(ws + WS_WQT); P.LWT = (bf16*)(ws + WS_LWT); P.WOT = (bf16*)(ws + WS_WOT); P.WINT = (bf16*)(ws + WS_WINT); P.LA = (bf16*)(ws + WS_LA);
    P.XN = (bf16*)(ws + WS_XN); P.PROJ = (bf16*)(ws + WS_PROJ); P.MIXED = (bf16*)(ws + WS_MIXED); P.KP = (bf16*)(ws + WS_KP); P.AV = (bf16*)(ws + WS_AV); P.BV = (bf16*)(ws + WS_BV);
    P.QP = (bf16*)(ws + WS_QP); P.G = (bf16*)((unsigned char*)outp + OUT_G); P.AIC = (bf16*)((unsigned char*)outp + OUT_AIC);
    P.C2 = (float*)(ws + WS_C2); P.BON = (float*)(ws + WS_BON); P.Y = (float*)(ws + WS_XN); P.DEC = (float*)((unsigned char*)outp + OUT_DEC);
    P.GATE = (float*)(ws + WS_GATE); P.USC = (float*)(ws + WS_USC); P.VSC = (float*)(ws + WS_VSC); P.SSQ = (float*)(ws + WS_SSQ);
    P.IDX = (unsigned short*)(ws + WS_IDX); P.U8 = ws + WS_U8; P.V8 = ws + WS_V8;
    return P;
}
#define PHASE_BEGIN() Frame F = make_frame(lds, wv_); const int gw = F.vcu * NWAVES + F.wave, NGW = F.G * NWAVES; (void)gw; (void)NGW; kau64* ka_ = (kau64*)__builtin_amdgcn_kernarg_segment_ptr(); asm volatile("" : "+s"(ka_)); \
    const Ptrs P = make_ptrs(ka_); unsigned char* ws_ = (unsigned char*)(GAS unsigned char*)ka_[24]; (void)ws_; \
    const int lane = F.lane, tid = F.tid; (void)lane; (void)tid
__global__ void __launch_bounds__(NWAVES * 64, 2) hymba_fwd(Args args) {
    extern __shared__ __attribute__((aligned(16))) unsigned char lds[];
    const int wv_ = __builtin_amdgcn_readfirstlane((int)threadIdx.x >> 6);
    { Frame F = make_frame(lds, wv_);
    for (int u = F.tid; u < (LDS_BYTES - LDSCTL_OFF) / 4; u += NWAVES * 64) ((LAS unsigned*)(F.lds + LDSCTL_OFF))[u] = 0u;
    __syncthreads();
    { kau64* kb_ = (kau64*)__builtin_amdgcn_kernarg_segment_ptr(); F.ctl = (gu32*)((GAS unsigned char*)kb_[24] + WS_CTL); }
    (void)xcd_barrier_post((unsigned*)(F.ctl + CW_BAR), F.MISC + 8, F.tid); }
#ifdef PROBE_MASK
#define STAMP(k) do { if (blockIdx.x == 0 && wv_ == 0) { unsigned long long t_; __builtin_amdgcn_sched_barrier(0); asm volatile("s_memrealtime %0\n\ts_waitcnt lgkmcnt(0)" : "=s"(t_) :: "memory"); __builtin_amdgcn_sched_barrier(0); if (lane_id_fresh() == 0) { ((volatile LAS unsigned*)((LAS unsigned char*)lds + MISC_OFF))[64 + (k)] = (unsigned)t_; } } } while (0)
#else
#define STAMP(k) do {} while (0)
#endif
#define GRID_BAR() do { kau64* kb_ = (kau64*)__builtin_amdgcn_kernarg_segment_ptr(); asm volatile("" : "+s"(kb_)); XcdBarrier b_; b_.bar = (unsigned*)((gu32*)((GAS unsigned char*)kb_[24] + WS_CTL) + CW_BAR); b_.x = xb_xcc_id(); b_.st = (volatile LAS unsigned*)((LAS unsigned char*)lds + MISC_OFF) + 8; xcd_barrier(b_, wv_ * 64 + lane_id_fresh()); } while (0)

    STAMP(0);
    { PHASE_BEGIN();
        LAS float* scr = (LAS float*)(F.lds + RING_OFF + F.wave * 16384);
        constexpr int B_IN = 32 * 26, B_O = 32 * 8, B_Q = 32 * 4, I_L = 2 * 32;
        for (int it = (int)blockIdx.x; it < B_IN + B_O + B_Q; it += F.G) {
            int r = it; LAS float* bscr = (LAS float*)(F.lds + RING_OFF);
            if (r < B_IN) { p0_transpose_block(P.w_in, 2048, NIN, P.WINT, 2048, bscr, r / 26, r % 26, tid); continue; } r -= B_IN;
            if (r < B_O) { p0_transpose_block(P.w_out, 2048, 2048, P.WOT, 2048, bscr, r / 8, r % 8, tid); continue; } r -= B_O;
            p0_transpose_block(P.w_q, 2048, 1024, P.WQT, 2048, bscr, r / 4, r % 4, tid);
        }
        for (int it = gw; it < 3 * I_L; it += NGW) {
            int r = it;
            if (r < I_L) { p0_transpose_item(P.w_decay_up, 64, 1024, P.LWT, 128, scr, r / 32, r % 32, lane); continue; } r -= I_L;
            if (r < I_L) { p0_transpose_item(P.w_iclr_up, 64, 1024, P.LWT + 1024 * 128, 128, scr, r / 32, r % 32, lane); continue; } r -= I_L;
            p0_transpose_item(P.w_gate_up, 128, 1024, P.LWT + 2 * 1024 * 128, 128, scr, r / 32, r % 32, lane);
        }
        STAMP(16);
        for (int e = gw; e < 2 * NEXP; e += NGW) {
            if (e < NEXP) fp6_row(P.peer_u + (size_t)e * 2048, P.U8 + (size_t)e * ROW6, P.USC + e, lane);
            else fp6_row(P.peer_v + (size_t)(e - NEXP) * 2048, P.V8 + (size_t)(e - NEXP) * ROW6, P.VSC + (e - NEXP), lane);
        }
        STAMP(17);
        for (int m = gw; m < M; m += NGW) rms_row_to_bf16(P.x + (size_t)m * DMODEL, P.norm1_g, P.XN + (size_t)m * DMODEL, lane);
    }
    GRID_BAR(); STAMP(1);
    { PHASE_BEGIN();
        pg8::Gemm g{P.XN, P.WINT, M, PJ, DMODEL}; pg8::StaticOrder S; S.init(M, PJ, F.G, (int)blockIdx.x);
        pg8::EpiBf16<0> E{P.PROJ, PJ, nullptr, 0, 0, 1.f};
        pg8::gemm_phase<pg8::EpiBf16<0>, pg8::StaticOrder, PG8_ALIGN, PG8_SP2>(F.lds + RING_OFF, g, S, E, tid);
    }
    GRID_BAR(); STAMP(2);
    { PHASE_BEGIN();
        if (blockIdx.x < 32) fox_cumsum(P, (int)blockIdx.x, (LAS float*)(F.lds + RING_OFF), tid);
        for (int m = gw; m < M; m += NGW) prepA_token(P, m, lane);
    }
    GRID_BAR(); STAMP(3);
    { PHASE_BEGIN();
        pg8::Gemm g{P.LA, P.LWT, M, 3072, 128, 4, (size_t)M * 128 * 2}; pg8::StaticOrder S; S.init(M, 3072, F.G, (int)blockIdx.x);
        pg8::EpiLora3 E{P.w0, P.a0, P.DEC, P.AIC, P.G};
        pg8::gemm_phase<pg8::EpiLora3, pg8::StaticOrder, PG8_ALIGN, PG8_SP2>(F.lds + RING_OFF, g, S, E, tid);
    }
    GRID_BAR(); STAMP(4);
    STAMP(5);
    { PHASE_BEGIN(); rk::S1Regs R; int u = (int)blockIdx.x; if (u < 4096) rk::s1_load(P, u, tid, R);
#ifdef PROBE_MASK
      if (blockIdx.x == 0 && F.wave == 0) { unsigned long long t_; asm volatile("s_memrealtime %0\n\ts_waitcnt lgkmcnt(0)" : "=s"(t_) :: "memory"); if (lane == 0) ((volatile LAS unsigned*)((LAS unsigned char*)lds + MISC_OFF))[87] = (unsigned)t_; }
#endif
      for (; u < 4096; u += F.G) rk::s1_unit(P, u, u + F.G, R, F.lds + RING_OFF, tid, F.wave); }
    GRID_BAR(); STAMP(13);
    { PHASE_BEGIN();
        if (blockIdx.x < 32) rk::s2_block(P, (int)blockIdx.x, F.lds + RING_OFF, tid, F.wave);
        {
            static_assert(attn_body::ATTN_LDS_BYTES <= RING_BYTES, "attention LDS");
            const attn_body::AttnTensors AT{(const attn_body::bf16*)(P.PROJ + C_FQ), (const attn_body::bf16*)(P.PROJ + C_FK), (const attn_body::bf16*)(P.PROJ + C_FV), (attn_body::bf16*)(P.MIXED + 1024), P.C2};
            const AttnQueue S{(gu32*)(ws_ + WS_CTL) + CW_QUEUE, F.MISC + 16, tid, xb_xcc_id() & 7u};
            attn_body::attn_phase<AttnQueue>((char*)lds + RING_OFF, AT, S, tid);
            STAMP(14);
        }
    }
    GRID_BAR(); STAMP(6);
    { PHASE_BEGIN();
        for (int m = gw; m < M; m += NGW) post_token(P, m, lane);
    }
    GRID_BAR(); STAMP(7);
    { PHASE_BEGIN();
        pg8::Gemm g{P.MIXED, P.WOT, M, DMODEL, DMODEL}; pg8::StaticOrder S; S.init(M, DMODEL, F.G, (int)blockIdx.x);
        pg8::EpiResNorm E{P.x, P.out, P.XN, P.norm2_g, (float*)(ws_ + WS_SSQ), DMODEL};
        pg8::gemm_phase<pg8::EpiResNorm, pg8::StaticOrder, PG8_ALIGN, PG8_SP2>(F.lds + RING_OFF, g, S, E, tid);
    }
    GRID_BAR(); STAMP(8);
    STAMP(9);
    { PHASE_BEGIN();
        pg8::Gemm g{P.XN, P.WQT, M, 1024, DMODEL}; pg8::StaticOrder S; S.init(M, 1024, F.G, (int)blockIdx.x);
        pg8::EpiBf16RowNorm E{P.QP, 1024, (const float*)(ws_ + WS_SSQ), 1.0f / DMODEL, 1e-6f};
        pg8::gemm_phase<pg8::EpiBf16RowNorm, pg8::StaticOrder, PG8_ALIGN, PG8_SP2>(F.lds + RING_OFF, g, S, E, tid);
    }
    GRID_BAR(); STAMP(10);
    { PHASE_BEGIN(); for (int it = (int)blockIdx.x; it < 8 * (M / 512); it += F.G) peer_topk(P, it & 7, (it >> 3) * 512, F.lds + RING_OFF, tid); }
    GRID_BAR(); STAMP(11);
    { PHASE_BEGIN(); for (int t = gw; t < M; t += NGW) peer_token(P, t, lane); }
#ifdef PROBE_MASK
    GRID_BAR();
    STAMP(12);
    if (blockIdx.x == 0 && wv_ == 0) { asm volatile("s_waitcnt lgkmcnt(0)" ::: "memory"); volatile LAS unsigned* ts_ = (volatile LAS unsigned*)((LAS unsigned char*)lds + MISC_OFF) + 64; unsigned tot = 0;
      for (int k = 0; k < 12; ++k) if ((PROBE_MASK >> k) & 1) tot += ts_[k + 1] - ts_[k];
      if ((PROBE_MASK >> 12) & 1) tot += ts_[13] - ts_[5];
      if ((PROBE_MASK >> 13) & 1) tot += ts_[6] - ts_[13];
      if ((PROBE_MASK >> 15) & 1) tot += ts_[15] - ts_[11];
      if ((PROBE_MASK >> 16) & 1) tot += ts_[12] - ts_[15];
      for (int k = 0; k < 7; ++k) if ((PROBE_MASK >> (17 + k)) & 1) tot += ((volatile LAS unsigned*)((LAS unsigned char*)lds + MISC_OFF))[80 + k];
      if ((PROBE_MASK >> 24) & 1) tot += ts_[16] - ts_[0];
      if ((PROBE_MASK >> 25) & 1) tot += ts_[17] - ts_[16];
      if ((PROBE_MASK >> 26) & 1) tot += ts_[1] - ts_[17];
      if ((PROBE_MASK >> 14) & 1) tot += ts_[14] - ts_[13];
      const unsigned long long t0_ = __builtin_amdgcn_s_memrealtime(); while ((unsigned)(__builtin_amdgcn_s_memrealtime() - t0_) < tot) __builtin_amdgcn_s_sleep(8); }
#endif
}

extern "C" void kernel_launch(void* const* d_in, const int* in_sizes, int n_in, void* d_out, int out_size, void* d_ws, size_t ws_size, hipStream_t stream) {
    static int grid = 0;
    if (grid == 0) {
        if (n_in != 23 || out_size != M * DMODEL || ws_size < WS_END) { fprintf(stderr, "kernel_launch: unexpected shapes (n_in %d, out %d, ws %zu); nothing launched\n", n_in, out_size, ws_size); grid = -1; return; }
        int dev = 0, cus = 0;
        if (hipGetDevice(&dev) != hipSuccess || hipDeviceGetAttribute(&cus, hipDeviceAttributeMultiprocessorCount, dev) != hipSuccess) { grid = -1; return; }
        if (hipFuncSetAttribute((const void*)hymba_fwd, hipFuncAttributeMaxDynamicSharedMemorySize, LDS_BYTES) != hipSuccess) { fprintf(stderr, "kernel_launch: hipFuncSetAttribute failed\n"); grid = -1; return; }
        int per_cu = 0;
        if (hipOccupancyMaxActiveBlocksPerMultiprocessor(&per_cu, (const void*)hymba_fwd, NWAVES * 64, LDS_BYTES) != hipSuccess || per_cu < 1) fprintf(stderr, "kernel_launch: occupancy query reports %d\n", per_cu);
        (void)hipGetLastError();
        grid = cus;
    }
    if (grid < 0) return;
    if (hipMemsetAsync((char*)d_ws + WS_CTL, 0, CTL_ZERO_BYTES, stream) != hipSuccess) return;
    Args a{};
    for (int i = 0; i < 23; ++i) a.in[i] = (const float*)d_in[i];
    a.out = (float*)d_out; a.ws = (unsigned char*)d_ws;
    hipLaunchKernelGGL(hymba_fwd, dim3(grid), dim3(NWAVES * 64), LDS_BYTES, stream, a);
}
```

```cpp
#include <hip/hip_runtime.h>
#include <cstdio>
#include <cstdint>
namespace pg8 {
#define PG8_LAS __attribute__((address_space(3)))
typedef unsigned short bf16_t;
typedef short bf16x8 __attribute__((ext_vector_type(8)));
typedef float f32x4 __attribute__((ext_vector_type(4)));
typedef unsigned u32x4 __attribute__((ext_vector_type(4)));
constexpr int BM = 256, BK = 64, HALF = 128, HTB = HALF * BK * 2  , STAGE_BYTES = 8 * HTB, NXCD = 8, WGM = 8;

__host__ __device__ __forceinline__ int lds_byte(int r, int c) { const int st = (r >> 4) * 2 + (c >> 5), rr = r & 15, cc = c & 31, ob = rr * 64 + cc * 2; return st * 1024 + (ob ^ (((ob >> 9) & 1) << 5)); }
__host__ __device__ __forceinline__ void stage_rc(int b, int& R, int& C) { const int st = b / 1024, sb = b % 1024, swz = sb ^ (((sb >> 9) & 1) << 5); R = (st >> 1) * 16 + swz / 64; C = (st & 1) * 32 + (swz % 64) / 2; }
__host__ __device__ __forceinline__ int perm32(int rho) { const int n = rho >> 4, i = rho & 15; return 8 * (i >> 2) + 4 * n + (i & 3); }

struct Unit { int pm, pn; };
struct Gemm { const bf16_t* A; const bf16_t* Bt; int M, N, K; int adiv = 1 << 20; size_t astride = 0; };

struct StaticOrder {
    int nM, nN, nwg, G, c;
    __host__ __device__ void init(int M, int N, int G_, int c_) { nM = M / BM; nN = N / BM; nwg = nM * nN; G = G_; c = c_; }
    __host__ __device__ bool next(int i, Unit& u) const {
        const long L = (long)i * G + c; if (L >= nwg) return false;
        int wgid = (int)L; { const int q = nwg / NXCD, r = nwg % NXCD, xcd = wgid % NXCD, off = wgid / NXCD; wgid = (xcd < r ? xcd * (q + 1) : r * (q + 1) + (xcd - r) * q) + off; }
        const int nig = WGM * nN, gid = wgid / nig, fm = gid * WGM, gsz = (nM - fm) < WGM ? (nM - fm) : WGM;
        u.pm = fm + ((wgid % nig) % gsz); u.pn = (wgid % nig) / gsz; return true;
    }
    __device__ __forceinline__ void a_ready(const Unit&) const {}
    __device__ __forceinline__ void done(const Unit&) const {}
};

__device__ __forceinline__ unsigned cvt_pk_bf16(float lo, float hi) { unsigned r; asm volatile("v_cvt_pk_bf16_f32 %0, %1, %2" : "=v"(r) : "v"(lo), "v"(hi)); return r; }
typedef float f32x2 __attribute__((ext_vector_type(2)));
__device__ __forceinline__ f32x2 gelu_pk(f32x2 v) {
    const f32x2 av = __builtin_elementwise_abs(v), d = av * 0.2316418882f + 1.0f;
    f32x2 t; t.x = __builtin_amdgcn_rcpf(d.x); t.y = __builtin_amdgcn_rcpf(d.y);
    f32x2 q = t * 0.5307027145f + (-0.7265760135f); q = q * t + 0.7107068705f; q = q * t + (-0.142248368f); q = q * t + 0.127414796f; q = q * t;
    const f32x2 s = (v * v) * (-0.72134752044f);
    f32x2 e; e.x = __builtin_amdgcn_exp2f(s.x); e.y = __builtin_amdgcn_exp2f(s.y);
    const f32x2 m = v * (q * e), r = v - m;
    f32x2 o; o.x = v.x < 0.f ? m.x : r.x; o.y = v.y < 0.f ? m.y : r.y; return o;
}

template <int ACT  > struct EpiBf16 {
    static constexpr bool PERM = true, AFTER_DRAIN = false; static_assert(ACT == 0 || ACT == 1, "EpiBf16: ACT is 0 (none) or 1 (gelu_pk)");
    bf16_t* O; int ldc; const float* bias; int split_cols; size_t split_stride; float scale0;
    __device__ __forceinline__ void operator()(const f32x4 (&acc)[2][2][4][2], const Unit& u, int wr, int wc, int fr, int fq) const {
        const int row0 = u.pm * BM + wr * 64 + fr; int colt = u.pn * BM; bf16_t* base = O;
        float sc = 1.f; if (split_cols) { const int t = colt / split_cols; base += (size_t)t * split_stride; colt -= t * split_cols; if (t == 0) sc = scale0; }
        const int col0 = colt + wc * 32 + 8 * fq, bcol0 = u.pn * BM + wc * 32 + 8 * fq;
        f32x4 bv[2][2];
#pragma unroll
        for (int bj = 0; bj < 2; ++bj)
#pragma unroll
            for (int n = 0; n < 2; ++n) bv[bj][n] = bias ? *(const f32x4*)(bias + bcol0 + bj * HALF + 4 * n) : (f32x4){0.f, 0.f, 0.f, 0.f};
#pragma unroll
        for (int ai = 0; ai < 2; ++ai)
#pragma unroll
            for (int m = 0; m < 4; ++m) { bf16_t* rowp = base + (size_t)(row0 + ai * HALF + m * 16) * ldc + col0;
#pragma unroll
                for (int bj = 0; bj < 2; ++bj) { f32x4 v0 = acc[ai][bj][m][0] + bv[bj][0], v1 = acc[ai][bj][m][1] + bv[bj][1];
                    if (ACT == 1) { f32x2 a = gelu_pk((f32x2){v0[0], v0[1]}), b = gelu_pk((f32x2){v0[2], v0[3]}), c = gelu_pk((f32x2){v1[0], v1[1]}), d = gelu_pk((f32x2){v1[2], v1[3]});
                        v0 = (f32x4){a.x, a.y, b.x, b.y}; v1 = (f32x4){c.x, c.y, d.x, d.y}; }
                    v0 = v0 * sc; v1 = v1 * sc; u32x4 w; w.x = cvt_pk_bf16(v0[0], v0[1]); w.y = cvt_pk_bf16(v0[2], v0[3]); w.z = cvt_pk_bf16(v1[0], v1[1]); w.w = cvt_pk_bf16(v1[2], v1[3]);
                    *(u32x4*)(rowp + bj * HALF) = w; } }
    }
};

typedef unsigned u32x2 __attribute__((ext_vector_type(2)));
struct EpiResF32 {
    static constexpr bool PERM = false, AFTER_DRAIN = false;
    const float* base; float* out; int ldc;
    __device__ __forceinline__ void operator()(const f32x4 (&acc)[2][2][4][2], const Unit& u, int wr, int wc, int fr, int fq) const {
        const int col0 = u.pn * BM + wc * 32 + 4 * fq;
#pragma unroll
        for (int ai = 0; ai < 2; ++ai)
#pragma unroll
            for (int m = 0; m < 4; ++m) { const size_t off = (size_t)(u.pm * BM + ai * HALF + wr * 64 + m * 16 + fr) * ldc + col0;
#pragma unroll
                for (int bj = 0; bj < 2; ++bj)
#pragma unroll
                    for (int n = 0; n < 2; ++n) { const f32x4 b = *(const f32x4*)(base + off + bj * HALF + n * 16); *(f32x4*)(out + off + bj * HALF + n * 16) = b + acc[ai][bj][m][n]; }
                asm volatile("" ::: "memory"); }
    }
};
struct EpiLora3 {
    static constexpr bool PERM = false, AFTER_DRAIN = false;
    const float* w0; const float* a0; float* dec; bf16_t* aic; bf16_t* gg;
    __device__ __forceinline__ void operator()(const f32x4 (&acc)[2][2][4][2], const Unit& u, int wr, int wc, int fr, int fq) const {
        const int br = u.pn >> 2; const int col0 = (u.pn & 3) * BM + wc * 32 + 4 * fq;
        const float* vec = (br == 0) ? w0 : (br == 1) ? a0 : nullptr; bf16_t* outh = (br == 1) ? aic : gg;
#pragma unroll
        for (int bj = 0; bj < 2; ++bj)
#pragma unroll
            for (int n = 0; n < 2; ++n) { const int col = col0 + bj * HALF + n * 16;
                f32x4 p = (f32x4){0.f, 0.f, 0.f, 0.f}; if (vec) p = *(const f32x4*)(vec + col);
#pragma unroll
                for (int ai = 0; ai < 2; ++ai)
#pragma unroll
                    for (int m = 0; m < 4; ++m) { const size_t off = (size_t)(u.pm * BM + ai * HALF + wr * 64 + m * 16 + fr) * 1024 + col;
                        const f32x4 z = acc[ai][bj][m][n] + p;
                        if (br == 0) *(f32x4*)(dec + off) = z;
                        else { u32x2 w; w.x = cvt_pk_bf16(z[0], z[1]); w.y = cvt_pk_bf16(z[2], z[3]); *(u32x2*)(outh + off) = w; } } }
    }
};
struct EpiResNorm {
    static constexpr bool PERM = false, AFTER_DRAIN = false;
    const float* base; float* out; bf16_t* hb; const float* g; float* ssq; int ldc;
    __device__ __forceinline__ void operator()(const f32x4 (&acc)[2][2][4][2], const Unit& u, int wr, int wc, int fr, int fq) const {
        const int col0 = u.pn * BM + wc * 32 + 4 * fq;
        f32x4 gv[2][2];
#pragma unroll
        for (int bj = 0; bj < 2; ++bj)
#pragma unroll
            for (int n = 0; n < 2; ++n) gv[bj][n] = *(const f32x4*)(g + col0 + bj * HALF + n * 16);
#pragma unroll
        for (int ai = 0; ai < 2; ++ai)
#pragma unroll
            for (int m = 0; m < 4; ++m) { const int row = u.pm * BM + ai * HALF + wr * 64 + m * 16 + fr; const size_t off = (size_t)row * ldc + col0; float sq = 0.f;
#pragma unroll
                for (int bj = 0; bj < 2; ++bj)
#pragma unroll
                    for (int n = 0; n < 2; ++n) { const f32x4 hv = *(const f32x4*)(base + off + bj * HALF + n * 16) + acc[ai][bj][m][n]; *(f32x4*)(out + off + bj * HALF + n * 16) = hv;
                        sq += (hv[0] * hv[0] + hv[1] * hv[1]) + (hv[2] * hv[2] + hv[3] * hv[3]);
                        const f32x4 hg = hv * gv[bj][n]; u32x2 w; w.x = cvt_pk_bf16(hg[0], hg[1]); w.y = cvt_pk_bf16(hg[2], hg[3]); *(u32x2*)(hb + off + bj * HALF + n * 16) = w; }
                sq += __shfl_xor(sq, 16); sq += __shfl_xor(sq, 32);
                if (fq == 0) ssq[(size_t)row * 32 + u.pn * 4 + wc] = sq;
                asm volatile("" ::: "memory"); }
    }
};
struct EpiBf16RowNorm {
    static constexpr bool PERM = true, AFTER_DRAIN = false;
    bf16_t* O; int ldc; const float* ssq; float inv_n, eps;
    __device__ __forceinline__ void operator()(const f32x4 (&acc)[2][2][4][2], const Unit& u, int wr, int wc, int fr, int fq) const {
        const int row0 = u.pm * BM + wr * 64 + fr, col0 = u.pn * BM + wc * 32 + 8 * fq;
#pragma unroll
        for (int ai = 0; ai < 2; ++ai)
#pragma unroll
            for (int m = 0; m < 4; ++m) { const int row = row0 + ai * HALF + m * 16; const f32x4 s0 = *(const f32x4*)(ssq + (size_t)row * 32 + fq * 8), s1 = *(const f32x4*)(ssq + (size_t)row * 32 + fq * 8 + 4); float ss = ((s0[0] + s0[1]) + (s0[2] + s0[3])) + ((s1[0] + s1[1]) + (s1[2] + s1[3]));
                ss += __shfl_xor(ss, 16); ss += __shfl_xor(ss, 32); const float rs = 1.0f / sqrtf(ss * inv_n + eps); bf16_t* rowp = O + (size_t)row * ldc + col0;
#pragma unroll
                for (int bj = 0; bj < 2; ++bj) { const f32x4 v0 = acc[ai][bj][m][0] * rs, v1 = acc[ai][bj][m][1] * rs;
                    u32x4 w; w.x = cvt_pk_bf16(v0[0], v0[1]); w.y = cvt_pk_bf16(v0[2], v0[3]); w.z = cvt_pk_bf16(v1[0], v1[1]); w.w = cvt_pk_bf16(v1[2], v1[3]);
                    *(u32x4*)(rowp + bj * HALF) = w; } }
    }
};
template <class Epi, class Sched, bool ALIGN_EPI = false, bool SP2 = false>
__device__ __forceinline__ void gemm_phase(PG8_LAS unsigned char* lds, const Gemm g, const Sched& S, const Epi& E, int tid_in) {
    int tid_ = tid_in; asm volatile("" : "+v"(tid_));
    const int tid = tid_, wid = __builtin_amdgcn_readfirstlane(tid >> 6), lane = tid & 63, wr = wid >> 2, wc = wid & 3, fr = lane & 15, fq = lane >> 4;
    const int K = g.K, nt = K / BK;
    unsigned voffA[2], voffB[2];
#pragma unroll
    for (int i = 0; i < 2; ++i) { int R, C; stage_rc(tid * 16 + i * 8192, R, C); const int Rb = Epi::PERM ? ((R & ~31) + perm32(R & 31)) : R;
        voffA[i] = (unsigned)(R * K + C) * 2u; voffB[i] = (unsigned)(Rb * K + C) * 2u; }
    const size_t kstep = (size_t)(BK * 2);
    const size_t hstep = (size_t)HALF * K * 2;
    const size_t tstep = 2 * hstep;
    const unsigned ldsw = (unsigned)wid * 1024u;
    const int aoff = lds_byte(wr * 64 + fr, fq * 8), boff = lds_byte(wc * 32 + fr, fq * 8);
#define PG8_SA(b, h) (((b) * 2 + (h)) * HTB)
#define PG8_SB(b, h) ((4 + (b) * 2 + (h)) * HTB)
#define PG8_STAGE(bufoff, gbase, voff) do { _Pragma("unroll") for (int _i = 0; _i < 2; ++_i) \
        __builtin_amdgcn_global_load_lds((const unsigned*)((const char*)(gbase) + (voff)[_i]), (PG8_LAS unsigned*)(lds + (bufoff) + ldsw + _i * 8192), 16, 0, 0); } while (0)
#define PG8_LDA(dst, b, h) do { _Pragma("unroll") for (int m = 0; m < 4; ++m) _Pragma("unroll") for (int k = 0; k < 2; ++k) dst[m][k] = *(const PG8_LAS bf16x8*)(lds + PG8_SA(b, h) + aoff + m * 2048 + k * 1024); } while (0)
#define PG8_LDB(dst, b, h) do { _Pragma("unroll") for (int n = 0; n < 2; ++n) _Pragma("unroll") for (int k = 0; k < 2; ++k) dst[n][k] = *(const PG8_LAS bf16x8*)(lds + PG8_SB(b, h) + boff + n * 2048 + k * 1024); } while (0)
#define PG8_MMA(ai, bj, At, Bt) do { __builtin_amdgcn_s_setprio(1); _Pragma("unroll") for (int m = 0; m < 4; ++m) _Pragma("unroll") for (int n = 0; n < 2; ++n) _Pragma("unroll") for (int k = 0; k < 2; ++k) \
        acc[ai][bj][m][n] = __builtin_amdgcn_mfma_f32_16x16x32_bf16(Bt[n][k], At[m][k], acc[ai][bj][m][n], 0, 0, 0); __builtin_amdgcn_s_setprio(0); } while (0)
#define PG8_WAIT_V(n) asm volatile("s_waitcnt vmcnt(" #n ")" ::: "memory")
#define PG8_WAIT_L(n) asm volatile("s_waitcnt lgkmcnt(" #n ")" ::: "memory")
#define PG8_BAR __builtin_amdgcn_s_barrier()
#define PG8_SCHED __builtin_amdgcn_sched_barrier(0)
    Unit cur, nxt; int ui = 0;
    if (!S.next(0, cur)) return;
    f32x4 acc[2][2][4][2];
#pragma unroll
    for (int a = 0; a < 2; ++a)
#pragma unroll
        for (int b = 0; b < 2; ++b)
#pragma unroll
            for (int m = 0; m < 4; ++m)
#pragma unroll
                for (int n = 0; n < 2; ++n) acc[a][b][m][n] = (f32x4){0.f, 0.f, 0.f, 0.f};
    bf16x8 At[4][2], B0[2][2], B1[2][2];
    const char* cA = (const char*)g.A + (size_t)cur.pm * tstep + (size_t)(cur.pn / g.adiv) * g.astride; const char* cB = (const char*)g.Bt + (size_t)cur.pn * tstep;
    S.a_ready(cur);
    if constexpr (SP2) {
        PG8_STAGE(PG8_SB(0, 0), cB, voffB); PG8_STAGE(PG8_SB(0, 1), cB + hstep, voffB); PG8_STAGE(PG8_SA(0, 0), cA, voffA); PG8_STAGE(PG8_SA(0, 1), cA + hstep, voffA);
        if (wr == 1) PG8_BAR;
        PG8_WAIT_V(2); PG8_BAR;
        PG8_STAGE(PG8_SB(1, 0), cB + kstep, voffB); PG8_STAGE(PG8_SA(1, 0), cA + kstep, voffA); PG8_STAGE(PG8_SB(1, 1), cB + hstep + kstep, voffB);
        PG8_WAIT_V(6); PG8_BAR;
    } else {
        PG8_STAGE(PG8_SB(0, 0), cB, voffB); PG8_STAGE(PG8_SA(0, 0), cA, voffA); PG8_STAGE(PG8_SB(0, 1), cB + hstep, voffB); PG8_STAGE(PG8_SA(0, 1), cA + hstep, voffA);
        if (wr == 1) PG8_BAR;
        PG8_WAIT_V(4); PG8_BAR;
        PG8_STAGE(PG8_SB(1, 0), cB + kstep, voffB); PG8_STAGE(PG8_SA(1, 0), cA + kstep, voffA); PG8_STAGE(PG8_SB(1, 1), cB + hstep + kstep, voffB);
        PG8_WAIT_V(6); PG8_BAR;
    }
    for (;;) {
        const bool has_next = S.next(ui + 1, nxt);
        const char* nA = has_next ? (const char*)g.A + (size_t)nxt.pm * tstep + (size_t)(nxt.pn / g.adiv) * g.astride : cA; const char* nB = has_next ? (const char*)g.Bt + (size_t)nxt.pn * tstep : cB;
        for (int t = 0; t < nt; t += 2) {
            const bool last = (t == nt - 2);
            const char* a1 = cA + (size_t)(t + 1) * kstep;
            const char* a2 = last ? nA : cA + (size_t)(t + 2) * kstep; const char* b2 = last ? nB : cB + (size_t)(t + 2) * kstep;
            const char* a3 = a2 + kstep; const char* b3 = b2 + kstep;
            if (last && has_next) S.a_ready(nxt);
            if constexpr (SP2) {
            PG8_LDB(B0, 0, 0); PG8_LDB(B1, 0, 1); PG8_SCHED; PG8_LDA(At, 0, 0); PG8_STAGE(PG8_SA(1, 1), a1 + hstep, voffA);
            PG8_WAIT_V(8); PG8_WAIT_L(0); PG8_BAR; PG8_MMA(0, 0, At, B0); PG8_MMA(0, 1, At, B1); PG8_BAR; PG8_SCHED;
            PG8_LDA(At, 0, 1); PG8_STAGE(PG8_SB(0, 0), b2, voffB); PG8_STAGE(PG8_SB(0, 1), b2 + hstep, voffB); PG8_STAGE(PG8_SA(0, 0), a2, voffA);
            PG8_WAIT_V(8); PG8_WAIT_L(0); PG8_BAR; PG8_MMA(1, 0, At, B0); PG8_MMA(1, 1, At, B1); PG8_BAR; PG8_SCHED;
            PG8_LDB(B0, 1, 0); PG8_LDB(B1, 1, 1); PG8_SCHED; PG8_LDA(At, 1, 0); PG8_STAGE(PG8_SA(0, 1), a2 + hstep, voffA);
            PG8_WAIT_V(8); PG8_WAIT_L(0); PG8_BAR; PG8_MMA(0, 0, At, B0); PG8_MMA(0, 1, At, B1); PG8_BAR; PG8_SCHED;
            PG8_LDA(At, 1, 1); PG8_STAGE(PG8_SB(1, 0), b3, voffB); PG8_STAGE(PG8_SB(1, 1), b3 + hstep, voffB); PG8_STAGE(PG8_SA(1, 0), a3, voffA);
            PG8_WAIT_V(8); PG8_WAIT_L(0); PG8_BAR; PG8_MMA(1, 0, At, B0); PG8_MMA(1, 1, At, B1); PG8_BAR; PG8_SCHED;
            } else {
            PG8_LDB(B0, 0, 0); PG8_SCHED; PG8_LDA(At, 0, 0); PG8_STAGE(PG8_SA(1, 1), a1 + hstep, voffA);
            PG8_WAIT_L(8); PG8_BAR; PG8_WAIT_L(0); PG8_MMA(0, 0, At, B0); PG8_BAR; PG8_SCHED;
            PG8_LDB(B1, 0, 1); PG8_STAGE(PG8_SB(0, 0), b2, voffB);
            PG8_BAR; PG8_WAIT_L(0); PG8_MMA(0, 1, At, B1); PG8_BAR;
            PG8_LDA(At, 0, 1); PG8_STAGE(PG8_SA(0, 0), a2, voffA);
            PG8_BAR; PG8_WAIT_L(0); PG8_MMA(1, 0, At, B0); PG8_BAR; PG8_SCHED;
            PG8_STAGE(PG8_SB(0, 1), b2 + hstep, voffB);
            PG8_WAIT_V(6); PG8_BAR; PG8_MMA(1, 1, At, B1); PG8_BAR;
            PG8_LDB(B0, 1, 0); PG8_SCHED; PG8_LDA(At, 1, 0); PG8_STAGE(PG8_SA(0, 1), a2 + hstep, voffA);
            PG8_WAIT_L(8); PG8_BAR; PG8_WAIT_L(0); PG8_MMA(0, 0, At, B0); PG8_BAR; PG8_SCHED;
            PG8_LDB(B1, 1, 1); PG8_STAGE(PG8_SB(1, 0), b3, voffB);
            PG8_BAR; PG8_WAIT_L(0); PG8_MMA(0, 1, At, B1); PG8_BAR;
            PG8_LDA(At, 1, 1); PG8_STAGE(PG8_SA(1, 0), a3, voffA);
            PG8_BAR; PG8_WAIT_L(0); PG8_MMA(1, 0, At, B0); PG8_BAR; PG8_SCHED;
            PG8_STAGE(PG8_SB(1, 1), b3 + hstep, voffB);
            PG8_WAIT_V(6); PG8_BAR; PG8_MMA(1, 1, At, B1); PG8_BAR;
            }
        }
        if constexpr (ALIGN_EPI) { if (wr == 0) PG8_BAR; }
        if constexpr (!Epi::AFTER_DRAIN) { E(acc, cur, wr, wc, fr, fq); S.done(cur); }
        if (!has_next) break;
#pragma unroll
        for (int a = 0; a < 2; ++a)
#pragma unroll
            for (int b = 0; b < 2; ++b)
#pragma unroll
                for (int m = 0; m < 4; ++m)
#pragma unroll
                    for (int n = 0; n < 2; ++n) acc[a][b][m][n] = (f32x4){0.f, 0.f, 0.f, 0.f};
        cur = nxt; cA = nA; cB = nB; ++ui;
        if constexpr (ALIGN_EPI) { if (wr == 1) PG8_BAR; }
    }
    PG8_WAIT_V(0);
    if constexpr (!ALIGN_EPI) { if (wr == 0) PG8_BAR; }
    PG8_BAR;
    if constexpr (Epi::AFTER_DRAIN) { E.fused(acc, cur, wr, wc, fr, fq, lds, wid, lane); S.done(cur); }
#undef PG8_SA
#undef PG8_SB
#undef PG8_STAGE
#undef PG8_LDA
#undef PG8_LDB
#undef PG8_MMA
#undef PG8_WAIT_V
#undef PG8_WAIT_L
#undef PG8_BAR
#undef PG8_SCHED
}
}

#ifndef PG8_SP2
#define PG8_SP2 true
#endif
#ifndef PG8_ALIGN
#define PG8_ALIGN true
#endif
#include <hip/hip_bf16.h>
#include <cmath>
namespace attn_body {
using bf16=__hip_bfloat16;
using bf16x8=__attribute__((ext_vector_type(8)))short;
using s16x4=__attribute__((ext_vector_type(4)))short;
using f32x16=__attribute__((ext_vector_type(16)))float;
using u32x4=__attribute__((ext_vector_type(4)))unsigned;
constexpr int BATCH=2,NHEAD=16,SEQ=8192,D=64,DM=6656,DMO=2048;
constexpr int NW=8,QBLK=32,QB=QBLK*NW,KVBLK=64,NQB=SEQ/QB;
constexpr int ATTN_UNIT_ROWS=QB;
__device__ __forceinline__ int crow(int r,int hi){return (r&3)+8*(r>>2)+4*hi;}
#define SBAR() __builtin_amdgcn_sched_barrier(0)
__device__ __forceinline__ void cmask(f32x16&p0,f32x16&p1,int jb,int qrel,int hi){
  const float NEG=-INFINITY; int kb=64*jb+4*hi;
  #pragma unroll
  for(int r=0;r<16;++r){int kv=kb+(r&3)+8*(r>>2); if(kv>qrel)p0[r]=NEG; if(kv+32>qrel)p1[r]=NEG;}
}

constexpr int NSLOT=3, SLOTB=8192;
constexpr int LDS_K=0, LDS_V=NSLOT*SLOTB, LDS_WS=2*NSLOT*SLOTB, LDS_OST=LDS_WS+NW*64*4, LDS_CK=LDS_OST+NW*4096, LDS_BYTES=LDS_CK+SEQ*4;
constexpr float C2=0.125f*1.4426950408889634f;
__device__ __forceinline__ void glds16(const void*gsrc,unsigned lds_dst){unsigned keep;
  asm volatile("s_mov_b32 %0, m0\n\ts_mov_b32 m0, %2\n\ts_nop 0\n\tglobal_load_lds_dwordx4 %1, off\n\ts_mov_b32 m0, %0":"=&s"(keep):"v"(gsrc),"s"(lds_dst):"memory");}
__device__ __forceinline__ void glds16s(const void*sbase,unsigned voff,unsigned lds_dst){unsigned keep;
  asm volatile("s_mov_b32 %0, m0\n\ts_mov_b32 m0, %3\n\ts_nop 0\n\tglobal_load_lds_dwordx4 %1, %2\n\ts_mov_b32 m0, %0":"=&s"(keep):"v"(voff),"s"(sbase),"s"(lds_dst):"memory");}
__device__ __forceinline__ float max3f(float a,float b,float c){float r;asm("v_max3_f32 %0, %1, %2, %3":"=v"(r):"v"(a),"v"(b),"v"(c));return r;}
__device__ __forceinline__ float max2f(float a,float b){float r;asm("v_max_f32_e32 %0, %1, %2":"=v"(r):"v"(a),"v"(b));return r;}
__device__ __forceinline__ float fadd_s(float a,float b){float r;asm("v_add_f32_e32 %0, %1, %2":"=v"(r):"v"(a),"v"(b));return r;}
__device__ __forceinline__ float fsub_s(float a,float b){float r;asm("v_sub_f32_e32 %0, %1, %2":"=v"(r):"v"(a),"v"(b));return r;}
typedef float f32x2_t __attribute__((ext_vector_type(2))); typedef __bf16 bf16x2_t __attribute__((ext_vector_type(2)));
__device__ __forceinline__ unsigned cvtpk_s(float lo,float hi){f32x2_t v={lo,hi};bf16x2_t b=__builtin_convertvector(v,bf16x2_t);return __builtin_bit_cast(unsigned,b);}
#define WAIT_BAR(N) asm volatile("s_waitcnt vmcnt(" #N ") lgkmcnt(0)\n\ts_barrier":::"memory")

__device__ __forceinline__ void qkt(f32x16&p0,f32x16&p1,const char*Kslot,const bf16x8*qr,int r32,int hi){
  const char*kb=Kslot+hi*1024+r32*16;
  #pragma unroll
  for(int d0=0;d0<4;++d0){
    const bf16x8 b0=*reinterpret_cast<const bf16x8*>(kb+d0*2048);
    const bf16x8 b1=*reinterpret_cast<const bf16x8*>(kb+d0*2048+512);
    p0=__builtin_amdgcn_mfma_f32_32x32x16_bf16(b0,qr[d0],p0,0,0,0);p1=__builtin_amdgcn_mfma_f32_32x32x16_bf16(b1,qr[d0],p1,0,0,0);}
}
typedef __attribute__((address_space(3))) const char* lds_cptr;
typedef short v4i16_t __attribute__((ext_vector_type(4)));
__device__ __forceinline__ void kload8(bf16x8*kf,lds_cptr kp){
  kf[0]=*(const __attribute__((address_space(3))) bf16x8*)(kp);      kf[1]=*(const __attribute__((address_space(3))) bf16x8*)(kp+512);
  kf[2]=*(const __attribute__((address_space(3))) bf16x8*)(kp+2048); kf[3]=*(const __attribute__((address_space(3))) bf16x8*)(kp+2560);
  kf[4]=*(const __attribute__((address_space(3))) bf16x8*)(kp+4096); kf[5]=*(const __attribute__((address_space(3))) bf16x8*)(kp+4608);
  kf[6]=*(const __attribute__((address_space(3))) bf16x8*)(kp+6144); kf[7]=*(const __attribute__((address_space(3))) bf16x8*)(kp+6656);
}
__device__ __forceinline__ void kload2(bf16x8*kf,lds_cptr kp,int j){ kf[2*j]=*(const __attribute__((address_space(3))) bf16x8*)(kp+j*2048); kf[2*j+1]=*(const __attribute__((address_space(3))) bf16x8*)(kp+j*2048+512); }
__device__ __forceinline__ s16x4 vtr(lds_cptr p){ return __builtin_bit_cast(s16x4,__builtin_amdgcn_ds_read_tr16_b64_v4i16((__attribute__((address_space(3))) v4i16_t*)p)); }
typedef float f32x4c __attribute__((ext_vector_type(4)));
__device__ __forceinline__ void ldck(f32x16&c0,f32x16&c1,lds_cptr ckt){
  #pragma unroll
  for(int g=0;g<4;++g){ const f32x4c a=*(const __attribute__((address_space(3))) f32x4c*)(ckt+32*g); const f32x4c b=*(const __attribute__((address_space(3))) f32x4c*)(ckt+128+32*g);
    c0[4*g]=a[0];c0[4*g+1]=a[1];c0[4*g+2]=a[2];c0[4*g+3]=a[3]; c1[4*g]=b[0];c1[4*g+1]=b[1];c1[4*g+2]=b[2];c1[4*g+3]=b[3]; }
}
__device__ __forceinline__ float rowmax(const f32x16&p0,const f32x16&p1){
  float a=max3f(p0[0],p0[1],p1[0]),b=max3f(p0[2],p0[3],p1[1]);a=max3f(a,p1[2],p1[3]);
  #pragma unroll
  for(int r=4;r<16;r+=4){a=max3f(a,p0[r],p0[r+1]);b=max3f(b,p0[r+2],p0[r+3]);a=max3f(a,p1[r],p1[r+1]);b=max3f(b,p1[r+2],p1[r+3]);}
  const float m=max2f(a,b);
  auto rr=__builtin_amdgcn_permlane32_swap(__float_as_uint(m),__float_as_uint(m),false,false);
  return max2f(__uint_as_float(rr[0]),__uint_as_float(rr[1]));
}
__device__ __forceinline__ void pv(f32x16*o,int vb,bf16x8 pa0,bf16x8 pa1,bf16x8 pa2,bf16x8 pa3){
  #pragma unroll
  for(int d0=0;d0<2;++d0){s16x4 lo[4],hi[4];
    #pragma unroll
    for(int ks=0;ks<4;++ks){
      asm volatile("ds_read_b64_tr_b16 %0,%1 offset:%c2":"=&v"(lo[ks]):"v"(vb),"i"(d0*4096+ks*1024):"memory");
      asm volatile("ds_read_b64_tr_b16 %0,%1 offset:%c2":"=&v"(hi[ks]):"v"(vb),"i"(d0*4096+ks*1024+512):"memory");}
    asm volatile("s_waitcnt lgkmcnt(0)":::"memory");SBAR();
    #define PK(k) (bf16x8){lo[k][0],lo[k][1],lo[k][2],lo[k][3],hi[k][0],hi[k][1],hi[k][2],hi[k][3]}
    o[d0]=__builtin_amdgcn_mfma_f32_32x32x16_bf16(pa0,PK(0),o[d0],0,0,0);
    o[d0]=__builtin_amdgcn_mfma_f32_32x32x16_bf16(pa1,PK(1),o[d0],0,0,0);
    o[d0]=__builtin_amdgcn_mfma_f32_32x32x16_bf16(pa2,PK(2),o[d0],0,0,0);
    o[d0]=__builtin_amdgcn_mfma_f32_32x32x16_bf16(pa3,PK(3),o[d0],0,0,0);
    #undef PK
  }
}

#ifndef ATTN_STORE16
#define ATTN_STORE16(p,v) (*(u32x4*)(p)=(v))
#endif
template<int THRL> __device__ __forceinline__ void attn_unit(int b,int h,int qb,const bf16*Q,const bf16*K,const bf16*V,bf16*O,const float*C2G,char*shm,int tid_in){
  int tid_=tid_in; asm volatile("":"+v"(tid_)); const int tid=tid_,lane=tid&63,r32=lane&31,hi=lane>>5; const int wid=__builtin_amdgcn_readfirstlane(tid>>6);
  const long rowbase=(long)b*SEQ; const int q0=qb*QB;
  const bf16*Qw=Q+(rowbase+q0+wid*QBLK)*DM+h*D;
  const bf16*Kh0=K+rowbase*DM+h*D,*Vh0=V+rowbase*DM+h*D;
  const unsigned lds0=(unsigned)(uintptr_t)shm;
  float*wsf=(float*)(shm+LDS_WS)+wid*64;
  const unsigned koff=(unsigned)(lane*DM+wid*8)*2u;
  const unsigned voff=(unsigned)((16*(wid&3)+(lane>>2))*DM+(wid>>2)*32+(lane&3)*8)*2u;
  const unsigned kdst=lds0+LDS_K+wid*1024, vdst=lds0+LDS_V+wid*1024;
  #define DMA_K(t,slot) glds16s(Kh+(long)(t)*KVBLK*DM,koff,(unsigned)__builtin_amdgcn_readfirstlane(kdst+(slot)))
  #define DMA_V(t,slot) glds16s(Vh+(long)(t)*KVBLK*DM,voff,(unsigned)__builtin_amdgcn_readfirstlane(vdst+(slot)))
  const int vb0=(int)(lds0+LDS_V)+((lane>>4)&1)*32+(lane&3)*8+(4*hi+((lane&15)>>2))*64;
  const char*Kbase=shm+LDS_K; bf16x8 kf[8];
  const lds_cptr shm3=(lds_cptr)shm; const lds_cptr kp0=shm3+LDS_K+hi*1024+r32*16; const lds_cptr vp0=shm3+LDS_V+((lane>>4)&1)*32+(lane&3)*8+(4*hi+((lane&15)>>2))*64;
  const int NT0=(q0+QB)/KVBLK;
  { const float*csrc=C2G+(long)(b*NHEAD+h)*SEQ; const int n4=(q0+QB)/4;
    for(int i4=tid;i4<n4;i4+=NW*64){ const f32x4c v=*(const f32x4c*)(csrc+4*i4); *(__attribute__((address_space(3))) f32x4c*)(shm3+LDS_CK+16*i4)=v; } }
  asm volatile("s_waitcnt vmcnt(0) lgkmcnt(0)\n\ts_barrier":::"memory");
  const float cq2=*(const __attribute__((address_space(3))) float*)(shm3+LDS_CK+4*(q0+wid*QBLK+r32));
  int t0;
  { const float thr=*(const __attribute__((address_space(3))) float*)(shm3+LDS_CK+4*q0)+164.0f; int lo=0,hi_=NT0-4;
    while(lo<hi_){ const int mid=(lo+hi_)>>1; if(*(const __attribute__((address_space(3))) float*)(shm3+LDS_CK+4*(64*mid+63))>thr)lo=mid+1; else hi_=mid; }
    t0=__builtin_amdgcn_readfirstlane(lo&~1); }
  const int NT=NT0-t0;
  const bf16*Kh=Kh0+(long)t0*KVBLK*DM,*Vh=Vh0+(long)t0*KVBLK*DM;
  const lds_cptr ckp0=shm3+LDS_CK+16*hi+256*t0;
  DMA_K(0,0);DMA_V(0,0);DMA_K(1,SLOTB);
  bf16x8 qr[4];
  #pragma unroll
  for(int d0=0;d0<4;++d0)qr[d0]=*reinterpret_cast<const bf16x8*>(&Qw[(long)r32*DM+d0*16+hi*8]);
  float l_reg=0.f;f32x16 o[2];o[0]=f32x16{};o[1]=f32x16{};
  const int qrel=wid*QBLK+r32;
  #define CMASK(P0,P1,t) do{int jb_=(t)-(NT-4); if(jb_>=0)cmask(P0,P1,jb_,qrel,hi);}while(0)
  #define CINIT(X) do{ _Pragma("unroll") for(int r=0;r<16;++r)X[r]=cq2-X[r]; }while(0)
  f32x16 pA0,pA1,pB0,pB1;
  int sl_prev=0,sl_cur=0,sl_next=SLOTB;
  #define ROT() do{sl_prev=sl_cur;sl_cur=sl_next;sl_next=(sl_next==(NSLOT-1)*SLOTB)?0:sl_next+SLOTB;}while(0)
  DMA_K(2,2*SLOTB);
  WAIT_BAR(3);
  ldck(pA0,pA1,ckp0); CINIT(pA0); CINIT(pA1);
  qkt(pA0,pA1,Kbase,qr,r32,hi);asm volatile("s_nop 15\n\ts_nop 7":"+v"(pA0),"+v"(pA1));CMASK(pA0,pA1,0);
  _Pragma("unroll") for(int r=0;r<16;++r){pA0[r]=__builtin_amdgcn_exp2f(pA0[r]);pA1[r]=__builtin_amdgcn_exp2f(pA1[r]);}
  ldck(pB0,pB1,ckp0+256);
  WAIT_BAR(0);
  DMA_K(3,0);DMA_V(1,SLOTB);
  ROT();
  kload8(kf,kp0+sl_cur);
  WAIT_BAR(2);
  s16x4 vlo[8],vhi[8]; u32x4 pw0,pw1,pw2,pw3;
  #define PKW(P,B) cvtpk_s(P[B],P[B+1])
  #define PAF(k) __builtin_bit_cast(bf16x8,pw##k)
  #define VFR(i) (bf16x8){vlo[i][0],vlo[i][1],vlo[i][2],vlo[i][3],vhi[i][0],vhi[i][1],vhi[i][2],vhi[i][3]}
  #define PIN(x) asm volatile("":"+v"(x))
  #define MX3(a,b,c) __builtin_fmaxf(__builtin_fmaxf((a),(b)),(c))
  #define GAPA(MF,A0,A1,A2,A3,W0,W1,PW) do{ MF; sacc+=A0; sacc+=A1; sacc+=A2; sacc+=A3; PIN(sacc); W0; W1; PIN(PW); SBAR(); }while(0)
  #define EX(v) __builtin_amdgcn_exp2f(v)
  #define GAPB(MF,X,B) do{ MF; X[B]=EX(X[B]); X[B+1]=EX(X[B+1]); X[B+2]=EX(X[B+2]); X[B+3]=EX(X[B+3]); PIN(X); SBAR(); }while(0)
  #define VRD(i) do{ vlo[i]=vtr(vp_+(((i)>>2)*4096+((i)&3)*1024)); vhi[i]=vtr(vp_+(((i)>>2)*4096+((i)&3)*1024+512)); }while(0)
  #define KRD(G,j) do{ if(G){ kload2(kf,kp0+sl_next,j); SBAR(); } }while(0)
  #define STEP(C0,C1,P0,P1,t,GK,GV,GL,GC) do{ SBAR(); \
    const lds_cptr vp_=vp0+sl_prev; \
    CINIT(C0); CINIT(C1); SBAR(); \
    VRD(0); SBAR(); float sacc=(P0[0]+P0[1]); \
    GAPA(C0=__builtin_amdgcn_mfma_f32_32x32x16_bf16(kf[0],qr[0],C0,0,0,0), P0[2],P0[3],P0[4],P0[5],     pw0[0]=PKW(P0,0), pw0[1]=PKW(P0,2), pw0); \
    VRD(4); SBAR(); GAPA(C1=__builtin_amdgcn_mfma_f32_32x32x16_bf16(kf[1],qr[0],C1,0,0,0), P0[6],P0[7],P0[8],P0[9],     pw0[2]=PKW(P0,4), pw0[3]=PKW(P0,6), pw0); \
    VRD(1); SBAR(); GAPA(C0=__builtin_amdgcn_mfma_f32_32x32x16_bf16(kf[2],qr[1],C0,0,0,0),   P0[10],P0[11],P0[12],P0[13], pw1[0]=PKW(P0,8), pw1[1]=PKW(P0,10), pw1); \
    VRD(5); SBAR(); GAPA(C1=__builtin_amdgcn_mfma_f32_32x32x16_bf16(kf[3],qr[1],C1,0,0,0),   P0[14],P0[15],P1[0],P1[1],   pw1[2]=PKW(P0,12),pw1[3]=PKW(P0,14), pw1); \
    VRD(2); SBAR(); GAPA(C0=__builtin_amdgcn_mfma_f32_32x32x16_bf16(kf[4],qr[2],C0,0,0,0),   P1[2],P1[3],P1[4],P1[5],     pw2[0]=PKW(P1,0), pw2[1]=PKW(P1,2), pw2); \
    VRD(6); SBAR(); GAPA(C1=__builtin_amdgcn_mfma_f32_32x32x16_bf16(kf[5],qr[2],C1,0,0,0),   P1[6],P1[7],P1[8],P1[9],     pw2[2]=PKW(P1,4), pw2[3]=PKW(P1,6), pw2); \
    VRD(3); SBAR(); GAPA(C0=__builtin_amdgcn_mfma_f32_32x32x16_bf16(kf[6],qr[3],C0,0,0,0),   P1[10],P1[11],P1[12],P1[13], pw3[0]=PKW(P1,8), pw3[1]=PKW(P1,10), pw3); \
    VRD(7); SBAR(); GAPA(C1=__builtin_amdgcn_mfma_f32_32x32x16_bf16(kf[7],qr[3],C1,0,0,0),   P1[14],P1[15],0.f,0.f,       pw3[2]=PKW(P1,12),pw3[3]=PKW(P1,14), pw3); \
    l_reg+=sacc; \
    if(GK){DMA_K((t)+3,sl_cur);} if(GV){DMA_V((t)+1,sl_next);} \
    CMASK(C0,C1,t); \
    SBAR(); \
    GAPB(o[0]=__builtin_amdgcn_mfma_f32_32x32x16_bf16(PAF(0),VFR(0),o[0],0,0,0), C0,0); \
    GAPB(o[1]=__builtin_amdgcn_mfma_f32_32x32x16_bf16(PAF(0),VFR(4),o[1],0,0,0), C0,4); \
    KRD(GL,0); GAPB(o[0]=__builtin_amdgcn_mfma_f32_32x32x16_bf16(PAF(1),VFR(1),o[0],0,0,0), C0,8); \
    KRD(GL,1); GAPB(o[1]=__builtin_amdgcn_mfma_f32_32x32x16_bf16(PAF(1),VFR(5),o[1],0,0,0), C0,12); \
    KRD(GL,2); GAPB(o[0]=__builtin_amdgcn_mfma_f32_32x32x16_bf16(PAF(2),VFR(2),o[0],0,0,0), C1,0); \
    KRD(GL,3); GAPB(o[1]=__builtin_amdgcn_mfma_f32_32x32x16_bf16(PAF(2),VFR(6),o[1],0,0,0), C1,4); \
    GAPB(o[0]=__builtin_amdgcn_mfma_f32_32x32x16_bf16(PAF(3),VFR(3),o[0],0,0,0), C1,8); \
    GAPB(o[1]=__builtin_amdgcn_mfma_f32_32x32x16_bf16(PAF(3),VFR(7),o[1],0,0,0), C1,12); \
    if(GC){ ldck(P0,P1,ckp0+((t)+1)*256); } \
    }while(0)
  int t=1;
  #undef CMASK
  #define CMASK(P0,P1,t) do{}while(0)
  for(;t+5<NT;t+=2){
    STEP(pB0,pB1,pA0,pA1,t,true,true,true,true);     WAIT_BAR(2); ROT();
    STEP(pA0,pA1,pB0,pB1,t+1,true,true,true,true);   WAIT_BAR(2); ROT();
  }
  #undef CMASK
  #define CMASK(P0,P1,t) do{int jb_=(t)-(NT-4); if(jb_>=0)cmask(P0,P1,jb_,qrel,hi);}while(0)
  #define ENDW(tt) do{ if((tt)+3<NT){WAIT_BAR(2);} else if((tt)+2<NT){WAIT_BAR(1);} else {WAIT_BAR(0);} }while(0)
  for(;t+1<NT;t+=2){
    STEP(pB0,pB1,pA0,pA1,t,(t+3<NT),(t+1<NT),(t+1<NT),(t+1<NT));       ENDW(t);   ROT();
    STEP(pA0,pA1,pB0,pB1,t+1,(t+4<NT),(t+2<NT),(t+2<NT),(t+2<NT));     ENDW(t+1); ROT();
  }
  STEP(pB0,pB1,pA0,pA1,NT-1,false,false,false,false);
  { float sacc=pB0[0]+pB0[1]; _Pragma("unroll") for(int r=2;r<16;++r)sacc+=pB0[r]; _Pragma("unroll") for(int r=0;r<16;++r)sacc+=pB1[r]; l_reg+=sacc;
    pw0=(u32x4){PKW(pB0,0),PKW(pB0,2),PKW(pB0,4),PKW(pB0,6)};pw1=(u32x4){PKW(pB0,8),PKW(pB0,10),PKW(pB0,12),PKW(pB0,14)};pw2=(u32x4){PKW(pB1,0),PKW(pB1,2),PKW(pB1,4),PKW(pB1,6)};pw3=(u32x4){PKW(pB1,8),PKW(pB1,10),PKW(pB1,12),PKW(pB1,14)};
    SBAR(); pv(o,vb0+sl_cur,PAF(0),PAF(1),PAF(2),PAF(3)); }
  #undef PKW
  #undef PAF
  #undef VFR
  #undef PIN
  #undef MX3
  #undef GAPA
  #undef GAPB
  #undef EX
  #undef VRD
  #undef KRD
  #undef STEP
  #undef ENDW
  {auto rr=__builtin_amdgcn_permlane32_swap(__float_as_uint(l_reg),__float_as_uint(l_reg),false,false);l_reg=__uint_as_float(rr[0])+__uint_as_float(rr[1]);}
  if(hi==0)wsf[32+r32]=l_reg;asm volatile("s_waitcnt lgkmcnt(0)":::"memory");
  float rli[16];
  #pragma unroll
  for(int r=0;r<16;++r)rli[r]=__builtin_amdgcn_rcpf(wsf[32+crow(r,hi)]);
  bf16*Ow=O+(rowbase+q0+wid*QBLK)*DMO+h*D;
  { bf16*stg=(bf16*)(shm+LDS_OST)+wid*2048;
    #pragma unroll
    for(int r=0;r<16;++r){const int orow=crow(r,hi);
      #pragma unroll
      for(int d0=0;d0<2;++d0)stg[orow*64+d0*32+r32]=__float2bfloat16(o[d0][r]*rli[r]);}
    asm volatile("s_waitcnt lgkmcnt(0)":::"memory");
    #pragma unroll
    for(int i=0;i<4;++i){const int row=i*8+(lane>>3),ch=lane&7; const u32x4 v=*(const u32x4*)(stg+row*64+ch*8); ATTN_STORE16(Ow+(long)row*DMO+ch*8,v);} }
  asm volatile("s_waitcnt lgkmcnt(0)\n\ts_barrier":::"memory");
  #undef DMA_K
  #undef DMA_V
  #undef CMASK
  #undef CINIT
  #undef ROT
}
constexpr int ATTN_LDS_BYTES=LDS_BYTES;
struct AttnTensors { const bf16* Q; const bf16* K; const bf16* V; bf16* O; const float* C2G; };
struct AttnUnit { int bh; int qb; };
struct StaticOrder {
  int vcu;
  __device__ __forceinline__ explicit StaticOrder(int grid,int block):vcu((block%8)*(grid/8)+block/8){}
  __device__ __forceinline__ bool next(int i,AttnUnit&u)const{ if(i>=4)return false; const int s=vcu&7; u.bh=vcu>>3; u.qb=(i==0)?s:(i==1)?15-s:(i==2)?16+s:31-s; return true; }
  __device__ __forceinline__ void a_ready(const AttnUnit&)const{}
  __device__ __forceinline__ void done(const AttnUnit&)const{}
};
template<class Sched,int THRL=8> __device__ __forceinline__ void attn_phase(char*lds,const AttnTensors&T,const Sched&S,int tid_in){
  AttnUnit u;
  for(int i=0;S.next(i,u);++i){ S.a_ready(u); attn_unit<THRL>(u.bh/NHEAD,u.bh%NHEAD,u.qb,T.Q,T.K,T.V,T.O,T.C2G,lds,tid_in); S.done(u); }
}
#undef SBAR
#undef WAIT_BAR
}
constexpr int NWAVES = 8;
constexpr int SEQ = 8192, NB = 2, M = NB * SEQ, DMODEL = 2048;
constexpr int PJ = 6656;
constexpr int NIN = 6416;
constexpr int C_R = 0, C_K = 1024, C_V = 2048, C_WD = 3072, C_AD = 3136, C_GD = 3200;
constexpr int C_FQ = 3328, C_FK = 4352, C_FV = 5376, C_FF = 6400;
constexpr int NEXP = 16384;
constexpr float C2Q = 0.125f * 1.4426950408889634f;
constexpr float LOG2E = 1.4426950408889634f;

constexpr size_t MiB = 1u << 20;
constexpr size_t WS_CTL = 0, CTL_ZERO_BYTES = 1 * MiB;
constexpr size_t WS_SSQ = 42 * MiB;
constexpr size_t WS_WQT = 1 * MiB;
constexpr size_t WS_LWT = 5 * MiB;
constexpr size_t WS_C2 = 6 * MiB;
constexpr size_t WS_BON = 7 * MiB;
constexpr size_t WS_WOT = 8 * MiB;
constexpr size_t WS_WINT = 16 * MiB;
constexpr size_t WS_LA = 42 * MiB;
constexpr size_t WS_XN = 64 * MiB;
constexpr size_t WS_PROJ = 128 * MiB;
constexpr size_t WS_MIXED = 336 * MiB;
constexpr size_t WS_KP = 400 * MiB, WS_AV = 432 * MiB, WS_BV = 464 * MiB;
constexpr size_t WS_END = 497 * MiB;
constexpr size_t WS_GATE = 128 * MiB;
constexpr size_t WS_IDX = 136 * MiB;
constexpr size_t WS_QP = 140 * MiB;
constexpr size_t WS_U8 = 464 * MiB, WS_V8 = 480 * MiB;
constexpr size_t WS_USC = 496 * MiB, WS_VSC = 496 * MiB + 65536;
constexpr size_t OUT_DEC = 0, OUT_G = 64 * MiB, OUT_AIC = 96 * MiB;
constexpr int CW_TMO = 0, CW_BAR = 4096, CW_QUEUE = 16384, CW_QU = 32768, CW_QV = 36864;
constexpr size_t WS_W = 238 * MiB;

constexpr int RING_OFF = 0, RING_BYTES = 131072;
constexpr int LDSCTL_OFF = RING_BYTES, MISC_OFF = LDSCTL_OFF + 320;
constexpr int LDS_BYTES = 147456;

#define GAS __attribute__((address_space(1)))
#define LAS __attribute__((address_space(3)))
typedef unsigned short bf16;
typedef unsigned v4u __attribute__((ext_vector_type(4)));
typedef float f32x4 __attribute__((ext_vector_type(4)));
typedef short bf16x8 __attribute__((ext_vector_type(8)));
typedef GAS unsigned gu32;
typedef GAS unsigned long long gu64;
#define RLX_AGENT __ATOMIC_RELAXED, __HIP_MEMORY_SCOPE_AGENT
#define LDS_WAIT() asm volatile("s_waitcnt lgkmcnt(0)" ::: "memory")
#define VM_WAIT() asm volatile("s_waitcnt vmcnt(0)" ::: "memory")
__device__ __forceinline__ unsigned long long rt() { return __builtin_amdgcn_s_memrealtime(); }
__device__ __forceinline__ unsigned f2bf(float f) { unsigned u = __builtin_bit_cast(unsigned, f); return (u + 0x7fffu + ((u >> 16) & 1u)) >> 16; }
__device__ __forceinline__ unsigned pk2(float lo, float hi) { return f2bf(lo) | (f2bf(hi) << 16); }

#define XB_TMO      128
#define XB_XCNT(j)  (256  + 64 * (j))
#define XB_XSUB(j)  (1280 + 64 * (j))
#define XB_XGEN(j)  (2304 + 64 * (j))
#define XB_TOP      3328
#define XB_TOPGEN   3392
#define XCD_BAR_WORDS 3456
#define XB_SPIN_CAP (1u << 18)

__device__ __forceinline__ unsigned xb_ld(unsigned* p)              { return __hip_atomic_load(p, __ATOMIC_RELAXED, __HIP_MEMORY_SCOPE_AGENT); }
__device__ __forceinline__ unsigned xb_add(unsigned* p, unsigned v) { return __hip_atomic_fetch_add(p, v, __ATOMIC_RELAXED, __HIP_MEMORY_SCOPE_AGENT); }
__device__ __forceinline__ unsigned xb_xcc_id() { return (unsigned)__builtin_amdgcn_s_getreg((3 << 11) | 20) & 0xFu; }
#define XB_SPIN(cond, bar) do { unsigned _sp = 0; while (cond) { __builtin_amdgcn_s_sleep(1); \
    if ((++_sp & 255u) == 0u) { if (xb_ld(&(bar)[XB_TMO])) break; if (_sp > XB_SPIN_CAP) { atomicAdd(&(bar)[XB_TMO], 1u); break; } } } } while (0)

struct XcdBarrier {
    unsigned* bar; unsigned x;
    volatile LAS unsigned* st;
};

__device__ __forceinline__ XcdBarrier xcd_barrier_post(unsigned* bar, volatile LAS unsigned* st, int tid) {
    XcdBarrier b; b.bar = bar; b.x = xb_xcc_id(); b.st = st;
    if (tid == 0) (void)xb_add(&bar[XB_XCNT(b.x)], 1u);
    return b;
}
__device__ __forceinline__ void xcd_barrier_complete(unsigned* bar, unsigned x, unsigned& nloc, unsigned& nx) {
    const unsigned G = gridDim.x * gridDim.y * gridDim.z;
    unsigned sum, cnt, mine, sp = 0u;
    for (;;) {
        sum = 0u; cnt = 0u; mine = 0u;
#pragma unroll
        for (unsigned j = 0; j < 16; ++j) { const unsigned c = xb_ld(&bar[XB_XCNT(j)]); sum += c; cnt += (c > 0u) ? 1u : 0u; mine = (j == x) ? c : mine; }
        if (sum == G) break;
        __builtin_amdgcn_s_sleep(1);
        if ((++sp & 255u) == 0u) { if (xb_ld(&bar[XB_TMO])) break; if (sp > XB_SPIN_CAP) { atomicAdd(&bar[XB_TMO], 1u); break; } }
    }
    nloc = mine > 0u ? mine : 1u; nx = cnt > 0u ? cnt : 1u;
}

__device__ __forceinline__ void xcd_barrier(const XcdBarrier& b, int tid) {
    asm volatile("s_waitcnt vmcnt(0)" ::: "memory");
    __syncthreads();
    if (tid == 0) {
        unsigned* bar = b.bar;
        __builtin_amdgcn_s_waitcnt(0);
        unsigned nloc = b.st[0], nx = b.st[1];
        if (nloc == 0u) { xcd_barrier_complete(bar, b.x, nloc, nx); b.st[0] = nloc; b.st[1] = nx; }
        const unsigned old = xb_add(&bar[XB_XSUB(b.x)], 1u);
        const unsigned gen = old / nloc;
        if (old + 1u == (gen + 1u) * nloc) {
            __builtin_amdgcn_fence(__ATOMIC_RELEASE, "agent");
            asm volatile("s_waitcnt vmcnt(0)" ::: "memory");
            const unsigned og = xb_add(&bar[XB_TOP], 1u);
            const unsigned tg = og / nx;
            if (og + 1u == (tg + 1u) * nx) xb_add(&bar[XB_TOPGEN], 1u);
            else XB_SPIN(xb_ld(&bar[XB_TOPGEN]) == tg, bar);
            __builtin_amdgcn_fence(__ATOMIC_ACQUIRE, "agent");
            xb_add(&bar[XB_XGEN(b.x)], 1u);
            asm volatile("s_waitcnt vmcnt(0)" ::: "memory");
        } else {
            XB_SPIN(xb_ld(&bar[XB_XGEN(b.x)]) == gen, bar);
            __builtin_amdgcn_fence(__ATOMIC_ACQUIRE, "agent");
            asm volatile("s_waitcnt vmcnt(0)" ::: "memory");
        }
    }
    __syncthreads();
}


struct Frame {
    LAS unsigned char* lds;
    volatile LAS unsigned* MISC;
    gu32* ctl;
    int tid, lane, wave, vcu, G;
};
__device__ __forceinline__ float wave_sum(float v) {
#pragma unroll
    for (int o = 1; o < 64; o <<= 1) v += __shfl_xor(v, o);
    return v;
}
__device__ __forceinline__ float wave_max(float v) {
#pragma unroll
    for (int o = 1; o < 64; o <<= 1) v = fmaxf(v, __shfl_xor(v, o));
    return v;
}
__device__ __forceinline__ float bflo(unsigned u) { return __uint_as_float(u << 16); }
__device__ __forceinline__ float bfhi(unsigned u) { return __uint_as_float(u & 0xffff0000u); }
__device__ __forceinline__ float bf1(const bf16* p) { return __uint_as_float((unsigned)(*p) << 16); }
__device__ __forceinline__ void ld16bf(const bf16* p, float (&x)[16]) {
    const v4u a = *(const v4u*)p, b = *(const v4u*)(p + 8);
    x[0] = bflo(a.x); x[1] = bfhi(a.x); x[2] = bflo(a.y); x[3] = bfhi(a.y); x[4] = bflo(a.z); x[5] = bfhi(a.z); x[6] = bflo(a.w); x[7] = bfhi(a.w);
    x[8] = bflo(b.x); x[9] = bfhi(b.x); x[10] = bflo(b.y); x[11] = bfhi(b.y); x[12] = bflo(b.z); x[13] = bfhi(b.z); x[14] = bflo(b.w); x[15] = bfhi(b.w);
}
__device__ __forceinline__ void st16bf(bf16* p, const float (&x)[16]) {
    v4u a, b;
    a.x = pk2(x[0], x[1]); a.y = pk2(x[2], x[3]); a.z = pk2(x[4], x[5]); a.w = pk2(x[6], x[7]);
    b.x = pk2(x[8], x[9]); b.y = pk2(x[10], x[11]); b.z = pk2(x[12], x[13]); b.w = pk2(x[14], x[15]);
    *(v4u*)p = a; *(v4u*)(p + 8) = b;
}
__device__ __forceinline__ void ld16f(const float* p, float (&x)[16]) {
#pragma unroll
    for (int j = 0; j < 4; ++j) { const f32x4 v = *(const f32x4*)(p + 4 * j); x[4 * j] = v.x; x[4 * j + 1] = v.y; x[4 * j + 2] = v.z; x[4 * j + 3] = v.w; }
}
__device__ __forceinline__ void shift16(const bf16* row, bool has_prev, int col, const float* mu, float (&x)[16]) {
    float p[16], q[16], m[16];
    ld16bf(row + col, p); ld16f(mu + col, m);
    if (has_prev) ld16bf(row - PJ + col, q); else {
#pragma unroll
        for (int i = 0; i < 16; ++i) q[i] = 0.f; }
#pragma unroll
    for (int i = 0; i < 16; ++i) x[i] = p[i] + m[i] * (q[i] - p[i]);
}

__device__ __forceinline__ void p0_transpose_item(const float* W, int Ks, int Ns, bf16* WT, int Kd, LAS float* scr, int kb, int nb, int lane) {
    const int k0 = 64 * kb, n0 = 32 * nb;
    float wv_[32];
#pragma unroll
    for (int i = 0; i < 32; ++i) { const int kk = 2 * i + (lane >> 5), k = k0 + kk, n = n0 + (lane & 31); wv_[i] = (k < Ks && n < Ns) ? W[(size_t)k * Ns + n] : 0.f; }
#pragma unroll
    for (int i = 0; i < 32; ++i) { const int kk = 2 * i + (lane >> 5); scr[kk * 33 + (lane & 31)] = wv_[i]; }
    LDS_WAIT(); asm volatile("" ::: "memory");
    const int c = lane & 7;
#pragma unroll
    for (int j = 0; j < 4; ++j) { const int n = (lane >> 3) + 8 * j; const LAS float* s = scr + (8 * c) * 33 + n;
        v4u o; o.x = pk2(s[0 * 33], s[1 * 33]); o.y = pk2(s[2 * 33], s[3 * 33]); o.z = pk2(s[4 * 33], s[5 * 33]); o.w = pk2(s[6 * 33], s[7 * 33]);
        *(GAS v4u*)(WT + (size_t)(n0 + n) * Kd + k0 + 8 * c) = o; }
    LDS_WAIT(); asm volatile("" ::: "memory");
}
__device__ __forceinline__ void p0_transpose_block(const float* W, int Ks, int Ns, bf16* WT, int Kd, LAS float* scr, int kb, int nb, int tid) {
    const int k0 = 64 * kb, n0 = 256 * nb, r8 = tid >> 6, c = tid & 63, lane = tid & 63, w = tid >> 6;
    f32x4 v[8];
#pragma unroll
    for (int i = 0; i < 8; ++i) { const int k = k0 + r8 + 8 * i, n = n0 + 4 * c; v[i] = (k < Ks && n < Ns) ? *(const f32x4*)(W + (size_t)k * Ns + n) : (f32x4){0.f, 0.f, 0.f, 0.f}; }
#pragma unroll
    for (int i = 0; i < 8; ++i) { LAS float* d = scr + (r8 + 8 * i) * 257 + 4 * c; d[0] = v[i].x; d[1] = v[i].y; d[2] = v[i].z; d[3] = v[i].w; }
    __syncthreads();
    const int nl = lane >> 3, c8 = lane & 7;
#pragma unroll
    for (int jj = 0; jj < 4; ++jj) { const int n = 8 * (w * 4 + jj) + nl; const LAS float* s = scr + (8 * c8) * 257 + n;
        v4u o; o.x = pk2(s[0 * 257], s[1 * 257]); o.y = pk2(s[2 * 257], s[3 * 257]); o.z = pk2(s[4 * 257], s[5 * 257]); o.w = pk2(s[6 * 257], s[7 * 257]);
        *(GAS v4u*)(WT + (size_t)(n0 + n) * Kd + k0 + 8 * c8) = o; }
    __syncthreads();
}
struct Row8 { f32x4 v[8]; };
__device__ __forceinline__ void ld_row8(const float* src, int lane, Row8& R) {
    const GAS f32x4* xr = (const GAS f32x4*)src + lane;
#pragma unroll
    for (int j = 0; j < 8; ++j) R.v[j] = xr[64 * j];
}
__device__ __forceinline__ void rms_finish(const Row8& R, const float* g, bf16* orow, int lane) {
    const GAS f32x4* gr = (const GAS f32x4*)g + lane; float s = 0.f;
#pragma unroll
    for (int j = 0; j < 8; ++j) s += (R.v[j].x * R.v[j].x + R.v[j].y * R.v[j].y) + (R.v[j].z * R.v[j].z + R.v[j].w * R.v[j].w);
    const float rs = 1.0f / sqrtf(wave_sum(s) * (1.f / DMODEL) + 1e-6f);
    GAS unsigned long long* o8 = (GAS unsigned long long*)orow + lane;
#pragma unroll
    for (int j = 0; j < 8; ++j) { const f32x4 gg = gr[64 * j];
        o8[64 * j] = (unsigned long long)pk2(R.v[j].x * rs * gg.x, R.v[j].y * rs * gg.y) | ((unsigned long long)pk2(R.v[j].z * rs * gg.z, R.v[j].w * rs * gg.w) << 32); }
}
struct Ptrs {
    const float *x, *norm1_g, *w_in, *mu, *w_decay_up, *w0, *w_iclr_up, *a0, *w_gate_up, *k_k, *k_a, *r_k, *lnx_g, *lnx_b, *fox_b_f, *q_norm_g, *k_norm_g, *w_out, *norm2_g, *w_q, *sub_keys, *peer_u, *peer_v;
    float* out;
    bf16 *WQT, *LWT, *WOT, *WINT, *LA, *XN, *PROJ, *MIXED, *KP, *AV, *BV, *QP, *G, *AIC;
    float *C2, *BON, *Y, *DEC, *GATE, *USC, *VSC, *SSQ;
    unsigned short* IDX; unsigned char *U8, *V8;
};
__device__ __forceinline__ void prepA_token(const Ptrs& P, int m, int lane) {
    bf16* row = P.PROJ + (size_t)m * PJ;
    const bool has_prev = (m % SEQ) != 0;
#pragma unroll
    for (int which = 0; which < 2; ++which) {
        bf16* p = row + (which == 0 ? C_FQ : C_FK) + lane * 16;
        float x[16], g[16]; ld16bf(p, x); ld16f((which == 0 ? P.q_norm_g : P.k_norm_g) + (lane & 3) * 16, g);
        float ss = 0.f;
#pragma unroll
        for (int i = 0; i < 16; ++i) ss += x[i] * x[i];
        ss += __shfl_xor(ss, 1); ss += __shfl_xor(ss, 2);
        const float rs = (1.0f / sqrtf(ss * (1.f / 64.f) + 1e-6f)) * (which == 0 ? C2Q : 1.f);
#pragma unroll
        for (int i = 0; i < 16; ++i) x[i] = x[i] * rs * g[i];
        st16bf(p, x);
    }
    {
        const bf16* prow = row - PJ;
        auto sh = [&](int col) -> float { const float p = bf1(row + col); const float q = has_prev ? bf1(prow + col) : 0.f; return p + P.mu[col] * (q - p); };
        bf16* la0 = P.LA + (size_t)m * 128; bf16* la1 = P.LA + (size_t)M * 128 + (size_t)m * 128; bf16* la2 = P.LA + (size_t)2 * M * 128 + (size_t)m * 128;
        const float wd = sh(C_WD + lane), ad = sh(C_AD + lane), g0 = sh(C_GD + lane), g1 = sh(C_GD + 64 + lane);
        la0[lane] = (bf16)f2bf(tanhf(wd)); la0[64 + lane] = 0;
        la1[lane] = (bf16)f2bf(ad); la1[64 + lane] = 0;
        la2[lane] = (bf16)f2bf(1.0f / (1.0f + __expf(-g0))); la2[64 + lane] = (bf16)f2bf(1.0f / (1.0f + __expf(-g1)));
    }
}
__device__ __forceinline__ void fox_cumsum(const Ptrs& P, int bh, LAS float* scr, int tid) {
    const int b = bh >> 4, h = bh & 15; const float bf_ = P.fox_b_f[h];
    const bf16* src = P.PROJ + (size_t)(b * SEQ + tid * 16) * PJ + C_FF + h;
    float v[16]; float run = 0.f;
#pragma unroll
    for (int i = 0; i < 16; ++i) { const float x = bf1(src + (size_t)i * PJ) + bf_;
        const float ls = (x >= 0.f) ? -log1pf(__expf(-x)) : (x - log1pf(__expf(x))); run += ls; v[i] = run; }
    float inc = run; const int lane = tid & 63, w = tid >> 6;
#pragma unroll
    for (int o = 1; o < 64; o <<= 1) { const float t = __shfl_up(inc, o); if (lane >= o) inc += t; }
    if (lane == 63) scr[w] = inc;
    __syncthreads();
    float off = inc - run;
    for (int j = 0; j < w; ++j) off += scr[j];
    float* dst = P.C2 + (size_t)bh * SEQ + tid * 16;
#pragma unroll
    for (int i = 0; i < 16; i += 4) *(f32x4*)(dst + i) = (f32x4){(off + v[i]) * LOG2E, (off + v[i + 1]) * LOG2E, (off + v[i + 2]) * LOG2E, (off + v[i + 3]) * LOG2E};
    __syncthreads();
}

#define DPP_ADD(x, ctrl) ((x) + __uint_as_float((unsigned)__builtin_amdgcn_update_dpp(0, (int)__float_as_uint(x), (ctrl), 0xf, 0xf, true)))
__device__ __forceinline__ float row16_sum(float x) {
    x = DPP_ADD(x, 0xB1);
    x = DPP_ADD(x, 0x4E);
    x = DPP_ADD(x, 0x141);
    x = DPP_ADD(x, 0x140);
    return x;
}
__device__ __forceinline__ void post_token(const Ptrs& P, int m, int lane) {
    const bf16* row = P.PROJ + (size_t)m * PJ;
    const bool has_prev = (m % SEQ) != 0;
    const int c = lane * 16, h = lane >> 2;
    float y[16], vs[16], g[16], lg[16], lb[16];
    ld16f(P.Y + (size_t)m * 1024 + c, y);
    float s = 0.f;
#pragma unroll
    for (int i = 0; i < 16; ++i) s += y[i];
    s += __shfl_xor(s, 1); s += __shfl_xor(s, 2);
    const float mean = s * (1.f / 64.f);
    float q = 0.f;
#pragma unroll
    for (int i = 0; i < 16; ++i) { y[i] -= mean; q += y[i] * y[i]; }
    q += __shfl_xor(q, 1); q += __shfl_xor(q, 2);
    const float rstd = 1.0f / sqrtf(q * (1.f / 64.f) + 64e-5f);
    shift16(row, has_prev, C_V + c, P.mu, vs);
    ld16bf(P.G + (size_t)m * 1024 + c, g); ld16f(P.lnx_g + c, lg); ld16f(P.lnx_b + c, lb);
    const float bon = P.BON[(size_t)m * 16 + h];
#pragma unroll
    for (int i = 0; i < 16; ++i) y[i] = (y[i] * rstd * lg[i] + lb[i] + bon * vs[i]) * g[i];
    st16bf(P.MIXED + (size_t)m * 2048 + c, y);
}
typedef float v16f __attribute__((ext_vector_type(16)));
typedef float v32f __attribute__((ext_vector_type(32)));
typedef unsigned v6u __attribute__((ext_vector_type(6)));
constexpr int ROW6 = 1024;
__device__ __forceinline__ void fp4_finish(const Row8& R, unsigned char* dst, float* mult, int lane) {
    const f32x4 (&v)[8] = R.v; float am = 0.f;
#pragma unroll
    for (int j = 0; j < 8; ++j) am = fmaxf(am, fmaxf(fmaxf(fabsf(v[j].x), fabsf(v[j].y)), fmaxf(fabsf(v[j].z), fabsf(v[j].w))));
    am = wave_max(am);
    const float sc = am > 0.f ? 6.0f / am : 1.0f;
    unsigned w[4];
#pragma unroll
    for (int d = 0; d < 4; ++d) { unsigned x = 0u;
        x = __builtin_amdgcn_cvt_scalef32_pk_fp4_f32(x, v[2 * d].x * sc, v[2 * d].y * sc, 1.0f, 0); x = __builtin_amdgcn_cvt_scalef32_pk_fp4_f32(x, v[2 * d].z * sc, v[2 * d].w * sc, 1.0f, 1);
        x = __builtin_amdgcn_cvt_scalef32_pk_fp4_f32(x, v[2 * d + 1].x * sc, v[2 * d + 1].y * sc, 1.0f, 2); x = __builtin_amdgcn_cvt_scalef32_pk_fp4_f32(x, v[2 * d + 1].z * sc, v[2 * d + 1].w * sc, 1.0f, 3);
        w[d] = x; }
    *(GAS v4u*)(dst + lane * 16) = (v4u){w[0], w[1], w[2], w[3]};
    if (lane == 0) *mult = am > 0.f ? am * (1.0f / 6.0f) : 1.0f;
}
namespace rk {
typedef float f32x16 __attribute__((ext_vector_type(16)));
constexpr int CS = 144;
constexpr int FS = 272;
constexpr int L_AT = 0, L_RT = 9216, L_BT = 18432, L_KT = 27648, L_PF = 18432, L_VT = 36864, L_BH = 46080, L_M1 = 55296, L_KH = 64512, L_Q1 = 55296,
              L_M3 = 73728, L_M4 = 82944, L_M2 = 92160, L_GL = 109568, L_WT = 109824, L_QF = 111872, L_M2B = 111872, L_PI = 121088, L_RTW = 36864, L_END = 129280;
__device__ __forceinline__ int crow(int r, int hi) { return (r & 3) + 8 * (r >> 2) + 4 * hi; }
typedef float f32x2c __attribute__((ext_vector_type(2))); typedef __bf16 bf16x2c __attribute__((ext_vector_type(2)));
__device__ __forceinline__ unsigned cvtpk_v(float lo, float hi) { const f32x2c v = {lo, hi}; const bf16x2c b = __builtin_convertvector(v, bf16x2c); return __builtin_bit_cast(unsigned, b); }
__device__ __forceinline__ int permcol(int j) { const int x = j & 15; return (j & ~15) + ((x >> 2) & 1) * 8 + (x >> 3) * 4 + (x & 3); }
__device__ __forceinline__ void mm32(f32x16& acc, const LAS unsigned char* A, const LAS unsigned char* Bt, int lane) {
    const int r = lane & 31, h = lane >> 5;
    const LAS unsigned char* pa = A + r * CS + h * 16; const LAS unsigned char* pb = Bt + r * CS + h * 16;
#pragma unroll
    for (int ks = 0; ks < 4; ++ks) { const bf16x8 a = *(const LAS bf16x8*)(pa + ks * 32), b = *(const LAS bf16x8*)(pb + ks * 32); acc = __builtin_amdgcn_mfma_f32_32x32x16_bf16(a, b, acc, 0, 0, 0); }
}
__device__ __forceinline__ void st_bf16(LAS unsigned char* p, float v) { *(LAS unsigned short*)p = (unsigned short)cvtpk_v(v, v); }

struct S1Regs { v4u rk, rkp, raic, rr, rrp, rv, rvp; f32x4 rw0, rw1; };
__device__ __forceinline__ void s1_load(const Ptrs& P, int unit, int tid, S1Regs& R) {
    const int c = unit >> 5, bh = unit & 31, b = bh >> 4, h = bh & 15, tt = tid >> 3, sg = tid & 7;
    const int t_ = c * 64 + tt; const size_t m_ = (size_t)b * SEQ + t_; const int cb = h * 64 + sg * 8;
    R.rk = *(const v4u*)(P.PROJ + m_ * PJ + C_K + cb); R.raic = *(const v4u*)(P.AIC + m_ * 1024 + cb);
    R.rw0 = *(const f32x4*)(P.DEC + m_ * 1024 + cb); R.rw1 = *(const f32x4*)(P.DEC + m_ * 1024 + cb + 4);
    R.rr = *(const v4u*)(P.PROJ + m_ * PJ + C_R + cb); R.rv = *(const v4u*)(P.PROJ + m_ * PJ + C_V + cb);
    if (t_ > 0) { R.rrp = *(const v4u*)(P.PROJ + (m_ - 1) * PJ + C_R + cb); R.rvp = *(const v4u*)(P.PROJ + (m_ - 1) * PJ + C_V + cb); R.rkp = *(const v4u*)(P.PROJ + (m_ - 1) * PJ + C_K + cb); }
    else { R.rrp = (v4u){0u, 0u, 0u, 0u}; R.rvp = (v4u){0u, 0u, 0u, 0u}; R.rkp = (v4u){0u, 0u, 0u, 0u}; }
}
__device__ __forceinline__ void unpk8(const v4u u, float (&x)[8]) { x[0] = bflo(u.x); x[1] = bfhi(u.x); x[2] = bflo(u.y); x[3] = bfhi(u.y); x[4] = bflo(u.z); x[5] = bfhi(u.z); x[6] = bflo(u.w); x[7] = bfhi(u.w); }
__device__ __forceinline__ v4u pk8(const float (&x)[8]) { v4u o; o.x = pk2(x[0], x[1]); o.y = pk2(x[2], x[3]); o.z = pk2(x[4], x[5]); o.w = pk2(x[6], x[7]); return o; }

#ifdef PROBE_MASK
#define S1T(k) do { if (blockIdx.x == 0 && wv == 0) { unsigned long long t_; __builtin_amdgcn_sched_barrier(0); asm volatile("s_memrealtime %0\n\ts_waitcnt lgkmcnt(0)" : "=s"(t_) :: "memory"); __builtin_amdgcn_sched_barrier(0); \
    volatile LAS unsigned* w_ = (volatile LAS unsigned*)(lds + MISC_OFF) + 96; if ((tid & 63) == 0) { w_[(k)] += (unsigned)t_ - w_[7]; w_[7] = (unsigned)t_; } } } while (0)
#else
#define S1T(k) do {} while (0)
#endif
#define S1_BAR() asm volatile("s_waitcnt lgkmcnt(0)\n\ts_barrier" ::: "memory")
__device__ __forceinline__ void s1_unit(const Ptrs& P, int unit, int next_unit, S1Regs& R, LAS unsigned char* lds, int tid_in, int wv) {
    int tid = tid_in; asm volatile("" : "+v"(tid));
    const int c = unit >> 5, bh = unit & 31, b = bh >> 4, h = bh & 15, tt = tid >> 3, sg = tid & 7, lane = tid & 63;
    const size_t m0 = (size_t)b * SEQ + c * 64;
    {
        float a8[8], b8[8], k8[8], r8[8], v8[8], p8[8], lw[8], cum[8];
        const int cb = h * 64 + sg * 8;
        float mu8[8], c8[8];
#define S1_LD8(dst, ptr) do { const f32x4 u0_ = *(const f32x4*)(ptr), u1_ = *(const f32x4*)((ptr) + 4); dst[0] = u0_.x; dst[1] = u0_.y; dst[2] = u0_.z; dst[3] = u0_.w; dst[4] = u1_.x; dst[5] = u1_.y; dst[6] = u1_.z; dst[7] = u1_.w; } while (0)
        unpk8(R.rk, k8); unpk8(R.rkp, p8); S1_LD8(mu8, P.mu + C_K + cb);
#pragma unroll
        for (int e = 0; e < 8; ++e) k8[e] = k8[e] + mu8[e] * (p8[e] - k8[e]);
        S1_LD8(c8, P.k_k + cb);
        float n2 = 0.f;
#pragma unroll
        for (int e = 0; e < 8; ++e) { a8[e] = k8[e] * c8[e]; n2 += a8[e] * a8[e]; }
        n2 = DPP_ADD(n2, 0xB1); n2 = DPP_ADD(n2, 0x4E); n2 = DPP_ADD(n2, 0x141);
        const float inv = 1.0f / fmaxf(sqrtf(n2), 1e-12f);
        unpk8(R.raic, b8); S1_LD8(c8, P.k_a + cb);
#pragma unroll
        for (int e = 0; e < 8; ++e) { const float ic = 1.0f / (1.0f + __expf(-b8[e])); const float kk = a8[e] * inv; k8[e] = k8[e] * (1.0f + (ic - 1.0f) * c8[e]); a8[e] = -kk; b8[e] = kk * ic; }
        unpk8(R.rr, r8); unpk8(R.rrp, p8); S1_LD8(mu8, P.mu + C_R + cb);
#pragma unroll
        for (int e = 0; e < 8; ++e) r8[e] = r8[e] + mu8[e] * (p8[e] - r8[e]);
        S1_LD8(c8, P.r_k + cb);
        float bon = 0.f;
#pragma unroll
        for (int e = 0; e < 8; ++e) bon += r8[e] * k8[e] * c8[e];
        bon = DPP_ADD(bon, 0xB1); bon = DPP_ADD(bon, 0x4E); bon = DPP_ADD(bon, 0x141);
        if (sg == 0) P.BON[(m0 + tt) * 16 + h] = bon;
        unpk8(R.rv, v8); unpk8(R.rvp, p8); S1_LD8(mu8, P.mu + C_V + cb);
#pragma unroll
        for (int e = 0; e < 8; ++e) v8[e] = v8[e] + mu8[e] * (p8[e] - v8[e]);
        const float z8[8] = {R.rw0.x, R.rw0.y, R.rw0.z, R.rw0.w, R.rw1.x, R.rw1.y, R.rw1.z, R.rw1.w};
#pragma unroll
        for (int e = 0; e < 8; ++e) { lw[e] = -__expf(-__logf(1.0f + __expf(-z8[e])) - 0.5f); cum[e] = lw[e]; }
#undef S1_LD8
#pragma unroll
        for (int o = 8; o < 64; o <<= 1)
#pragma unroll
            for (int e = 0; e < 8; ++e) { const float t = __shfl_up(cum[e], o); if (lane >= o) cum[e] += t; }
        LAS float* WT = (LAS float*)(lds + L_WT);
        if (lane >= 56) {
#pragma unroll
            for (int e = 0; e < 8; ++e) WT[wv * 64 + sg * 8 + e] = cum[e]; }
        S1_BAR(); S1T(0);
        float cL[8];
#pragma unroll
        for (int e = 0; e < 8; ++e) cL[e] = 0.f;
        {
            float off[8];
#pragma unroll
            for (int e = 0; e < 8; ++e) off[e] = 0.f;
#pragma unroll
            for (int w2 = 0; w2 < 8; ++w2) { const f32x4 x0 = *(const LAS f32x4*)(WT + w2 * 64 + sg * 8), x1 = *(const LAS f32x4*)(WT + w2 * 64 + sg * 8 + 4);
                const float xs[8] = {x0.x, x0.y, x0.z, x0.w, x1.x, x1.y, x1.z, x1.w};
#pragma unroll
                for (int e = 0; e < 8; ++e) { cL[e] += xs[e]; off[e] += (w2 < wv) ? xs[e] : 0.f; } }
#pragma unroll
            for (int e = 0; e < 8; ++e) cum[e] += off[e];
        }
        float o8[8];
#pragma unroll
        for (int e = 0; e < 8; ++e) o8[e] = a8[e] * __expf(cum[e] - lw[e]);
        *(LAS v4u*)(lds + L_AT + tt * CS + sg * 16) = pk8(o8);
#pragma unroll
        for (int e = 0; e < 8; ++e) o8[e] = r8[e] * __expf(cum[e]);
        *(LAS v4u*)(lds + L_RT + tt * CS + sg * 16) = pk8(o8);
        float gi[8];
#pragma unroll
        for (int e = 0; e < 8; ++e) { gi[e] = __expf(-cum[e]); o8[e] = b8[e] * gi[e]; }
        *(LAS v4u*)(lds + L_BT + tt * CS + sg * 16) = pk8(o8);
#pragma unroll
        for (int e = 0; e < 8; ++e) o8[e] = k8[e] * gi[e];
        *(LAS v4u*)(lds + L_KT + tt * CS + sg * 16) = pk8(o8);
#pragma unroll
        for (int e = 0; e < 8; ++e) { const float gl = __expf(cL[e] - cum[e]);
            st_bf16(lds + L_VT + (sg * 8 + e) * CS + tt * 2, v8[e]); st_bf16(lds + L_BH + (sg * 8 + e) * CS + tt * 2, b8[e] * gl); st_bf16(lds + L_KH + (sg * 8 + e) * CS + tt * 2, k8[e] * gl); }
        if (tt == 0) {
#pragma unroll
            for (int e = 0; e < 8; ++e) ((LAS float*)(lds + L_GL))[sg * 8 + e] = __expf(cL[e]); }
    }
    S1_BAR(); S1T(1);
    if (next_unit < 4096) s1_load(P, next_unit, tid, R);
    int lane2 = lane; asm volatile("" : "+v"(lane2));
    const int hl = lane2 >> 5, cl = lane2 & 31;
    {
        const int p = wv >> 1, mb = wv & 1;
        const LAS unsigned char* A = lds + ((p < 2) ? L_AT : L_RT) + mb * 32 * CS;
        const LAS unsigned char* B = lds + ((p == 0 || p == 3) ? L_KT : L_BT);
#pragma unroll
        for (int nb = 0; nb < 2; ++nb) {
            f32x16 acc = {}; mm32(acc, A, B + nb * 32 * CS, lane);
            const int col = nb * 32 + cl;
#pragma unroll
            for (int rg = 0; rg < 16; ++rg) { const int row = mb * 32 + crow(rg, hl);
                const bool keep = (p < 2) ? (col < row) : (col <= row); const float v = keep ? acc[rg] : 0.f;
                if (p == 1) { *(LAS float*)(lds + L_M2 + row * FS + col * 4) = v; st_bf16(lds + L_M2B + row * CS + col * 2, v); }
                else st_bf16(lds + ((p == 0) ? L_M1 : (p == 2) ? L_M3 : L_M4) + row * CS + col * 2, v); }
        }
    }
    S1_BAR(); S1T(2);
    f32x16 accQ = {}, accY = {};
    const int tb = (wv >> 1) & 1, ib = wv & 1;
    if (wv < 4) {
        f32x16 acc = {}; mm32(acc, lds + L_M1 + tb * 32 * CS, lds + L_VT + ib * 32 * CS, lane);
#pragma unroll
        for (int rg = 0; rg < 16; ++rg) *(LAS float*)(lds + L_PF + (ib * 32 + cl) * FS + (tb * 32 + crow(rg, hl)) * 4) = acc[rg];
        if (lane2 < 32) {
            const int I = wv; const LAS unsigned char* mdia = lds + L_M2 + I * 16 * FS + I * 64; LAS unsigned char* pib = lds + L_PI + I * 1024 + lane2 * 2;
            asm volatile("" : "+v"(mdia), "+v"(pib));
            float pc[16];
#pragma unroll
            for (int r2 = 0; r2 < 16; ++r2) {
                float s_ = (r2 == lane2) ? 1.0f : 0.0f;
#pragma unroll
                for (int g = 0; g < (r2 + 3) / 4; ++g) { const f32x4 m = *(const LAS f32x4*)(mdia + r2 * FS + g * 16);
                    s_ += m.x * pc[4 * g];
                    if (4 * g + 1 < r2) s_ += m.y * pc[4 * g + 1];
                    if (4 * g + 2 < r2) s_ += m.z * pc[4 * g + 2];
                    if (4 * g + 3 < r2) s_ += m.w * pc[4 * g + 3]; }
                pc[r2] = s_;
                st_bf16(pib + r2 * 64, s_);
            }
        }
    } else { mm32(accQ, lds + L_KH + tb * 32 * CS, lds + L_VT + ib * 32 * CS, lane); mm32(accY, lds + L_M4 + tb * 32 * CS, lds + L_VT + ib * 32 * CS, lane); }
    S1_BAR(); S1T(3);
    {
        typedef float f32x4m __attribute__((ext_vector_type(4)));
        const int c16 = lane2 & 15, kq = lane2 >> 4, n0 = wv * 16, n = n0 + c16;
        LAS unsigned char* q1w = lds + L_Q1 + n0 * CS;
        LAS unsigned char* rtw = lds + L_RTW + wv * 1024;
        {
            const v4u z = (v4u){0u, 0u, 0u, 0u};
            for (int o = lane2 * 16; o < 16 * CS; o += 1024) *(LAS v4u*)(q1w + o) = z;
            *(LAS v4u*)(rtw + lane2 * 16) = z;
        }
        const LAS unsigned char* a_m2 = lds + L_M2B + c16 * CS + kq * 16;
        const LAS unsigned char* b_q1 = q1w + c16 * CS + kq * 16;
        const LAS unsigned char* a_pi = lds + L_PI + c16 * 64 + kq * 16;
        const LAS unsigned char* b_rt = rtw + c16 * 64 + kq * 16;
        asm volatile("s_waitcnt lgkmcnt(0)" ::: "memory");
#pragma unroll
        for (int I = 0; I < 4; ++I) {
            f32x4m cacc;
            if (wv < 4) {
#pragma unroll
                for (int e = 0; e < 4; ++e) cacc[e] = __uint_as_float((unsigned)(*(const LAS unsigned short*)(lds + L_AT + (16 * I + 4 * kq + e) * CS + n * 2)) << 16);
            } else cacc = *(const LAS f32x4m*)(lds + L_PF + (n - 64) * FS + (16 * I + 4 * kq) * 4);
            if (I > 0) {
#pragma unroll
                for (int ks = 0; ks < 2; ++ks) { const bf16x8 a = *(const LAS bf16x8*)(a_m2 + I * 16 * CS + ks * 64), b2 = *(const LAS bf16x8*)(b_q1 + ks * 64);
                    cacc = __builtin_amdgcn_mfma_f32_16x16x32_bf16(a, b2, cacc, 0, 0, 0); }
            }
            { v4u w; w.x = cvtpk_v(cacc[0], cacc[1]); w.y = cvtpk_v(cacc[2], cacc[3]); *(LAS unsigned long long*)(rtw + c16 * 64 + kq * 8) = (unsigned long long)w.x | ((unsigned long long)w.y << 32); }
            asm volatile("s_waitcnt lgkmcnt(0)" ::: "memory");
            const bf16x8 pa = *(const LAS bf16x8*)(a_pi + I * 1024), rb = *(const LAS bf16x8*)(b_rt);
            f32x4m q = {0.f, 0.f, 0.f, 0.f};
            q = __builtin_amdgcn_mfma_f32_16x16x32_bf16(pa, rb, q, 0, 0, 0);
            { v4u w; w.x = cvtpk_v(q[0], q[1]); w.y = cvtpk_v(q[2], q[3]); *(LAS unsigned long long*)(q1w + c16 * CS + (16 * I + 4 * kq) * 2) = (unsigned long long)w.x | ((unsigned long long)w.y << 32); }
            asm volatile("s_waitcnt lgkmcnt(0)" ::: "memory");
        }
    }
    S1_BAR(); S1T(4);
    int lane3 = lane; asm volatile("" : "+v"(lane3));
    const int hl4 = lane3 >> 5, cl4 = lane3 & 31;
    if (wv < 4) {
        f32x16 aw = {}, as = {};
        mm32(aw, lds + L_M3 + tb * 32 * CS, lds + L_Q1 + ib * 32 * CS, lane3);
        mm32(as, lds + L_BH + tb * 32 * CS, lds + L_Q1 + ib * 32 * CS, lane3);
        const int j = ib * 32 + cl4; const float gl = ((const LAS float*)(lds + L_GL))[j]; const int pc = permcol(j);
#pragma unroll
        for (int rg = 0; rg < 16; ++rg) { const int row = tb * 32 + crow(rg, hl4);
            const float rt = __uint_as_float((unsigned)(*(const LAS unsigned short*)(lds + L_RT + row * CS + j * 2)) << 16);
            st_bf16(lds + L_PF + row * CS + pc * 2, aw[rg] + rt);
            st_bf16(lds + L_PF + 9216 + row * CS + pc * 2, as[rg] + ((row == j) ? gl : 0.f)); }
    } else {
        mm32(accY, lds + L_M3 + tb * 32 * CS, lds + L_Q1 + (64 + ib * 32) * CS, lane3);
        mm32(accQ, lds + L_BH + tb * 32 * CS, lds + L_Q1 + (64 + ib * 32) * CS, lane3);
        const size_t o0 = (m0 + tb * 32 + (lane3 >> 3)) * 1024 + h * 64 + ib * 32 + (lane3 & 7) * 4;
#pragma unroll
        for (int g = 0; g < 4; ++g) { *(f32x4*)(P.Y + o0 + (size_t)g * 8 * 1024) = (f32x4){accY[4 * g], accY[4 * g + 1], accY[4 * g + 2], accY[4 * g + 3]};
            *(f32x4*)(P.DEC + o0 + (size_t)g * 8 * 1024) = (f32x4){accQ[4 * g], accQ[4 * g + 1], accQ[4 * g + 2], accQ[4 * g + 3]}; }
    }
    S1_BAR(); S1T(5);
    { const int row = tid >> 3, pc8 = tid & 7;
      *(v4u*)(P.KP + (m0 + row) * 1024 + h * 64 + pc8 * 8) = *(const LAS v4u*)(lds + L_PF + row * CS + pc8 * 16);
      *(v4u*)(P.AV + (m0 + row) * 1024 + h * 64 + pc8 * 8) = *(const LAS v4u*)(lds + L_PF + 9216 + row * CS + pc8 * 16); }
    S1_BAR(); S1T(6);
}

constexpr int S2_WY = 0, S2_WS = 9216, S2_YI = 18432, S2_QS = 35840, S2_SLOT = 53248;
struct S2Set { v4u kp, av, y0, y1, d0, d1; };
__device__ __forceinline__ void s2_load(const Ptrs& P, int b, int h, int c, int tid, S2Set& G) {
    const size_t m0 = (size_t)b * SEQ + (size_t)c * 64; const int lr = tid >> 3, lp = tid & 7, yr = tid >> 4, yp = tid & 15;
    G.kp = *(const v4u*)(P.KP + (m0 + lr) * 1024 + h * 64 + lp * 8); G.av = *(const v4u*)(P.AV + (m0 + lr) * 1024 + h * 64 + lp * 8);
    G.y0 = *(const v4u*)(P.Y + (m0 + yr) * 1024 + h * 64 + yp * 4); G.y1 = *(const v4u*)(P.Y + (m0 + 32 + yr) * 1024 + h * 64 + yp * 4);
    G.d0 = *(const v4u*)(P.DEC + (m0 + yr) * 1024 + h * 64 + yp * 4); G.d1 = *(const v4u*)(P.DEC + (m0 + 32 + yr) * 1024 + h * 64 + yp * 4);
}
__device__ __forceinline__ void s2_write(LAS unsigned char* slot, int tid, const S2Set& G) {
    const int lr = tid >> 3, lp = tid & 7, yr = tid >> 4, yp = tid & 15;
    *(LAS v4u*)(slot + S2_WY + lr * CS + lp * 16) = G.kp; *(LAS v4u*)(slot + S2_WS + lr * CS + lp * 16) = G.av;
    *(LAS v4u*)(slot + S2_YI + yr * FS + yp * 16) = G.y0; *(LAS v4u*)(slot + S2_YI + (32 + yr) * FS + yp * 16) = G.y1;
    *(LAS v4u*)(slot + S2_QS + yr * FS + yp * 16) = G.d0; *(LAS v4u*)(slot + S2_QS + (32 + yr) * FS + yp * 16) = G.d1;
}
typedef float f32x8 __attribute__((ext_vector_type(8)));
#define S2_CAT(a, b, c2, d) __builtin_shufflevector(__builtin_shufflevector(a, b, 0, 1, 2, 3, 4, 5, 6, 7), __builtin_shufflevector(c2, d, 0, 1, 2, 3, 4, 5, 6, 7), 0, 1, 2, 3, 4, 5, 6, 7, 8, 9, 10, 11, 12, 13, 14, 15)
__device__ __forceinline__ void s2_compute(const Ptrs& P, int b, int h, int ib, int c, const LAS unsigned char* slot, int lane, f32x16& X0, f32x16& X1) {
    const int r = lane & 31, hl = lane >> 5;
    bf16x8 bf[2][2];
    {
        const f32x16* X[2] = {&X0, &X1};
#pragma unroll
        for (int jb = 0; jb < 2; ++jb)
#pragma unroll
            for (int ks = 0; ks < 2; ++ks) { const f32x16& x = *X[jb]; v4u w;
                w.x = cvtpk_v(x[8 * ks], x[8 * ks + 1]); w.y = cvtpk_v(x[8 * ks + 2], x[8 * ks + 3]); w.z = cvtpk_v(x[8 * ks + 4], x[8 * ks + 5]); w.w = cvtpk_v(x[8 * ks + 6], x[8 * ks + 7]);
                bf[jb][ks] = __builtin_bit_cast(bf16x8, w); }
    }
    const LAS unsigned char* pa = slot + r * CS + hl * 16;
    const LAS unsigned char* pc = slot + (lane >> 3) * FS + ib * 128 + (lane & 7) * 16;
#define S2_TILE(base, tb) S2_CAT(*(const LAS f32x4*)(pc + (base) + ((tb) * 32) * FS), *(const LAS f32x4*)(pc + (base) + ((tb) * 32 + 8) * FS), *(const LAS f32x4*)(pc + (base) + ((tb) * 32 + 16) * FS), *(const LAS f32x4*)(pc + (base) + ((tb) * 32 + 24) * FS))
#define S2_AF(base, rb, jb, ks) (*(const LAS bf16x8*)(pa + (base) + (rb) * 32 * CS + (jb) * 64 + (ks) * 32))
    f32x16 y0 = S2_TILE(S2_YI, 0), y1 = S2_TILE(S2_YI, 1);
#pragma unroll
    for (int jb = 0; jb < 2; ++jb)
#pragma unroll
        for (int ks = 0; ks < 2; ++ks) { y0 = __builtin_amdgcn_mfma_f32_32x32x16_bf16(S2_AF(S2_WY, 0, jb, ks), bf[jb][ks], y0, 0, 0, 0); y1 = __builtin_amdgcn_mfma_f32_32x32x16_bf16(S2_AF(S2_WY, 1, jb, ks), bf[jb][ks], y1, 0, 0, 0); }
    {
        float* cb_ = P.Y + ((size_t)b * SEQ + (size_t)c * 64) * 1024; const unsigned offY = (unsigned)((4 * hl) * 1024 + h * 64 + ib * 32 + r);
#pragma unroll
        for (int rg = 0; rg < 16; ++rg) { const int rr = (rg & 3) + 8 * (rg >> 2); float *pa_ = cb_ + rr * 1024, *pb_ = cb_ + (32 + rr) * 1024; asm volatile("" : "+s"(pa_), "+s"(pb_)); pa_[offY] = y0[rg]; pb_[offY] = y1[rg]; }
    }
    f32x16 q0 = S2_TILE(S2_QS, 0), q1 = S2_TILE(S2_QS, 1);
#pragma unroll
    for (int jb = 0; jb < 2; ++jb)
#pragma unroll
        for (int ks = 0; ks < 2; ++ks) { q0 = __builtin_amdgcn_mfma_f32_32x32x16_bf16(S2_AF(S2_WS, 0, jb, ks), bf[jb][ks], q0, 0, 0, 0); q1 = __builtin_amdgcn_mfma_f32_32x32x16_bf16(S2_AF(S2_WS, 1, jb, ks), bf[jb][ks], q1, 0, 0, 0); }
    X0 = q0; X1 = q1;
#undef S2_TILE
#undef S2_AF
}
__device__ __forceinline__ void s2_block(const Ptrs& P, int bh, LAS unsigned char* lds, int tid, int wv) {
    const int b = bh >> 4, h = bh & 15, lane = tid & 63;
    constexpr int NC = SEQ / 64;
    f32x16 X0 = {}, X1 = {};
    S2Set GA, GB;
    s2_load(P, b, h, 0, tid, GA); s2_load(P, b, h, 1, tid, GB);
    s2_write(lds, tid, GA);
    s2_load(P, b, h, 2, tid, GA);
    __syncthreads();
    for (int c = 0; c < NC; c += 2) {
        s2_write(lds + S2_SLOT, tid, GB);
        if (c + 3 < NC) s2_load(P, b, h, c + 3, tid, GB);
        if (wv < 2) s2_compute(P, b, h, wv, c, lds, lane, X0, X1);
        __syncthreads();
        if (c + 2 < NC) s2_write(lds, tid, GA);
        if (c + 4 < NC) s2_load(P, b, h, c + 4, tid, GA);
        if (wv < 2) s2_compute(P, b, h, wv, c + 1, lds + S2_SLOT, lane, X0, X1);
        __syncthreads();
    }
}
#undef S2_CAT
}
__device__ __forceinline__ unsigned enc_key(float s) { const unsigned b = __float_as_uint(s); return b ^ ((b >> 31) ? 0xFFFFFFFFu : 0x80000000u); }
__device__ __forceinline__ float dec_key(unsigned u) { const unsigned b = (u & 0x80000000u) ? (u ^ 0x80000000u) : ~u; return __uint_as_float(b); }
__device__ __forceinline__ void ins16(unsigned (&L)[16], unsigned x) {
#pragma unroll
    for (int i = 0; i < 16; ++i) { const unsigned hi = max(L[i], x); x = min(L[i], x); L[i] = hi; }
}
constexpr int TK_CS = 144, TK_LO = 36864;
__device__ __forceinline__ void topk_pass(const Ptrs& P, int h, int tok0, const LAS unsigned char* lds, const int p, int lane, int w, unsigned (&L0)[16], unsigned (&L1)[16]) {
    const int r = lane & 31, hi = lane >> 5;
#pragma unroll
    for (int i = 0; i < 16; ++i) { L0[i] = 0u; L1[i] = 0u; }
    bf16x8 qf[2][4];
#pragma unroll
    for (int tt = 0; tt < 2; ++tt)
#pragma unroll
        for (int ks = 0; ks < 4; ++ks) qf[tt][ks] = *(const bf16x8*)(P.QP + (size_t)(tok0 + w * 64 + tt * 32 + r) * 1024 + h * 128 + p * 64 + ks * 16 + hi * 8);
    const LAS unsigned char* ka = lds + (size_t)(p * 128 + r) * TK_CS + hi * 16;
#pragma unroll
    for (int nt = 0; nt < 4; ++nt) {
        bf16x8 ah[4], al[4];
#pragma unroll
        for (int ks = 0; ks < 4; ++ks) { ah[ks] = *(const LAS bf16x8*)(ka + nt * 32 * TK_CS + ks * 32); al[ks] = *(const LAS bf16x8*)(ka + TK_LO + nt * 32 * TK_CS + ks * 32); }
        rk::f32x16 acc0 = {}, acc1 = {};
#pragma unroll
        for (int ks = 0; ks < 4; ++ks) { acc0 = __builtin_amdgcn_mfma_f32_32x32x16_bf16(ah[ks], qf[0][ks], acc0, 0, 0, 0); acc0 = __builtin_amdgcn_mfma_f32_32x32x16_bf16(al[ks], qf[0][ks], acc0, 0, 0, 0);
            acc1 = __builtin_amdgcn_mfma_f32_32x32x16_bf16(ah[ks], qf[1][ks], acc1, 0, 0, 0); acc1 = __builtin_amdgcn_mfma_f32_32x32x16_bf16(al[ks], qf[1][ks], acc1, 0, 0, 0); }
#pragma unroll
        for (int rg = 0; rg < 16; ++rg) { const unsigned tag = (unsigned)(127 - (nt * 32 + (rg & 3) + 8 * (rg >> 2) + 4 * hi));
            ins16(L0, (enc_key(acc0[rg]) & ~0x7Fu) | tag); ins16(L1, (enc_key(acc1[rg]) & ~0x7Fu) | tag); }
    }
}
__device__ __forceinline__ void peer_topk(const Ptrs& P, int h, int tok0, LAS unsigned char* lds, int tid) {
    const int lane = tid & 63, w = tid >> 6, r = lane & 31, hi = lane >> 5;
    {
        const int row = tid >> 1, d0 = (tid & 1) * 32; const float* src = P.sub_keys + ((size_t)h * 256 + row) * 64 + d0;
#pragma unroll
        for (int j = 0; j < 4; ++j) { const f32x4 a = *(const f32x4*)(src + 8 * j), b = *(const f32x4*)(src + 8 * j + 4);
            const float x[8] = {a.x, a.y, a.z, a.w, b.x, b.y, b.z, b.w}; float lo[8]; v4u vh, vl;
#pragma unroll
            for (int e = 0; e < 8; ++e) { const float hb = __uint_as_float(f2bf(x[e]) << 16); lo[e] = x[e] - hb; }
            vh.x = pk2(x[0], x[1]); vh.y = pk2(x[2], x[3]); vh.z = pk2(x[4], x[5]); vh.w = pk2(x[6], x[7]);
            vl.x = pk2(lo[0], lo[1]); vl.y = pk2(lo[2], lo[3]); vl.z = pk2(lo[4], lo[5]); vl.w = pk2(lo[6], lo[7]);
            *(LAS v4u*)(lds + row * TK_CS + (d0 + 8 * j) * 2) = vh; *(LAS v4u*)(lds + TK_LO + row * TK_CS + (d0 + 8 * j) * 2) = vl; }
    }
    __syncthreads();
    unsigned L00[16], L01[16], L10[16], L11[16];
    topk_pass(P, h, tok0, lds, 0, lane, w, L00, L01);
    topk_pass(P, h, tok0, lds, 1, lane, w, L10, L11);
    unsigned M1[2][16];
#pragma unroll
    for (int i = 0; i < 16; ++i) { M1[0][i] = hi ? L01[i] : L00[i]; M1[1][i] = hi ? L11[i] : L10[i]; }
#pragma unroll
    for (int i = 0; i < 16; ++i) { const unsigned s0 = hi ? L00[i] : L01[i], s1 = hi ? L10[i] : L11[i]; ins16(M1[0], (unsigned)__shfl_xor((int)s0, 32)); ins16(M1[1], (unsigned)__shfl_xor((int)s1, 32)); }
    const int t = tok0 + w * 64 + hi * 32 + r;
    unsigned F[16];
#pragma unroll
    for (int i = 0; i < 16; ++i) F[i] = 0u;
    float v1[16], v2[16];
#pragma unroll
    for (int i = 0; i < 16; ++i) { v1[i] = dec_key((M1[0][i] & ~0x7Fu) | 0x40u); v2[i] = dec_key((M1[1][i] & ~0x7Fu) | 0x40u); }
#pragma unroll
    for (int a = 0; a < 16; ++a)
#pragma unroll
        for (int b = 0; b < 16; ++b)
            if ((a + 1) * (b + 1) <= 16) ins16(F, (enc_key(v1[a] + v2[b]) & ~0xFFu) | (unsigned)(255 - (16 * a + b)));
    float sv[16]; unsigned id[16];
#pragma unroll
    for (int i = 0; i < 16; ++i) {
        sv[i] = dec_key((F[i] & ~0xFFu) | 0x80u);
        const unsigned ab = 255u - (F[i] & 0xFFu), a = ab >> 4, b = ab & 15u;
        unsigned la = 0u, lb = 0u;
#pragma unroll
        for (int j = 0; j < 16; ++j) { la = (a == (unsigned)j) ? M1[0][j] : la; lb = (b == (unsigned)j) ? M1[1][j] : lb; }
        id[i] = (127u - (la & 0x7Fu)) * 128u + (127u - (lb & 0x7Fu));
    }
    float z = 0.f;
#pragma unroll
    for (int i = 0; i < 16; ++i) { sv[i] = __expf(sv[i] - sv[0]); z += sv[i]; }
    const float rz = 1.0f / z;
    float* gdst = P.GATE + (size_t)t * 128 + h * 16;
#pragma unroll
    for (int i = 0; i < 16; i += 4) *(f32x4*)(gdst + i) = (f32x4){sv[i] * rz, sv[i + 1] * rz, sv[i + 2] * rz, sv[i + 3] * rz};
    unsigned short* idst = P.IDX + (size_t)t * 128 + h * 16;
    *(v4u*)idst = (v4u){id[0] | (id[1] << 16), id[2] | (id[3] << 16), id[4] | (id[5] << 16), id[6] | (id[7] << 16)};
    *(v4u*)(idst + 8) = (v4u){id[8] | (id[9] << 16), id[10] | (id[11] << 16), id[12] | (id[13] << 16), id[14] | (id[15] << 16)};
    __syncthreads();
}

__device__ __forceinline__ float gelu_erf(float x) { return 0.5f * x * (1.0f + erff(x * 0.70710678118654752f)); }
typedef float f32x2v __attribute__((ext_vector_type(2)));
__device__ __forceinline__ void ld_row4(const unsigned char* row, int lane, float (&r)[32]) {
    const v4u u = *(const v4u*)(row + lane * 16); const unsigned w[4] = {u.x, u.y, u.z, u.w};
#pragma unroll
    for (int d = 0; d < 4; ++d) {
        const f32x2v a = __builtin_amdgcn_cvt_scalef32_pk_f32_fp4(w[d], 1.0f, 0), b = __builtin_amdgcn_cvt_scalef32_pk_f32_fp4(w[d], 1.0f, 1), c2 = __builtin_amdgcn_cvt_scalef32_pk_f32_fp4(w[d], 1.0f, 2), d2 = __builtin_amdgcn_cvt_scalef32_pk_f32_fp4(w[d], 1.0f, 3);
        r[8 * d] = a.x; r[8 * d + 1] = a.y; r[8 * d + 2] = b.x; r[8 * d + 3] = b.y; r[8 * d + 4] = c2.x; r[8 * d + 5] = c2.y; r[8 * d + 6] = d2.x; r[8 * d + 7] = d2.y; }
}
__device__ __forceinline__ void peer_token(const Ptrs& P, int t, int lane) {
    float x2[32];
    float ss_t = 0.f;
#pragma unroll
    for (int i = 0; i < 8; ++i) { const f32x4 s4 = *(const f32x4*)(P.SSQ + (size_t)t * 32 + 4 * i); ss_t += (s4.x + s4.y) + (s4.z + s4.w); }
    const float rs_t = 1.0f / sqrtf(ss_t * (1.0f / DMODEL) + 1e-6f);
    { const bf16* xr = P.XN + (size_t)t * 2048 + lane * 4;
#pragma unroll
      for (int j = 0; j < 8; ++j) { const unsigned long long u = *(const unsigned long long*)(xr + 256 * j); const unsigned lo = (unsigned)u, hi2 = (unsigned)(u >> 32);
          x2[4 * j] = bflo(lo) * rs_t; x2[4 * j + 1] = bfhi(lo) * rs_t; x2[4 * j + 2] = bflo(hi2) * rs_t; x2[4 * j + 3] = bfhi(hi2) * rs_t; } }
    unsigned idxv[2]; float wv[2];
#pragma unroll
    for (int kb = 0; kb < 2; ++kb) {
        idxv[kb] = P.IDX[(size_t)t * 128 + kb * 64 + lane];
        float p[64];
#pragma unroll
        for (int i = 0; i < 64; ++i) {
            const unsigned e = (unsigned)__builtin_amdgcn_readlane((int)idxv[kb], i);
            float r[32]; ld_row4(P.U8 + (size_t)e * ROW6, lane, r);
            float a0 = 0.f, a1 = 0.f, a2 = 0.f, a3 = 0.f;
#pragma unroll
            for (int q = 0; q < 8; ++q) { a0 += r[4 * q] * x2[4 * q]; a1 += r[4 * q + 1] * x2[4 * q + 1]; a2 += r[4 * q + 2] * x2[4 * q + 2]; a3 += r[4 * q + 3] * x2[4 * q + 3]; }
            p[i] = (a0 + a1) + (a2 + a3);
        }
#pragma unroll
        for (int o = 32, n = 64; o >= 1; o >>= 1, n >>= 1) {
            const bool up = (lane & o) != 0;
#pragma unroll
            for (int i = 0; i < n / 2; ++i) { const float keep = up ? p[i + n / 2] : p[i], send = up ? p[i] : p[i + n / 2]; p[i] = keep + __shfl_xor(send, o); }
        }
        const unsigned e = idxv[kb];
        const float hk = gelu_erf(p[0] * P.USC[e]);
        wv[kb] = P.GATE[(size_t)t * 128 + kb * 64 + lane] * hk * P.VSC[e];
    }
    float acc[32];
#pragma unroll
    for (int i = 0; i < 32; ++i) acc[i] = 0.f;
#pragma unroll
    for (int kb = 0; kb < 2; ++kb) {
#pragma unroll 16
        for (int i = 0; i < 64; ++i) {
            const unsigned e = (unsigned)__builtin_amdgcn_readlane((int)idxv[kb], i);
            const float wk = __uint_as_float((unsigned)__builtin_amdgcn_readlane((int)__float_as_uint(wv[kb]), i));
            float r[32]; ld_row4(P.V8 + (size_t)e * ROW6, lane, r);
#pragma unroll
            for (int q = 0; q < 32; ++q) acc[q] += wk * r[q];
        }
    }
    float* orow = P.out + (size_t)t * 2048 + lane * 4;
#pragma unroll
    for (int q = 0; q < 8; ++q) { f32x4* o = (f32x4*)(orow + 256 * q); f32x4 v = *o;
        v.x += acc[4 * q]; v.y += acc[4 * q + 1]; v.z += acc[4 * q + 2]; v.w += acc[4 * q + 3]; *o = v; }
}
struct AttnQueue {
    gu32* ctr; volatile LAS unsigned* slot; int tid; unsigned q0;
    __device__ __forceinline__ bool next(int i, attn_body::AttnUnit& u) const {
        if (tid == 0) {
            unsigned k = slot[2], v = 0xFFFFFFFFu;
            while (k < 8u) { const unsigned q = (q0 + k) & 7u; const unsigned t = __hip_atomic_fetch_add(ctr + 64 * q, 1u, RLX_AGENT); if (t < 128u) { v = (q << 16) | t; break; } ++k; }
            slot[2] = k; slot[i & 1] = v;
        }
        __syncthreads();
        const unsigned v = (unsigned)__builtin_amdgcn_readfirstlane((int)slot[i & 1]);
        if (v == 0xFFFFFFFFu) return false;
        const unsigned q = v >> 16, t = v & 0xFFFFu;
        u.qb = 31 - (int)(t >> 2); u.bh = (int)(q + 8u * (t & 3u)); return true;
    }
    __device__ __forceinline__ void a_ready(const attn_body::AttnUnit&) const {}
    __device__ __forceinline__ void done(const attn_body::AttnUnit&) const {}
};

struct Args { const float* in[23]; float* out; unsigned char* ws; };

__device__ __forceinline__ int lane_id_fresh() { int l; asm volatile("v_mbcnt_lo_u32_b32 %0, -1, 0\n\tv_mbcnt_hi_u32_b32 %0, -1, %0" : "=v"(l)); return l; }
__device__ __forceinline__ Frame make_frame(unsigned char* lds, int wv) {
    Frame F; F.lds = (LAS unsigned char*)lds; F.MISC = (volatile LAS unsigned*)(F.lds + MISC_OFF); F.ctl = nullptr;
    F.lane = lane_id_fresh(); F.wave = wv; F.tid = wv * 64 + F.lane;
    F.G = gridDim.x; { const int bx = blockIdx.x; F.vcu = (F.G % 8 == 0) ? (bx % 8) * (F.G / 8) + bx / 8 : bx; }
    return F;
}
typedef __attribute__((address_space(4))) const unsigned long long kau64;
__device__ __forceinline__ Ptrs make_ptrs(kau64* ka) {
    Ptrs P; struct { const float* in[23]; } args;
#pragma unroll
    for (int i = 0; i < 23; ++i) args.in[i] = (const float*)(GAS const float*)ka[i];
    float* outp = (float*)(GAS float*)ka[23]; unsigned char* ws = (unsigned char*)(GAS unsigned char*)ka[24];
    P.x = args.in[0]; P.norm1_g = args.in[1]; P.w_in = args.in[2]; P.mu = args.in[3]; P.w_decay_up = args.in[4]; P.w0 = args.in[5]; P.w_iclr_up = args.in[6]; P.a0 = args.in[7];
    P.w_gate_up = args.in[8]; P.k_k = args.in[9]; P.k_a = args.in[10]; P.r_k = args.in[11]; P.lnx_g = args.in[12]; P.lnx_b = args.in[13]; P.fox_b_f = args.in[14];
    P.q_norm_g = args.in[15]; P.k_norm_g = args.in[16]; P.w_out = args.in[17]; P.norm2_g = args.in[18]; P.w_q = args.in[19]; P.sub_keys = args.in[20]; P.peer_u = args.in[21]; P.peer_v = args.in[22];
    P.out = outp;
    P.WQT = (bf16*)(ws + WS_WQT); P.LWT = (bf16*)(ws + WS_LWT); P.WOT = (bf16*)(ws + WS_WOT); P.WINT = (bf16*)(ws + WS_WINT); P.LA = (bf16*)(ws + WS_LA);
    P.XN = (bf16*)(ws + WS_XN); P.PROJ = (bf16*)(ws + WS_PROJ); P.MIXED = (bf16*)(ws + WS_MIXED); P.KP = (bf16*)(ws + WS_KP); P.AV = (bf16*)(ws + WS_AV); P.BV = (bf16*)(ws + WS_BV);
    P.QP = (bf16*)(ws + WS_QP); P.G = (bf16*)((unsigned char*)outp + OUT_G); P.AIC = (bf16*)((unsigned char*)outp + OUT_AIC);
    P.C2 = (float*)(ws + WS_C2); P.BON = (float*)(ws + WS_BON); P.Y = (float*)(ws + WS_XN); P.DEC = (float*)((unsigned char*)outp + OUT_DEC);
    P.GATE = (float*)(ws + WS_GATE); P.USC = (float*)(ws + WS_USC); P.VSC = (float*)(ws + WS_VSC); P.SSQ = (float*)(ws + WS_SSQ);
    P.IDX = (unsigned short*)(ws + WS_IDX); P.U8 = ws + WS_U8; P.V8 = ws + WS_V8;
    return P;
}
#define PHASE_BEGIN() Frame F = make_frame(lds, wv_); const int gw = F.vcu * NWAVES + F.wave, NGW = F.G * NWAVES; (void)gw; (void)NGW; kau64* ka_ = (kau64*)__builtin_amdgcn_kernarg_segment_ptr(); asm volatile("" : "+s"(ka_)); \
    const Ptrs P = make_ptrs(ka_); unsigned char* ws_ = (unsigned char*)(GAS unsigned char*)ka_[24]; (void)ws_; \
    const int lane = F.lane, tid = F.tid; (void)lane; (void)tid
__global__ void __launch_bounds__(NWAVES * 64, 2) hymba_fwd(Args args) {
    extern __shared__ __attribute__((aligned(16))) unsigned char lds[];
    const int wv_ = __builtin_amdgcn_readfirstlane((int)threadIdx.x >> 6);
    { Frame F = make_frame(lds, wv_);
    for (int u = F.tid; u < (LDS_BYTES - LDSCTL_OFF) / 4; u += NWAVES * 64) ((LAS unsigned*)(F.lds + LDSCTL_OFF))[u] = 0u;
    __syncthreads();
    { kau64* kb_ = (kau64*)__builtin_amdgcn_kernarg_segment_ptr(); F.ctl = (gu32*)((GAS unsigned char*)kb_[24] + WS_CTL); }
    (void)xcd_barrier_post((unsigned*)(F.ctl + CW_BAR), F.MISC + 8, F.tid); }
#ifdef PROBE_MASK
#define STAMP(k) do { if (blockIdx.x == 0 && wv_ == 0) { unsigned long long t_; __builtin_amdgcn_sched_barrier(0); asm volatile("s_memrealtime %0\n\ts_waitcnt lgkmcnt(0)" : "=s"(t_) :: "memory"); __builtin_amdgcn_sched_barrier(0); if (lane_id_fresh() == 0) { ((volatile LAS unsigned*)((LAS unsigned char*)lds + MISC_OFF))[64 + (k)] = (unsigned)t_; } } } while (0)
#else
#define STAMP(k) do {} while (0)
#endif
#define GRID_BAR() do { kau64* kb_ = (kau64*)__builtin_amdgcn_kernarg_segment_ptr(); asm volatile("" : "+s"(kb_)); XcdBarrier b_; b_.bar = (unsigned*)((gu32*)((GAS unsigned char*)kb_[24] + WS_CTL) + CW_BAR); b_.x = xb_xcc_id(); b_.st = (volatile LAS unsigned*)((LAS unsigned char*)lds + MISC_OFF) + 8; xcd_barrier(b_, wv_ * 64 + lane_id_fresh()); } while (0)

    STAMP(0);
    { PHASE_BEGIN();
        LAS float* scr = (LAS float*)(F.lds + RING_OFF + F.wave * 16384);
        constexpr int B_IN = 32 * 26, B_O = 32 * 8, B_Q = 32 * 4, I_L = 2 * 32;
        for (int it = (int)blockIdx.x; it < B_IN + B_O + B_Q; it += F.G) {
            int r = it; LAS float* bscr = (LAS float*)(F.lds + RING_OFF);
            if (r < B_IN) { p0_transpose_block(P.w_in, 2048, NIN, P.WINT, 2048, bscr, r / 26, r % 26, tid); continue; } r -= B_IN;
            if (r < B_O) { p0_transpose_block(P.w_out, 2048, 2048, P.WOT, 2048, bscr, r / 8, r % 8, tid); continue; } r -= B_O;
            p0_transpose_block(P.w_q, 2048, 1024, P.WQT, 2048, bscr, r / 4, r % 4, tid);
        }
        for (int it = gw; it < 3 * I_L; it += NGW) {
            int r = it;
            if (r < I_L) { p0_transpose_item(P.w_decay_up, 64, 1024, P.LWT, 128, scr, r / 32, r % 32, lane); continue; } r -= I_L;
            if (r < I_L) { p0_transpose_item(P.w_iclr_up, 64, 1024, P.LWT + 1024 * 128, 128, scr, r / 32, r % 32, lane); continue; } r -= I_L;
            p0_transpose_item(P.w_gate_up, 128, 1024, P.LWT + 2 * 1024 * 128, 128, scr, r / 32, r % 32, lane);
        }
        STAMP(16);
        {
            Row8 R0, R1; int e = gw;
            if (e < 2 * NEXP) ld_row8((e < NEXP ? P.peer_u : P.peer_v - (size_t)NEXP * 2048) + (size_t)e * 2048, lane, R0);
            for (; e < 2 * NEXP; e += NGW) {
                const int en = e + NGW;
                if (en < 2 * NEXP) ld_row8((en < NEXP ? P.peer_u : P.peer_v - (size_t)NEXP * 2048) + (size_t)en * 2048, lane, R1);
                if (e < NEXP) fp4_finish(R0, P.U8 + (size_t)e * ROW6, P.USC + e, lane); else fp4_finish(R0, P.V8 + (size_t)(e - NEXP) * ROW6, P.VSC + (e - NEXP), lane);
                R0 = R1;
            }
        }
        STAMP(17);
        {   Row8 R0, R1; int mr = gw;
            if (mr < M) ld_row8(P.x + (size_t)mr * DMODEL, lane, R0);
            for (; mr < M; mr += NGW) { const int mn = mr + NGW; if (mn < M) ld_row8(P.x + (size_t)mn * DMODEL, lane, R1);
                rms_finish(R0, P.norm1_g, P.XN + (size_t)mr * DMODEL, lane); R0 = R1; }
        }
    }
    GRID_BAR(); STAMP(1);
    { PHASE_BEGIN();
        pg8::Gemm g{P.XN, P.WINT, M, PJ, DMODEL}; pg8::StaticOrder S; S.init(M, PJ, F.G, (int)blockIdx.x);
        pg8::EpiBf16<0> E{P.PROJ, PJ, nullptr, 0, 0, 1.f};
        pg8::gemm_phase<pg8::EpiBf16<0>, pg8::StaticOrder, PG8_ALIGN, PG8_SP2>(F.lds + RING_OFF, g, S, E, tid);
    }
    GRID_BAR(); STAMP(2);
    { PHASE_BEGIN();
        if (blockIdx.x < 32) fox_cumsum(P, (int)blockIdx.x, (LAS float*)(F.lds + RING_OFF), tid);
        for (int m = gw; m < M; m += NGW) prepA_token(P, m, lane);
    }
    GRID_BAR(); STAMP(3);
    { PHASE_BEGIN();
        pg8::Gemm g{P.LA, P.LWT, M, 3072, 128, 4, (size_t)M * 128 * 2}; pg8::StaticOrder S; S.init(M, 3072, F.G, (int)blockIdx.x);
        pg8::EpiLora3 E{P.w0, P.a0, P.DEC, P.AIC, P.G};
        pg8::gemm_phase<pg8::EpiLora3, pg8::StaticOrder, PG8_ALIGN, PG8_SP2>(F.lds + RING_OFF, g, S, E, tid);
    }
    GRID_BAR(); STAMP(4);
    STAMP(5);
    { PHASE_BEGIN(); rk::S1Regs R; int u = (int)blockIdx.x; if (u < 4096) rk::s1_load(P, u, tid, R);
#ifdef PROBE_MASK
      if (blockIdx.x == 0 && F.wave == 0) { unsigned long long t_; asm volatile("s_memrealtime %0\n\ts_waitcnt lgkmcnt(0)" : "=s"(t_) :: "memory"); if (lane == 0) ((volatile LAS unsigned*)((LAS unsigned char*)lds + MISC_OFF))[103] = (unsigned)t_; }
#endif
      for (; u < 4096; u += F.G) rk::s1_unit(P, u, u + F.G, R, F.lds + RING_OFF, tid, F.wave); }
    GRID_BAR(); STAMP(13);
    { PHASE_BEGIN();
        if (blockIdx.x < 32) rk::s2_block(P, (int)blockIdx.x, F.lds + RING_OFF, tid, F.wave);
        {
            static_assert(attn_body::ATTN_LDS_BYTES <= RING_BYTES, "attention LDS");
            const attn_body::AttnTensors AT{(const attn_body::bf16*)(P.PROJ + C_FQ), (const attn_body::bf16*)(P.PROJ + C_FK), (const attn_body::bf16*)(P.PROJ + C_FV), (attn_body::bf16*)(P.MIXED + 1024), P.C2};
            const AttnQueue S{(gu32*)(ws_ + WS_CTL) + CW_QUEUE, F.MISC + 16, tid, xb_xcc_id() & 7u};
            attn_body::attn_phase<AttnQueue>((char*)lds + RING_OFF, AT, S, tid);
            STAMP(14);
        }
    }
    GRID_BAR(); STAMP(6);
    { PHASE_BEGIN();
        for (int m = gw; m < M; m += NGW) post_token(P, m, lane);
    }
    GRID_BAR(); STAMP(7);
    { PHASE_BEGIN();
        pg8::Gemm g{P.MIXED, P.WOT, M, DMODEL, DMODEL}; pg8::StaticOrder S; S.init(M, DMODEL, F.G, (int)blockIdx.x);
        pg8::EpiResNorm E{P.x, P.out, P.XN, P.norm2_g, (float*)(ws_ + WS_SSQ), DMODEL};
        pg8::gemm_phase<pg8::EpiResNorm, pg8::StaticOrder, PG8_ALIGN, PG8_SP2>(F.lds + RING_OFF, g, S, E, tid);
    }
    GRID_BAR(); STAMP(8);
    STAMP(9);
    { PHASE_BEGIN();
        pg8::Gemm g{P.XN, P.WQT, M, 1024, DMODEL}; pg8::StaticOrder S; S.init(M, 1024, F.G, (int)blockIdx.x);
        pg8::EpiBf16RowNorm E{P.QP, 1024, (const float*)(ws_ + WS_SSQ), 1.0f / DMODEL, 1e-6f};
        pg8::gemm_phase<pg8::EpiBf16RowNorm, pg8::StaticOrder, PG8_ALIGN, PG8_SP2>(F.lds + RING_OFF, g, S, E, tid);
    }
    GRID_BAR(); STAMP(10);
    { PHASE_BEGIN(); for (int it = (int)blockIdx.x; it < 8 * (M / 512); it += F.G) peer_topk(P, it & 7, (it >> 3) * 512, F.lds + RING_OFF, tid); }
    GRID_BAR(); STAMP(11);
    { PHASE_BEGIN(); for (int t = gw; t < M; t += NGW) peer_token(P, t, lane); }
#ifdef PROBE_MASK
    GRID_BAR();
    STAMP(12);
    if (blockIdx.x == 0 && wv_ == 0) { asm volatile("s_waitcnt lgkmcnt(0)" ::: "memory"); volatile LAS unsigned* ts_ = (volatile LAS unsigned*)((LAS unsigned char*)lds + MISC_OFF) + 64; unsigned tot = 0;
      for (int k = 0; k < 12; ++k) if ((PROBE_MASK >> k) & 1) tot += ts_[k + 1] - ts_[k];
      if ((PROBE_MASK >> 12) & 1) tot += ts_[13] - ts_[5];
      if ((PROBE_MASK >> 13) & 1) tot += ts_[6] - ts_[13];
      if ((PROBE_MASK >> 15) & 1) tot += ts_[15] - ts_[11];
      if ((PROBE_MASK >> 16) & 1) tot += ts_[12] - ts_[15];
      for (int k = 0; k < 7; ++k) if ((PROBE_MASK >> (17 + k)) & 1) tot += ((volatile LAS unsigned*)((LAS unsigned char*)lds + MISC_OFF))[96 + k];
      if ((PROBE_MASK >> 24) & 1) tot += ts_[16] - ts_[0];
      if ((PROBE_MASK >> 25) & 1) tot += ts_[17] - ts_[16];
      if ((PROBE_MASK >> 26) & 1) tot += ts_[1] - ts_[17];
      if ((PROBE_MASK >> 14) & 1) tot += ts_[14] - ts_[13];
      const unsigned long long t0_ = __builtin_amdgcn_s_memrealtime(); while ((unsigned)(__builtin_amdgcn_s_memrealtime() - t0_) < tot) __builtin_amdgcn_s_sleep(8); }
#endif
}

extern "C" void kernel_launch(void* const* d_in, const int* in_sizes, int n_in, void* d_out, int out_size, void* d_ws, size_t ws_size, hipStream_t stream) {
    static int grid = 0;
    if (grid == 0) {
        if (n_in != 23 || out_size != M * DMODEL || ws_size < WS_END) { fprintf(stderr, "kernel_launch: unexpected shapes (n_in %d, out %d, ws %zu); nothing launched\n", n_in, out_size, ws_size); grid = -1; return; }
        int dev = 0, cus = 0;
        if (hipGetDevice(&dev) != hipSuccess || hipDeviceGetAttribute(&cus, hipDeviceAttributeMultiprocessorCount, dev) != hipSuccess) { grid = -1; return; }
        if (hipFuncSetAttribute((const void*)hymba_fwd, hipFuncAttributeMaxDynamicSharedMemorySize, LDS_BYTES) != hipSuccess) { fprintf(stderr, "kernel_launch: hipFuncSetAttribute failed\n"); grid = -1; return; }
        int per_cu = 0;
        if (hipOccupancyMaxActiveBlocksPerMultiprocessor(&per_cu, (const void*)hymba_fwd, NWAVES * 64, LDS_BYTES) != hipSuccess || per_cu < 1) fprintf(stderr, "kernel_launch: occupancy query reports %d\n", per_cu);
        (void)hipGetLastError();
        grid = cus;
    }
    if (grid < 0) return;
    if (hipMemsetAsync((char*)d_ws + WS_CTL, 0, CTL_ZERO_BYTES, stream) != hipSuccess) return;
    Args a{};
    for (int i = 0; i < 23; ++i) a.in[i] = (const float*)d_in[i];
    a.out = (float*)d_out; a.ws = (unsigned char*)d_ws;
    hipLaunchKernelGGL(hymba_fwd, dim3(grid), dim3(NWAVES * 64), LDS_BYTES, stream, a);
}
```

```cpp
#include <hip/hip_runtime.h>
#include <cstdio>
#include <cstdint>
namespace pg8 {
#define PG8_LAS __attribute__((address_space(3)))
typedef unsigned short bf16_t;
typedef short bf16x8 __attribute__((ext_vector_type(8)));
typedef float f32x4 __attribute__((ext_vector_type(4)));
typedef unsigned u32x4 __attribute__((ext_vector_type(4)));
constexpr int BM = 256, BK = 64, HALF = 128, HTB = HALF * BK * 2  , STAGE_BYTES = 8 * HTB, NXCD = 8, WGM = 8;

__host__ __device__ __forceinline__ int lds_byte(int r, int c) { const int st = (r >> 4) * 2 + (c >> 5), rr = r & 15, cc = c & 31, ob = rr * 64 + cc * 2; return st * 1024 + (ob ^ (((ob >> 9) & 1) << 5)); }
__host__ __device__ __forceinline__ void stage_rc(int b, int& R, int& C) { const int st = b / 1024, sb = b % 1024, swz = sb ^ (((sb >> 9) & 1) << 5); R = (st >> 1) * 16 + swz / 64; C = (st & 1) * 32 + (swz % 64) / 2; }
__host__ __device__ __forceinline__ int perm32(int rho) { const int n = rho >> 4, i = rho & 15; return 8 * (i >> 2) + 4 * n + (i & 3); }

struct Unit { int pm, pn; };
struct Gemm { const bf16_t* A; const bf16_t* Bt; int M, N, K; int adiv = 1 << 20; size_t astride = 0; };

struct StaticOrder {
    int nM, nN, nwg, G, c;
    __host__ __device__ void init(int M, int N, int G_, int c_) { nM = M / BM; nN = N / BM; nwg = nM * nN; G = G_; c = c_; }
    __host__ __device__ bool next(int i, Unit& u) const {
        const long L = (long)i * G + c; if (L >= nwg) return false;
        int wgid = (int)L; { const int q = nwg / NXCD, r = nwg % NXCD, xcd = wgid % NXCD, off = wgid / NXCD; wgid = (xcd < r ? xcd * (q + 1) : r * (q + 1) + (xcd - r) * q) + off; }
        const int nig = WGM * nN, gid = wgid / nig, fm = gid * WGM, gsz = (nM - fm) < WGM ? (nM - fm) : WGM;
        u.pm = fm + ((wgid % nig) % gsz); u.pn = (wgid % nig) / gsz; return true;
    }
    __device__ __forceinline__ void a_ready(const Unit&) const {}
    __device__ __forceinline__ void done(const Unit&) const {}
};

__device__ __forceinline__ unsigned cvt_pk_bf16(float lo, float hi) { unsigned r; asm volatile("v_cvt_pk_bf16_f32 %0, %1, %2" : "=v"(r) : "v"(lo), "v"(hi)); return r; }
typedef float f32x2 __attribute__((ext_vector_type(2)));
__device__ __forceinline__ f32x2 gelu_pk(f32x2 v) {
    const f32x2 av = __builtin_elementwise_abs(v), d = av * 0.2316418882f + 1.0f;
    f32x2 t; t.x = __builtin_amdgcn_rcpf(d.x); t.y = __builtin_amdgcn_rcpf(d.y);
    f32x2 q = t * 0.5307027145f + (-0.7265760135f); q = q * t + 0.7107068705f; q = q * t + (-0.142248368f); q = q * t + 0.127414796f; q = q * t;
    const f32x2 s = (v * v) * (-0.72134752044f);
    f32x2 e; e.x = __builtin_amdgcn_exp2f(s.x); e.y = __builtin_amdgcn_exp2f(s.y);
    const f32x2 m = v * (q * e), r = v - m;
    f32x2 o; o.x = v.x < 0.f ? m.x : r.x; o.y = v.y < 0.f ? m.y : r.y; return o;
}

template <int ACT  > struct EpiBf16 {
    static constexpr bool PERM = true, AFTER_DRAIN = false; static_assert(ACT == 0 || ACT == 1, "EpiBf16: ACT is 0 (none) or 1 (gelu_pk)");
    bf16_t* O; int ldc; const float* bias; int split_cols; size_t split_stride; float scale0;
    __device__ __forceinline__ void operator()(const f32x4 (&acc)[2][2][4][2], const Unit& u, int wr, int wc, int fr, int fq) const {
        const int row0 = u.pm * BM + wr * 64 + fr; int colt = u.pn * BM; bf16_t* base = O;
        float sc = 1.f; if (split_cols) { const int t = colt / split_cols; base += (size_t)t * split_stride; colt -= t * split_cols; if (t == 0) sc = scale0; }
        const int col0 = colt + wc * 32 + 8 * fq, bcol0 = u.pn * BM + wc * 32 + 8 * fq;
        f32x4 bv[2][2];
#pragma unroll
        for (int bj = 0; bj < 2; ++bj)
#pragma unroll
            for (int n = 0; n < 2; ++n) bv[bj][n] = bias ? *(const f32x4*)(bias + bcol0 + bj * HALF + 4 * n) : (f32x4){0.f, 0.f, 0.f, 0.f};
#pragma unroll
        for (int ai = 0; ai < 2; ++ai)
#pragma unroll
            for (int m = 0; m < 4; ++m) { bf16_t* rowp = base + (size_t)(row0 + ai * HALF + m * 16) * ldc + col0;
#pragma unroll
                for (int bj = 0; bj < 2; ++bj) { f32x4 v0 = acc[ai][bj][m][0] + bv[bj][0], v1 = acc[ai][bj][m][1] + bv[bj][1];
                    if (ACT == 1) { f32x2 a = gelu_pk((f32x2){v0[0], v0[1]}), b = gelu_pk((f32x2){v0[2], v0[3]}), c = gelu_pk((f32x2){v1[0], v1[1]}), d = gelu_pk((f32x2){v1[2], v1[3]});
                        v0 = (f32x4){a.x, a.y, b.x, b.y}; v1 = (f32x4){c.x, c.y, d.x, d.y}; }
                    v0 = v0 * sc; v1 = v1 * sc; u32x4 w; w.x = cvt_pk_bf16(v0[0], v0[1]); w.y = cvt_pk_bf16(v0[2], v0[3]); w.z = cvt_pk_bf16(v1[0], v1[1]); w.w = cvt_pk_bf16(v1[2], v1[3]);
                    *(u32x4*)(rowp + bj * HALF) = w; } }
    }
};

typedef unsigned u32x2 __attribute__((ext_vector_type(2)));
struct EpiResF32 {
    static constexpr bool PERM = false, AFTER_DRAIN = false;
    const float* base; float* out; int ldc;
    __device__ __forceinline__ void operator()(const f32x4 (&acc)[2][2][4][2], const Unit& u, int wr, int wc, int fr, int fq) const {
        const int col0 = u.pn * BM + wc * 32 + 4 * fq;
#pragma unroll
        for (int ai = 0; ai < 2; ++ai)
#pragma unroll
            for (int m = 0; m < 4; ++m) { const size_t off = (size_t)(u.pm * BM + ai * HALF + wr * 64 + m * 16 + fr) * ldc + col0;
#pragma unroll
                for (int bj = 0; bj < 2; ++bj)
#pragma unroll
                    for (int n = 0; n < 2; ++n) { const f32x4 b = *(const f32x4*)(base + off + bj * HALF + n * 16); *(f32x4*)(out + off + bj * HALF + n * 16) = b + acc[ai][bj][m][n]; }
                asm volatile("" ::: "memory"); }
    }
};
struct EpiLora3 {
    static constexpr bool PERM = false, AFTER_DRAIN = false;
    const float* w0; const float* a0; float* dec; bf16_t* aic; bf16_t* gg;
    __device__ __forceinline__ void operator()(const f32x4 (&acc)[2][2][4][2], const Unit& u, int wr, int wc, int fr, int fq) const {
        const int br = u.pn >> 2; const int col0 = (u.pn & 3) * BM + wc * 32 + 4 * fq;
        const float* vec = (br == 0) ? w0 : (br == 1) ? a0 : nullptr; bf16_t* outh = (br == 1) ? aic : gg;
#pragma unroll
        for (int bj = 0; bj < 2; ++bj)
#pragma unroll
            for (int n = 0; n < 2; ++n) { const int col = col0 + bj * HALF + n * 16;
                f32x4 p = (f32x4){0.f, 0.f, 0.f, 0.f}; if (vec) p = *(const f32x4*)(vec + col);
#pragma unroll
                for (int ai = 0; ai < 2; ++ai)
#pragma unroll
                    for (int m = 0; m < 4; ++m) { const size_t off = (size_t)(u.pm * BM + ai * HALF + wr * 64 + m * 16 + fr) * 1024 + col;
                        const f32x4 z = acc[ai][bj][m][n] + p;
                        if (br == 0) *(f32x4*)(dec + off) = z;
                        else { u32x2 w; w.x = cvt_pk_bf16(z[0], z[1]); w.y = cvt_pk_bf16(z[2], z[3]); *(u32x2*)(outh + off) = w; } } }
    }
};
struct EpiResNorm {
    static constexpr bool PERM = false, AFTER_DRAIN = false;
    const float* base; float* out; bf16_t* hb; const float* g; float* ssq; int ldc;
    __device__ __forceinline__ void operator()(const f32x4 (&acc)[2][2][4][2], const Unit& u, int wr, int wc, int fr, int fq) const {
        const int col0 = u.pn * BM + wc * 32 + 4 * fq;
        f32x4 gv[2][2];
#pragma unroll
        for (int bj = 0; bj < 2; ++bj)
#pragma unroll
            for (int n = 0; n < 2; ++n) gv[bj][n] = *(const f32x4*)(g + col0 + bj * HALF + n * 16);
#pragma unroll
        for (int ai = 0; ai < 2; ++ai)
#pragma unroll
            for (int m = 0; m < 4; ++m) { const int row = u.pm * BM + ai * HALF + wr * 64 + m * 16 + fr; const size_t off = (size_t)row * ldc + col0; float sq = 0.f;
#pragma unroll
                for (int bj = 0; bj < 2; ++bj)
#pragma unroll
                    for (int n = 0; n < 2; ++n) { const f32x4 hv = *(const f32x4*)(base + off + bj * HALF + n * 16) + acc[ai][bj][m][n]; *(f32x4*)(out + off + bj * HALF + n * 16) = hv;
                        sq += (hv[0] * hv[0] + hv[1] * hv[1]) + (hv[2] * hv[2] + hv[3] * hv[3]);
                        const f32x4 hg = hv * gv[bj][n]; u32x2 w; w.x = cvt_pk_bf16(hg[0], hg[1]); w.y = cvt_pk_bf16(hg[2], hg[3]); *(u32x2*)(hb + off + bj * HALF + n * 16) = w; }
                sq += __shfl_xor(sq, 16); sq += __shfl_xor(sq, 32);
                if (fq == 0) ssq[(size_t)row * 32 + u.pn * 4 + wc] = sq;
                asm volatile("" ::: "memory"); }
    }
};
struct EpiBf16RowNorm {
    static constexpr bool PERM = true, AFTER_DRAIN = false;
    bf16_t* O; int ldc; const float* ssq; float inv_n, eps;
    __device__ __forceinline__ void operator()(const f32x4 (&acc)[2][2][4][2], const Unit& u, int wr, int wc, int fr, int fq) const {
        const int row0 = u.pm * BM + wr * 64 + fr, col0 = u.pn * BM + wc * 32 + 8 * fq;
#pragma unroll
        for (int ai = 0; ai < 2; ++ai)
#pragma unroll
            for (int m = 0; m < 4; ++m) { const int row = row0 + ai * HALF + m * 16; const f32x4 s0 = *(const f32x4*)(ssq + (size_t)row * 32 + fq * 8), s1 = *(const f32x4*)(ssq + (size_t)row * 32 + fq * 8 + 4); float ss = ((s0[0] + s0[1]) + (s0[2] + s0[3])) + ((s1[0] + s1[1]) + (s1[2] + s1[3]));
                ss += __shfl_xor(ss, 16); ss += __shfl_xor(ss, 32); const float rs = 1.0f / sqrtf(ss * inv_n + eps); bf16_t* rowp = O + (size_t)row * ldc + col0;
#pragma unroll
                for (int bj = 0; bj < 2; ++bj) { const f32x4 v0 = acc[ai][bj][m][0] * rs, v1 = acc[ai][bj][m][1] * rs;
                    u32x4 w; w.x = cvt_pk_bf16(v0[0], v0[1]); w.y = cvt_pk_bf16(v0[2], v0[3]); w.z = cvt_pk_bf16(v1[0], v1[1]); w.w = cvt_pk_bf16(v1[2], v1[3]);
                    *(u32x4*)(rowp + bj * HALF) = w; } }
    }
};
template <class Epi, class Sched, bool ALIGN_EPI = false, bool SP2 = false>
__device__ __forceinline__ void gemm_phase(PG8_LAS unsigned char* lds, const Gemm g, const Sched& S, const Epi& E, int tid_in) {
    int tid_ = tid_in; asm volatile("" : "+v"(tid_));
    const int tid = tid_, wid = __builtin_amdgcn_readfirstlane(tid >> 6), lane = tid & 63, wr = wid >> 2, wc = wid & 3, fr = lane & 15, fq = lane >> 4;
    const int K = g.K, nt = K / BK;
    unsigned voffA[2], voffB[2];
#pragma unroll
    for (int i = 0; i < 2; ++i) { int R, C; stage_rc(tid * 16 + i * 8192, R, C); const int Rb = Epi::PERM ? ((R & ~31) + perm32(R & 31)) : R;
        voffA[i] = (unsigned)(R * K + C) * 2u; voffB[i] = (unsigned)(Rb * K + C) * 2u; }
    const size_t kstep = (size_t)(BK * 2);
    const size_t hstep = (size_t)HALF * K * 2;
    const size_t tstep = 2 * hstep;
    const unsigned ldsw = (unsigned)wid * 1024u;
    const int aoff = lds_byte(wr * 64 + fr, fq * 8), boff = lds_byte(wc * 32 + fr, fq * 8);
#define PG8_SA(b, h) (((b) * 2 + (h)) * HTB)
#define PG8_SB(b, h) ((4 + (b) * 2 + (h)) * HTB)
#define PG8_STAGE(bufoff, gbase, voff) do { _Pragma("unroll") for (int _i = 0; _i < 2; ++_i) \
        __builtin_amdgcn_global_load_lds((const unsigned*)((const char*)(gbase) + (voff)[_i]), (PG8_LAS unsigned*)(lds + (bufoff) + ldsw + _i * 8192), 16, 0, 0); } while (0)
#define PG8_LDA(dst, b, h) do { _Pragma("unroll") for (int m = 0; m < 4; ++m) _Pragma("unroll") for (int k = 0; k < 2; ++k) dst[m][k] = *(const PG8_LAS bf16x8*)(lds + PG8_SA(b, h) + aoff + m * 2048 + k * 1024); } while (0)
#define PG8_LDB(dst, b, h) do { _Pragma("unroll") for (int n = 0; n < 2; ++n) _Pragma("unroll") for (int k = 0; k < 2; ++k) dst[n][k] = *(const PG8_LAS bf16x8*)(lds + PG8_SB(b, h) + boff + n * 2048 + k * 1024); } while (0)
#define PG8_MMA(ai, bj, At, Bt) do { __builtin_amdgcn_s_setprio(1); _Pragma("unroll") for (int m = 0; m < 4; ++m) _Pragma("unroll") for (int n = 0; n < 2; ++n) _Pragma("unroll") for (int k = 0; k < 2; ++k) \
        acc[ai][bj][m][n] = __builtin_amdgcn_mfma_f32_16x16x32_bf16(Bt[n][k], At[m][k], acc[ai][bj][m][n], 0, 0, 0); __builtin_amdgcn_s_setprio(0); } while (0)
#define PG8_WAIT_V(n) asm volatile("s_waitcnt vmcnt(" #n ")" ::: "memory")
#define PG8_WAIT_L(n) asm volatile("s_waitcnt lgkmcnt(" #n ")" ::: "memory")
#define PG8_BAR __builtin_amdgcn_s_barrier()
#define PG8_SCHED __builtin_amdgcn_sched_barrier(0)
    Unit cur, nxt; int ui = 0;
    if (!S.next(0, cur)) return;
    f32x4 acc[2][2][4][2];
#pragma unroll
    for (int a = 0; a < 2; ++a)
#pragma unroll
        for (int b = 0; b < 2; ++b)
#pragma unroll
            for (int m = 0; m < 4; ++m)
#pragma unroll
                for (int n = 0; n < 2; ++n) acc[a][b][m][n] = (f32x4){0.f, 0.f, 0.f, 0.f};
    bf16x8 At[4][2], B0[2][2], B1[2][2];
    const char* cA = (const char*)g.A + (size_t)cur.pm * tstep + (size_t)(cur.pn / g.adiv) * g.astride; const char* cB = (const char*)g.Bt + (size_t)cur.pn * tstep;
    S.a_ready(cur);
    if constexpr (SP2) {
        PG8_STAGE(PG8_SB(0, 0), cB, voffB); PG8_STAGE(PG8_SB(0, 1), cB + hstep, voffB); PG8_STAGE(PG8_SA(0, 0), cA, voffA); PG8_STAGE(PG8_SA(0, 1), cA + hstep, voffA);
        if (wr == 1) PG8_BAR;
        PG8_WAIT_V(2); PG8_BAR;
        PG8_STAGE(PG8_SB(1, 0), cB + kstep, voffB); PG8_STAGE(PG8_SA(1, 0), cA + kstep, voffA); PG8_STAGE(PG8_SB(1, 1), cB + hstep + kstep, voffB);
        PG8_WAIT_V(6); PG8_BAR;
    } else {
        PG8_STAGE(PG8_SB(0, 0), cB, voffB); PG8_STAGE(PG8_SA(0, 0), cA, voffA); PG8_STAGE(PG8_SB(0, 1), cB + hstep, voffB); PG8_STAGE(PG8_SA(0, 1), cA + hstep, voffA);
        if (wr == 1) PG8_BAR;
        PG8_WAIT_V(4); PG8_BAR;
        PG8_STAGE(PG8_SB(1, 0), cB + kstep, voffB); PG8_STAGE(PG8_SA(1, 0), cA + kstep, voffA); PG8_STAGE(PG8_SB(1, 1), cB + hstep + kstep, voffB);
        PG8_WAIT_V(6); PG8_BAR;
    }
    for (;;) {
        const bool has_next = S.next(ui + 1, nxt);
        const char* nA = has_next ? (const char*)g.A + (size_t)nxt.pm * tstep + (size_t)(nxt.pn / g.adiv) * g.astride : cA; const char* nB = has_next ? (const char*)g.Bt + (size_t)nxt.pn * tstep : cB;
        for (int t = 0; t < nt; t += 2) {
            const bool last = (t == nt - 2);
            const char* a1 = cA + (size_t)(t + 1) * kstep;
            const char* a2 = last ? nA : cA + (size_t)(t + 2) * kstep; const char* b2 = last ? nB : cB + (size_t)(t + 2) * kstep;
            const char* a3 = a2 + kstep; const char* b3 = b2 + kstep;
            if (last && has_next) S.a_ready(nxt);
            if constexpr (SP2) {
            PG8_LDB(B0, 0, 0); PG8_LDB(B1, 0, 1); PG8_SCHED; PG8_LDA(At, 0, 0); PG8_STAGE(PG8_SA(1, 1), a1 + hstep, voffA);
            PG8_WAIT_V(8); PG8_WAIT_L(0); PG8_BAR; PG8_MMA(0, 0, At, B0); PG8_MMA(0, 1, At, B1); PG8_BAR; PG8_SCHED;
            PG8_LDA(At, 0, 1); PG8_STAGE(PG8_SB(0, 0), b2, voffB); PG8_STAGE(PG8_SB(0, 1), b2 + hstep, voffB); PG8_STAGE(PG8_SA(0, 0), a2, voffA);
            PG8_WAIT_V(8); PG8_WAIT_L(0); PG8_BAR; PG8_MMA(1, 0, At, B0); PG8_MMA(1, 1, At, B1); PG8_BAR; PG8_SCHED;
            PG8_LDB(B0, 1, 0); PG8_LDB(B1, 1, 1); PG8_SCHED; PG8_LDA(At, 1, 0); PG8_STAGE(PG8_SA(0, 1), a2 + hstep, voffA);
            PG8_WAIT_V(8); PG8_WAIT_L(0); PG8_BAR; PG8_MMA(0, 0, At, B0); PG8_MMA(0, 1, At, B1); PG8_BAR; PG8_SCHED;
            PG8_LDA(At, 1, 1); PG8_STAGE(PG8_SB(1, 0), b3, voffB); PG8_STAGE(PG8_SB(1, 1), b3 + hstep, voffB); PG8_STAGE(PG8_SA(1, 0), a3, voffA);
            PG8_WAIT_V(8); PG8_WAIT_L(0); PG8_BAR; PG8_MMA(1, 0, At, B0); PG8_MMA(1, 1, At, B1); PG8_BAR; PG8_SCHED;
            } else {
            PG8_LDB(B0, 0, 0); PG8_SCHED; PG8_LDA(At, 0, 0); PG8_STAGE(PG8_SA(1, 1), a1 + hstep, voffA);
            PG8_WAIT_L(8); PG8_BAR; PG8_WAIT_L(0); PG8_MMA(0, 0, At, B0); PG8_BAR; PG8_SCHED;
            PG8_LDB(B1, 0, 1); PG8_STAGE(PG8_SB(0, 0), b2, voffB);
            PG8_BAR; PG8_WAIT_L(0); PG8_MMA(0, 1, At, B1); PG8_BAR;
            PG8_LDA(At, 0, 1); PG8_STAGE(PG8_SA(0, 0), a2, voffA);
            PG8_BAR; PG8_WAIT_L(0); PG8_MMA(1, 0, At, B0); PG8_BAR; PG8_SCHED;
            PG8_STAGE(PG8_SB(0, 1), b2 + hstep, voffB);
            PG8_WAIT_V(6); PG8_BAR; PG8_MMA(1, 1, At, B1); PG8_BAR;
            PG8_LDB(B0, 1, 0); PG8_SCHED; PG8_LDA(At, 1, 0); PG8_STAGE(PG8_SA(0, 1), a2 + hstep, voffA);
            PG8_WAIT_L(8); PG8_BAR; PG8_WAIT_L(0); PG8_MMA(0, 0, At, B0); PG8_BAR; PG8_SCHED;
            PG8_LDB(B1, 1, 1); PG8_STAGE(PG8_SB(1, 0), b3, voffB);
            PG8_BAR; PG8_WAIT_L(0); PG8_MMA(0, 1, At, B1); PG8_BAR;
            PG8_LDA(At, 1, 1); PG8_STAGE(PG8_SA(1, 0), a3, voffA);
            PG8_BAR; PG8_WAIT_L(0); PG8_MMA(1, 0, At, B0); PG8_BAR; PG8_SCHED;
            PG8_STAGE(PG8_SB(1, 1), b3 + hstep, voffB);
            PG8_WAIT_V(6); PG8_BAR; PG8_MMA(1, 1, At, B1); PG8_BAR;
            }
        }
        if constexpr (ALIGN_EPI) { if (wr == 0) PG8_BAR; }
        if constexpr (!Epi::AFTER_DRAIN) { E(acc, cur, wr, wc, fr, fq); S.done(cur); }
        if (!has_next) break;
#pragma unroll
        for (int a = 0; a < 2; ++a)
#pragma unroll
            for (int b = 0; b < 2; ++b)
#pragma unroll
                for (int m = 0; m < 4; ++m)
#pragma unroll
                    for (int n = 0; n < 2; ++n) acc[a][b][m][n] = (f32x4){0.f, 0.f, 0.f, 0.f};
        cur = nxt; cA = nA; cB = nB; ++ui;
        if constexpr (ALIGN_EPI) { if (wr == 1) PG8_BAR; }
    }
    PG8_WAIT_V(0);
    if constexpr (!ALIGN_EPI) { if (wr == 0) PG8_BAR; }
    PG8_BAR;
    if constexpr (Epi::AFTER_DRAIN) { E.fused(acc, cur, wr, wc, fr, fq, lds, wid, lane); S.done(cur); }
#undef PG8_SA
#undef PG8_SB
#undef PG8_STAGE
#undef PG8_LDA
#undef PG8_LDB
#undef PG8_MMA
#undef PG8_WAIT_V
#undef PG8_WAIT_L
#undef PG8_BAR
#undef PG8_SCHED
}
}

#ifndef PG8_SP2
#define PG8_SP2 true
#endif
#ifndef PG8_ALIGN
#define PG8_ALIGN true
#endif
#include <hip/hip_bf16.h>
#include <cmath>
namespace attn_body {
using bf16=__hip_bfloat16;
using bf16x8=__attribute__((ext_vector_type(8)))short;
using s16x4=__attribute__((ext_vector_type(4)))short;
using f32x16=__attribute__((ext_vector_type(16)))float;
using u32x4=__attribute__((ext_vector_type(4)))unsigned;
constexpr int BATCH=2,NHEAD=16,SEQ=8192,D=64,DM=6656,DMO=2048;
constexpr int NW=8,QBLK=32,QB=QBLK*NW,KVBLK=64,NQB=SEQ/QB;
constexpr int ATTN_UNIT_ROWS=QB;
__device__ __forceinline__ int crow(int r,int hi){return (r&3)+8*(r>>2)+4*hi;}
#define SBAR() __builtin_amdgcn_sched_barrier(0)
__device__ __forceinline__ void cmask(f32x16&p0,f32x16&p1,int jb,int qrel,int hi){
  const float NEG=-INFINITY; int kb=64*jb+4*hi;
  #pragma unroll
  for(int r=0;r<16;++r){int kv=kb+(r&3)+8*(r>>2); if(kv>qrel)p0[r]=NEG; if(kv+32>qrel)p1[r]=NEG;}
}

constexpr int NSLOT=3, SLOTB=8192;
constexpr int LDS_K=0, LDS_V=NSLOT*SLOTB, LDS_WS=2*NSLOT*SLOTB, LDS_OST=LDS_WS+NW*64*4, LDS_CK=LDS_OST+NW*4096, LDS_BYTES=LDS_CK+SEQ*4;
constexpr float C2=0.125f*1.4426950408889634f;
__device__ __forceinline__ void glds16(const void*gsrc,unsigned lds_dst){unsigned keep;
  asm volatile("s_mov_b32 %0, m0\n\ts_mov_b32 m0, %2\n\ts_nop 0\n\tglobal_load_lds_dwordx4 %1, off\n\ts_mov_b32 m0, %0":"=&s"(keep):"v"(gsrc),"s"(lds_dst):"memory");}
__device__ __forceinline__ void glds16s(const void*sbase,unsigned voff,unsigned lds_dst){unsigned keep;
  asm volatile("s_mov_b32 %0, m0\n\ts_mov_b32 m0, %3\n\ts_nop 0\n\tglobal_load_lds_dwordx4 %1, %2\n\ts_mov_b32 m0, %0":"=&s"(keep):"v"(voff),"s"(sbase),"s"(lds_dst):"memory");}
__device__ __forceinline__ float max3f(float a,float b,float c){float r;asm("v_max3_f32 %0, %1, %2, %3":"=v"(r):"v"(a),"v"(b),"v"(c));return r;}
__device__ __forceinline__ float max2f(float a,float b){float r;asm("v_max_f32_e32 %0, %1, %2":"=v"(r):"v"(a),"v"(b));return r;}
__device__ __forceinline__ float fadd_s(float a,float b){float r;asm("v_add_f32_e32 %0, %1, %2":"=v"(r):"v"(a),"v"(b));return r;}
__device__ __forceinline__ float fsub_s(float a,float b){float r;asm("v_sub_f32_e32 %0, %1, %2":"=v"(r):"v"(a),"v"(b));return r;}
typedef float f32x2_t __attribute__((ext_vector_type(2))); typedef __bf16 bf16x2_t __attribute__((ext_vector_type(2)));
__device__ __forceinline__ unsigned cvtpk_s(float lo,float hi){f32x2_t v={lo,hi};bf16x2_t b=__builtin_convertvector(v,bf16x2_t);return __builtin_bit_cast(unsigned,b);}
#define WAIT_BAR(N) asm volatile("s_waitcnt vmcnt(" #N ") lgkmcnt(0)\n\ts_barrier":::"memory")

__device__ __forceinline__ void qkt(f32x16&p0,f32x16&p1,const char*Kslot,const bf16x8*qr,int r32,int hi){
  const char*kb=Kslot+hi*1024+r32*16;
  #pragma unroll
  for(int d0=0;d0<4;++d0){
    const bf16x8 b0=*reinterpret_cast<const bf16x8*>(kb+d0*2048);
    const bf16x8 b1=*reinterpret_cast<const bf16x8*>(kb+d0*2048+512);
    p0=__builtin_amdgcn_mfma_f32_32x32x16_bf16(b0,qr[d0],p0,0,0,0);p1=__builtin_amdgcn_mfma_f32_32x32x16_bf16(b1,qr[d0],p1,0,0,0);}
}
typedef __attribute__((address_space(3))) const char* lds_cptr;
typedef short v4i16_t __attribute__((ext_vector_type(4)));
__device__ __forceinline__ void kload8(bf16x8*kf,lds_cptr kp){
  kf[0]=*(const __attribute__((address_space(3))) bf16x8*)(kp);      kf[1]=*(const __attribute__((address_space(3))) bf16x8*)(kp+512);
  kf[2]=*(const __attribute__((address_space(3))) bf16x8*)(kp+2048); kf[3]=*(const __attribute__((address_space(3))) bf16x8*)(kp+2560);
  kf[4]=*(const __attribute__((address_space(3))) bf16x8*)(kp+4096); kf[5]=*(const __attribute__((address_space(3))) bf16x8*)(kp+4608);
  kf[6]=*(const __attribute__((address_space(3))) bf16x8*)(kp+6144); kf[7]=*(const __attribute__((address_space(3))) bf16x8*)(kp+6656);
}
__device__ __forceinline__ void kload2(bf16x8*kf,lds_cptr kp,int j){ kf[2*j]=*(const __attribute__((address_space(3))) bf16x8*)(kp+j*2048); kf[2*j+1]=*(const __attribute__((address_space(3))) bf16x8*)(kp+j*2048+512); }
__device__ __forceinline__ s16x4 vtr(lds_cptr p){ return __builtin_bit_cast(s16x4,__builtin_amdgcn_ds_read_tr16_b64_v4i16((__attribute__((address_space(3))) v4i16_t*)p)); }
typedef float f32x4c __attribute__((ext_vector_type(4)));
__device__ __forceinline__ void ldck(f32x16&c0,f32x16&c1,lds_cptr ckt){
  #pragma unroll
  for(int g=0;g<4;++g){ const f32x4c a=*(const __attribute__((address_space(3))) f32x4c*)(ckt+32*g); const f32x4c b=*(const __attribute__((address_space(3))) f32x4c*)(ckt+128+32*g);
    c0[4*g]=a[0];c0[4*g+1]=a[1];c0[4*g+2]=a[2];c0[4*g+3]=a[3]; c1[4*g]=b[0];c1[4*g+1]=b[1];c1[4*g+2]=b[2];c1[4*g+3]=b[3]; }
}
__device__ __forceinline__ float rowmax(const f32x16&p0,const f32x16&p1){
  float a=max3f(p0[0],p0[1],p1[0]),b=max3f(p0[2],p0[3],p1[1]);a=max3f(a,p1[2],p1[3]);
  #pragma unroll
  for(int r=4;r<16;r+=4){a=max3f(a,p0[r],p0[r+1]);b=max3f(b,p0[r+2],p0[r+3]);a=max3f(a,p1[r],p1[r+1]);b=max3f(b,p1[r+2],p1[r+3]);}
  const float m=max2f(a,b);
  auto rr=__builtin_amdgcn_permlane32_swap(__float_as_uint(m),__float_as_uint(m),false,false);
  return max2f(__uint_as_float(rr[0]),__uint_as_float(rr[1]));
}
__device__ __forceinline__ void pv(f32x16*o,int vb,bf16x8 pa0,bf16x8 pa1,bf16x8 pa2,bf16x8 pa3){
  #pragma unroll
  for(int d0=0;d0<2;++d0){s16x4 lo[4],hi[4];
    #pragma unroll
    for(int ks=0;ks<4;++ks){
      asm volatile("ds_read_b64_tr_b16 %0,%1 offset:%c2":"=&v"(lo[ks]):"v"(vb),"i"(d0*4096+ks*1024):"memory");
      asm volatile("ds_read_b64_tr_b16 %0,%1 offset:%c2":"=&v"(hi[ks]):"v"(vb),"i"(d0*4096+ks*1024+512):"memory");}
    asm volatile("s_waitcnt lgkmcnt(0)":::"memory");SBAR();
    #define PK(k) (bf16x8){lo[k][0],lo[k][1],lo[k][2],lo[k][3],hi[k][0],hi[k][1],hi[k][2],hi[k][3]}
    o[d0]=__builtin_amdgcn_mfma_f32_32x32x16_bf16(pa0,PK(0),o[d0],0,0,0);
    o[d0]=__builtin_amdgcn_mfma_f32_32x32x16_bf16(pa1,PK(1),o[d0],0,0,0);
    o[d0]=__builtin_amdgcn_mfma_f32_32x32x16_bf16(pa2,PK(2),o[d0],0,0,0);
    o[d0]=__builtin_amdgcn_mfma_f32_32x32x16_bf16(pa3,PK(3),o[d0],0,0,0);
    #undef PK
  }
}

#ifndef ATTN_STORE16
#define ATTN_STORE16(p,v) (*(u32x4*)(p)=(v))
#endif
template<int THRL> __device__ __forceinline__ void attn_unit(int b,int h,int qb,const bf16*Q,const bf16*K,const bf16*V,bf16*O,const float*C2G,char*shm,int tid_in){
  int tid_=tid_in; asm volatile("":"+v"(tid_)); const int tid=tid_,lane=tid&63,r32=lane&31,hi=lane>>5; const int wid=__builtin_amdgcn_readfirstlane(tid>>6);
  const long rowbase=(long)b*SEQ; const int q0=qb*QB;
  const bf16*Qw=Q+(rowbase+q0+wid*QBLK)*DM+h*D;
  const bf16*Kh0=K+rowbase*DM+h*D,*Vh0=V+rowbase*DM+h*D;
  const unsigned lds0=(unsigned)(uintptr_t)shm;
  float*wsf=(float*)(shm+LDS_WS)+wid*64;
  const unsigned koff=(unsigned)(lane*DM+wid*8)*2u;
  const unsigned voff=(unsigned)((16*(wid&3)+(lane>>2))*DM+(wid>>2)*32+(lane&3)*8)*2u;
  const unsigned kdst=lds0+LDS_K+wid*1024, vdst=lds0+LDS_V+wid*1024;
  #define DMA_K(t,slot) glds16s(Kh+(long)(t)*KVBLK*DM,koff,(unsigned)__builtin_amdgcn_readfirstlane(kdst+(slot)))
  #define DMA_V(t,slot) glds16s(Vh+(long)(t)*KVBLK*DM,voff,(unsigned)__builtin_amdgcn_readfirstlane(vdst+(slot)))
  const int vb0=(int)(lds0+LDS_V)+((lane>>4)&1)*32+(lane&3)*8+(4*hi+((lane&15)>>2))*64;
  const char*Kbase=shm+LDS_K; bf16x8 kf[8];
  const lds_cptr shm3=(lds_cptr)shm; const lds_cptr kp0=shm3+LDS_K+hi*1024+r32*16; const lds_cptr vp0=shm3+LDS_V+((lane>>4)&1)*32+(lane&3)*8+(4*hi+((lane&15)>>2))*64;
  const int NT0=(q0+QB)/KVBLK;
  { const float*csrc=C2G+(long)(b*NHEAD+h)*SEQ; const int n4=(q0+QB)/4;
    for(int i4=tid;i4<n4;i4+=NW*64){ const f32x4c v=*(const f32x4c*)(csrc+4*i4); *(__attribute__((address_space(3))) f32x4c*)(shm3+LDS_CK+16*i4)=v; } }
  asm volatile("s_waitcnt vmcnt(0) lgkmcnt(0)\n\ts_barrier":::"memory");
  const float cq2=*(const __attribute__((address_space(3))) float*)(shm3+LDS_CK+4*(q0+wid*QBLK+r32));
  int t0;
  { const float thr=*(const __attribute__((address_space(3))) float*)(shm3+LDS_CK+4*q0)+164.0f; int lo=0,hi_=NT0-4;
    while(lo<hi_){ const int mid=(lo+hi_)>>1; if(*(const __attribute__((address_space(3))) float*)(shm3+LDS_CK+4*(64*mid+63))>thr)lo=mid+1; else hi_=mid; }
    t0=__builtin_amdgcn_readfirstlane(lo&~1); }
  const int NT=NT0-t0;
  const bf16*Kh=Kh0+(long)t0*KVBLK*DM,*Vh=Vh0+(long)t0*KVBLK*DM;
  const lds_cptr ckp0=shm3+LDS_CK+16*hi+256*t0;
  DMA_K(0,0);DMA_V(0,0);DMA_K(1,SLOTB);
  bf16x8 qr[4];
  #pragma unroll
  for(int d0=0;d0<4;++d0)qr[d0]=*reinterpret_cast<const bf16x8*>(&Qw[(long)r32*DM+d0*16+hi*8]);
  float l_reg=0.f;f32x16 o[2];o[0]=f32x16{};o[1]=f32x16{};
  const int qrel=wid*QBLK+r32;
  #define CMASK(P0,P1,t) do{int jb_=(t)-(NT-4); if(jb_>=0)cmask(P0,P1,jb_,qrel,hi);}while(0)
  #define CINIT(X) do{ _Pragma("unroll") for(int r=0;r<16;++r)X[r]=cq2-X[r]; }while(0)
  f32x16 pA0,pA1,pB0,pB1;
  int sl_prev=0,sl_cur=0,sl_next=SLOTB;
  #define ROT() do{sl_prev=sl_cur;sl_cur=sl_next;sl_next=(sl_next==(NSLOT-1)*SLOTB)?0:sl_next+SLOTB;}while(0)
  DMA_K(2,2*SLOTB);
  WAIT_BAR(3);
  ldck(pA0,pA1,ckp0); CINIT(pA0); CINIT(pA1);
  qkt(pA0,pA1,Kbase,qr,r32,hi);asm volatile("s_nop 15\n\ts_nop 7":"+v"(pA0),"+v"(pA1));CMASK(pA0,pA1,0);
  _Pragma("unroll") for(int r=0;r<16;++r){pA0[r]=__builtin_amdgcn_exp2f(pA0[r]);pA1[r]=__builtin_amdgcn_exp2f(pA1[r]);}
  ldck(pB0,pB1,ckp0+256);
  WAIT_BAR(0);
  DMA_K(3,0);DMA_V(1,SLOTB);
  ROT();
  kload8(kf,kp0+sl_cur);
  WAIT_BAR(2);
  s16x4 vlo[8],vhi[8]; u32x4 pw0,pw1,pw2,pw3;
  #define PKW(P,B) cvtpk_s(P[B],P[B+1])
  #define PAF(k) __builtin_bit_cast(bf16x8,pw##k)
  #define VFR(i) (bf16x8){vlo[i][0],vlo[i][1],vlo[i][2],vlo[i][3],vhi[i][0],vhi[i][1],vhi[i][2],vhi[i][3]}
  #define PIN(x) asm volatile("":"+v"(x))
  #define MX3(a,b,c) __builtin_fmaxf(__builtin_fmaxf((a),(b)),(c))
  #define GAPA(MF,A0,A1,A2,A3,W0,W1,PW) do{ MF; sacc+=A0; sacc+=A1; sacc+=A2; sacc+=A3; PIN(sacc); W0; W1; PIN(PW); SBAR(); }while(0)
  #define EX(v) __builtin_amdgcn_exp2f(v)
  #define GAPB(MF,X,B) do{ MF; X[B]=EX(X[B]); X[B+1]=EX(X[B+1]); X[B+2]=EX(X[B+2]); X[B+3]=EX(X[B+3]); PIN(X); SBAR(); }while(0)
  #define VRD(i) do{ vlo[i]=vtr(vp_+(((i)>>2)*4096+((i)&3)*1024)); vhi[i]=vtr(vp_+(((i)>>2)*4096+((i)&3)*1024+512)); }while(0)
  #define KRD(G,j) do{ if(G){ kload2(kf,kp0+sl_next,j); SBAR(); } }while(0)
  #define STEP(C0,C1,P0,P1,t,GK,GV,GL,GC) do{ SBAR(); \
    const lds_cptr vp_=vp0+sl_prev; \
    CINIT(C0); CINIT(C1); SBAR(); \
    VRD(0); SBAR(); float sacc=(P0[0]+P0[1]); \
    GAPA(C0=__builtin_amdgcn_mfma_f32_32x32x16_bf16(kf[0],qr[0],C0,0,0,0), P0[2],P0[3],P0[4],P0[5],     pw0[0]=PKW(P0,0), pw0[1]=PKW(P0,2), pw0); \
    VRD(4); SBAR(); GAPA(C1=__builtin_amdgcn_mfma_f32_32x32x16_bf16(kf[1],qr[0],C1,0,0,0), P0[6],P0[7],P0[8],P0[9],     pw0[2]=PKW(P0,4), pw0[3]=PKW(P0,6), pw0); \
    VRD(1); SBAR(); GAPA(C0=__builtin_amdgcn_mfma_f32_32x32x16_bf16(kf[2],qr[1],C0,0,0,0),   P0[10],P0[11],P0[12],P0[13], pw1[0]=PKW(P0,8), pw1[1]=PKW(P0,10), pw1); \
    VRD(5); SBAR(); GAPA(C1=__builtin_amdgcn_mfma_f32_32x32x16_bf16(kf[3],qr[1],C1,0,0,0),   P0[14],P0[15],P1[0],P1[1],   pw1[2]=PKW(P0,12),pw1[3]=PKW(P0,14), pw1); \
    VRD(2); SBAR(); GAPA(C0=__builtin_amdgcn_mfma_f32_32x32x16_bf16(kf[4],qr[2],C0,0,0,0),   P1[2],P1[3],P1[4],P1[5],     pw2[0]=PKW(P1,0), pw2[1]=PKW(P1,2), pw2); \
    VRD(6); SBAR(); GAPA(C1=__builtin_amdgcn_mfma_f32_32x32x16_bf16(kf[5],qr[2],C1,0,0,0),   P1[6],P1[7],P1[8],P1[9],     pw2[2]=PKW(P1,4), pw2[3]=PKW(P1,6), pw2); \
    VRD(3); SBAR(); GAPA(C0=__builtin_amdgcn_mfma_f32_32x32x16_bf16(kf[6],qr[3],C0,0,0,0),   P1[10],P1[11],P1[12],P1[13], pw3[0]=PKW(P1,8), pw3[1]=PKW(P1,10), pw3); \
    VRD(7); SBAR(); GAPA(C1=__builtin_amdgcn_mfma_f32_32x32x16_bf16(kf[7],qr[3],C1,0,0,0),   P1[14],P1[15],0.f,0.f,       pw3[2]=PKW(P1,12),pw3[3]=PKW(P1,14), pw3); \
    l_reg+=sacc; \
    if(GK){DMA_K((t)+3,sl_cur);} if(GV){DMA_V((t)+1,sl_next);} \
    CMASK(C0,C1,t); \
    SBAR(); \
    GAPB(o[0]=__builtin_amdgcn_mfma_f32_32x32x16_bf16(PAF(0),VFR(0),o[0],0,0,0), C0,0); \
    GAPB(o[1]=__builtin_amdgcn_mfma_f32_32x32x16_bf16(PAF(0),VFR(4),o[1],0,0,0), C0,4); \
    KRD(GL,0); GAPB(o[0]=__builtin_amdgcn_mfma_f32_32x32x16_bf16(PAF(1),VFR(1),o[0],0,0,0), C0,8); \
    KRD(GL,1); GAPB(o[1]=__builtin_amdgcn_mfma_f32_32x32x16_bf16(PAF(1),VFR(5),o[1],0,0,0), C0,12); \
    KRD(GL,2); GAPB(o[0]=__builtin_amdgcn_mfma_f32_32x32x16_bf16(PAF(2),VFR(2),o[0],0,0,0), C1,0); \
    KRD(GL,3); GAPB(o[1]=__builtin_amdgcn_mfma_f32_32x32x16_bf16(PAF(2),VFR(6),o[1],0,0,0), C1,4); \
    GAPB(o[0]=__builtin_amdgcn_mfma_f32_32x32x16_bf16(PAF(3),VFR(3),o[0],0,0,0), C1,8); \
    GAPB(o[1]=__builtin_amdgcn_mfma_f32_32x32x16_bf16(PAF(3),VFR(7),o[1],0,0,0), C1,12); \
    if(GC){ ldck(P0,P1,ckp0+((t)+1)*256); } \
    }while(0)
  int t=1;
  #undef CMASK
  #define CMASK(P0,P1,t) do{}while(0)
  for(;t+5<NT;t+=2){
    STEP(pB0,pB1,pA0,pA1,t,true,true,true,true);     WAIT_BAR(2); ROT();
    STEP(pA0,pA1,pB0,pB1,t+1,true,true,true,true);   WAIT_BAR(2); ROT();
  }
  #undef CMASK
  #define CMASK(P0,P1,t) do{int jb_=(t)-(NT-4); if(jb_>=0)cmask(P0,P1,jb_,qrel,hi);}while(0)
  #define ENDW(tt) do{ if((tt)+3<NT){WAIT_BAR(2);} else if((tt)+2<NT){WAIT_BAR(1);} else {WAIT_BAR(0);} }while(0)
  for(;t+1<NT;t+=2){
    STEP(pB0,pB1,pA0,pA1,t,(t+3<NT),(t+1<NT),(t+1<NT),(t+1<NT));       ENDW(t);   ROT();
    STEP(pA0,pA1,pB0,pB1,t+1,(t+4<NT),(t+2<NT),(t+2<NT),(t+2<NT));     ENDW(t+1); ROT();
  }
  STEP(pB0,pB1,pA0,pA1,NT-1,false,false,false,false);
  { float sacc=pB0[0]+pB0[1]; _Pragma("unroll") for(int r=2;r<16;++r)sacc+=pB0[r]; _Pragma("unroll") for(int r=0;r<16;++r)sacc+=pB1[r]; l_reg+=sacc;
    pw0=(u32x4){PKW(pB0,0),PKW(pB0,2),PKW(pB0,4),PKW(pB0,6)};pw1=(u32x4){PKW(pB0,8),PKW(pB0,10),PKW(pB0,12),PKW(pB0,14)};pw2=(u32x4){PKW(pB1,0),PKW(pB1,2),PKW(pB1,4),PKW(pB1,6)};pw3=(u32x4){PKW(pB1,8),PKW(pB1,10),PKW(pB1,12),PKW(pB1,14)};
    SBAR(); pv(o,vb0+sl_cur,PAF(0),PAF(1),PAF(2),PAF(3)); }
  #undef PKW
  #undef PAF
  #undef VFR
  #undef PIN
  #undef MX3
  #undef GAPA
  #undef GAPB
  #undef EX
  #undef VRD
  #undef KRD
  #undef STEP
  #undef ENDW
  {auto rr=__builtin_amdgcn_permlane32_swap(__float_as_uint(l_reg),__float_as_uint(l_reg),false,false);l_reg=__uint_as_float(rr[0])+__uint_as_float(rr[1]);}
  if(hi==0)wsf[32+r32]=l_reg;asm volatile("s_waitcnt lgkmcnt(0)":::"memory");
  float rli[16];
  #pragma unroll
  for(int r=0;r<16;++r)rli[r]=__builtin_amdgcn_rcpf(wsf[32+crow(r,hi)]);
  bf16*Ow=O+(rowbase+q0+wid*QBLK)*DMO+h*D;
  { bf16*stg=(bf16*)(shm+LDS_OST)+wid*2048;
    #pragma unroll
    for(int r=0;r<16;++r){const int orow=crow(r,hi);
      #pragma unroll
      for(int d0=0;d0<2;++d0)stg[orow*64+d0*32+r32]=__float2bfloat16(o[d0][r]*rli[r]);}
    asm volatile("s_waitcnt lgkmcnt(0)":::"memory");
    #pragma unroll
    for(int i=0;i<4;++i){const int row=i*8+(lane>>3),ch=lane&7; const u32x4 v=*(const u32x4*)(stg+row*64+ch*8); ATTN_STORE16(Ow+(long)row*DMO+ch*8,v);} }
  asm volatile("s_waitcnt lgkmcnt(0)\n\ts_barrier":::"memory");
  #undef DMA_K
  #undef DMA_V
  #undef CMASK
  #undef CINIT
  #undef ROT
}
constexpr int ATTN_LDS_BYTES=LDS_BYTES;
struct AttnTensors { const bf16* Q; const bf16* K; const bf16* V; bf16* O; const float* C2G; };
struct AttnUnit { int bh; int qb; };
struct StaticOrder {
  int vcu;
  __device__ __forceinline__ explicit StaticOrder(int grid,int block):vcu((block%8)*(grid/8)+block/8){}
  __device__ __forceinline__ bool next(int i,AttnUnit&u)const{ if(i>=4)return false; const int s=vcu&7; u.bh=vcu>>3; u.qb=(i==0)?s:(i==1)?15-s:(i==2)?16+s:31-s; return true; }
  __device__ __forceinline__ void a_ready(const AttnUnit&)const{}
  __device__ __forceinline__ void done(const AttnUnit&)const{}
};
template<class Sched,int THRL=8> __device__ __forceinline__ void attn_phase(char*lds,const AttnTensors&T,const Sched&S,int tid_in){
  AttnUnit u;
  for(int i=0;S.next(i,u);++i){ S.a_ready(u); attn_unit<THRL>(u.bh/NHEAD,u.bh%NHEAD,u.qb,T.Q,T.K,T.V,T.O,T.C2G,lds,tid_in); S.done(u); }
}
#undef SBAR
#undef WAIT_BAR
}
constexpr int NWAVES = 8;
constexpr int SEQ = 8192, NB = 2, M = NB * SEQ, DMODEL = 2048;
constexpr int PJ = 6656;
constexpr int NIN = 6416;
constexpr int C_R = 0, C_K = 1024, C_V = 2048, C_WD = 3072, C_AD = 3136, C_GD = 3200;
constexpr int C_FQ = 3328, C_FK = 4352, C_FV = 5376, C_FF = 6400;
constexpr int NEXP = 16384;
constexpr float C2Q = 0.125f * 1.4426950408889634f;
constexpr float LOG2E = 1.4426950408889634f;

constexpr size_t MiB = 1u << 20;
constexpr size_t WS_CTL = 0, CTL_ZERO_BYTES = 1 * MiB;
constexpr size_t WS_SSQ = 42 * MiB;
constexpr size_t WS_WQT = 1 * MiB;
constexpr size_t WS_LWT = 5 * MiB;
constexpr size_t WS_C2 = 6 * MiB;
constexpr size_t WS_BON = 7 * MiB;
constexpr size_t WS_WOT = 8 * MiB;
constexpr size_t WS_WINT = 16 * MiB;
constexpr size_t WS_LA = 42 * MiB;
constexpr size_t WS_XN = 64 * MiB;
constexpr size_t WS_PROJ = 128 * MiB;
constexpr size_t WS_MIXED = 336 * MiB;
constexpr size_t WS_KP = 400 * MiB, WS_AV = 432 * MiB, WS_BV = 464 * MiB;
constexpr size_t WS_END = 497 * MiB;
constexpr size_t WS_GATE = 128 * MiB;
constexpr size_t WS_IDX = 136 * MiB;
constexpr size_t WS_QP = 140 * MiB;
constexpr size_t WS_U8 = 464 * MiB, WS_V8 = 480 * MiB;
constexpr size_t WS_USC = 496 * MiB, WS_VSC = 496 * MiB + 65536;
constexpr size_t OUT_DEC = 0, OUT_G = 64 * MiB, OUT_AIC = 96 * MiB;
constexpr int CW_TMO = 0, CW_BAR = 4096, CW_QUEUE = 16384, CW_QU = 32768, CW_QV = 36864;
constexpr size_t WS_W = 238 * MiB;

constexpr int RING_OFF = 0, RING_BYTES = 131072;
constexpr int LDSCTL_OFF = RING_BYTES, MISC_OFF = LDSCTL_OFF + 320;
constexpr int LDS_BYTES = 147456;

#define GAS __attribute__((address_space(1)))
#define LAS __attribute__((address_space(3)))
typedef unsigned short bf16;
typedef unsigned v4u __attribute__((ext_vector_type(4)));
typedef float f32x4 __attribute__((ext_vector_type(4)));
typedef short bf16x8 __attribute__((ext_vector_type(8)));
typedef GAS unsigned gu32;
typedef GAS unsigned long long gu64;
#define RLX_AGENT __ATOMIC_RELAXED, __HIP_MEMORY_SCOPE_AGENT
#define LDS_WAIT() asm volatile("s_waitcnt lgkmcnt(0)" ::: "memory")
#define VM_WAIT() asm volatile("s_waitcnt vmcnt(0)" ::: "memory")
__device__ __forceinline__ unsigned long long rt() { return __builtin_amdgcn_s_memrealtime(); }
__device__ __forceinline__ unsigned f2bf(float f) { unsigned u = __builtin_bit_cast(unsigned, f); return (u + 0x7fffu + ((u >> 16) & 1u)) >> 16; }
__device__ __forceinline__ unsigned pk2(float lo, float hi) { return f2bf(lo) | (f2bf(hi) << 16); }

#define XB_TMO      128
#define XB_XCNT(j)  (256  + 64 * (j))
#define XB_XSUB(j)  (1280 + 64 * (j))
#define XB_XGEN(j)  (2304 + 64 * (j))
#define XB_TOP      3328
#define XB_TOPGEN   3392
#define XCD_BAR_WORDS 3456
#define XB_SPIN_CAP (1u << 18)

__device__ __forceinline__ unsigned xb_ld(unsigned* p)              { return __hip_atomic_load(p, __ATOMIC_RELAXED, __HIP_MEMORY_SCOPE_AGENT); }
__device__ __forceinline__ unsigned xb_add(unsigned* p, unsigned v) { return __hip_atomic_fetch_add(p, v, __ATOMIC_RELAXED, __HIP_MEMORY_SCOPE_AGENT); }
__device__ __forceinline__ unsigned xb_xcc_id() { return (unsigned)__builtin_amdgcn_s_getreg((3 << 11) | 20) & 0xFu; }
#define XB_SPIN(cond, bar) do { unsigned _sp = 0; while (cond) { __builtin_amdgcn_s_sleep(1); \
    if ((++_sp & 255u) == 0u) { if (xb_ld(&(bar)[XB_TMO])) break; if (_sp > XB_SPIN_CAP) { atomicAdd(&(bar)[XB_TMO], 1u); break; } } } } while (0)

struct XcdBarrier {
    unsigned* bar; unsigned x;
    volatile LAS unsigned* st;
};

__device__ __forceinline__ XcdBarrier xcd_barrier_post(unsigned* bar, volatile LAS unsigned* st, int tid) {
    XcdBarrier b; b.bar = bar; b.x = xb_xcc_id(); b.st = st;
    if (tid == 0) (void)xb_add(&bar[XB_XCNT(b.x)], 1u);
    return b;
}
__device__ __forceinline__ void xcd_barrier_complete(unsigned* bar, unsigned x, unsigned& nloc, unsigned& nx) {
    const unsigned G = gridDim.x * gridDim.y * gridDim.z;
    unsigned sum, cnt, mine, sp = 0u;
    for (;;) {
        sum = 0u; cnt = 0u; mine = 0u;
#pragma unroll
        for (unsigned j = 0; j < 16; ++j) { const unsigned c = xb_ld(&bar[XB_XCNT(j)]); sum += c; cnt += (c > 0u) ? 1u : 0u; mine = (j == x) ? c : mine; }
        if (sum == G) break;
        __builtin_amdgcn_s_sleep(1);
        if ((++sp & 255u) == 0u) { if (xb_ld(&bar[XB_TMO])) break; if (sp > XB_SPIN_CAP) { atomicAdd(&bar[XB_TMO], 1u); break; } }
    }
    nloc = mine > 0u ? mine : 1u; nx = cnt > 0u ? cnt : 1u;
}

__device__ __forceinline__ void xcd_barrier(const XcdBarrier& b, int tid) {
    asm volatile("s_waitcnt vmcnt(0)" ::: "memory");
    __syncthreads();
    if (tid == 0) {
        unsigned* bar = b.bar;
        __builtin_amdgcn_s_waitcnt(0);
        unsigned nloc = b.st[0], nx = b.st[1];
        if (nloc == 0u) { xcd_barrier_complete(bar, b.x, nloc, nx); b.st[0] = nloc; b.st[1] = nx; }
        const unsigned old = xb_add(&bar[XB_XSUB(b.x)], 1u);
        const unsigned gen = old / nloc;
        if (old + 1u == (gen + 1u) * nloc) {
            __builtin_amdgcn_fence(__ATOMIC_RELEASE, "agent");
            asm volatile("s_waitcnt vmcnt(0)" ::: "memory");
            const unsigned og = xb_add(&bar[XB_TOP], 1u);
            const unsigned tg = og / nx;
            if (og + 1u == (tg + 1u) * nx) xb_add(&bar[XB_TOPGEN], 1u);
            else XB_SPIN(xb_ld(&bar[XB_TOPGEN]) == tg, bar);
            __builtin_amdgcn_fence(__ATOMIC_ACQUIRE, "agent");
            xb_add(&bar[XB_XGEN(b.x)], 1u);
            asm volatile("s_waitcnt vmcnt(0)" ::: "memory");
        } else {
            XB_SPIN(xb_ld(&bar[XB_XGEN(b.x)]) == gen, bar);
            __builtin_amdgcn_fence(__ATOMIC_ACQUIRE, "agent");
            asm volatile("s_waitcnt vmcnt(0)" ::: "memory");
        }
    }
    __syncthreads();
}


struct Frame {
    LAS unsigned char* lds;
    volatile LAS unsigned* MISC;
    gu32* ctl;
    int tid, lane, wave, vcu, G;
};
__device__ __forceinline__ float wave_sum(float v) {
#pragma unroll
    for (int o = 1; o < 64; o <<= 1) v += __shfl_xor(v, o);
    return v;
}
__device__ __forceinline__ float wave_max(float v) {
#pragma unroll
    for (int o = 1; o < 64; o <<= 1) v = fmaxf(v, __shfl_xor(v, o));
    return v;
}
__device__ __forceinline__ float bflo(unsigned u) { return __uint_as_float(u << 16); }
__device__ __forceinline__ float bfhi(unsigned u) { return __uint_as_float(u & 0xffff0000u); }
__device__ __forceinline__ float bf1(const bf16* p) { return __uint_as_float((unsigned)(*p) << 16); }
__device__ __forceinline__ void ld16bf(const bf16* p, float (&x)[16]) {
    const v4u a = *(const v4u*)p, b = *(const v4u*)(p + 8);
    x[0] = bflo(a.x); x[1] = bfhi(a.x); x[2] = bflo(a.y); x[3] = bfhi(a.y); x[4] = bflo(a.z); x[5] = bfhi(a.z); x[6] = bflo(a.w); x[7] = bfhi(a.w);
    x[8] = bflo(b.x); x[9] = bfhi(b.x); x[10] = bflo(b.y); x[11] = bfhi(b.y); x[12] = bflo(b.z); x[13] = bfhi(b.z); x[14] = bflo(b.w); x[15] = bfhi(b.w);
}
__device__ __forceinline__ void st16bf(bf16* p, const float (&x)[16]) {
    v4u a, b;
    a.x = pk2(x[0], x[1]); a.y = pk2(x[2], x[3]); a.z = pk2(x[4], x[5]); a.w = pk2(x[6], x[7]);
    b.x = pk2(x[8], x[9]); b.y = pk2(x[10], x[11]); b.z = pk2(x[12], x[13]); b.w = pk2(x[14], x[15]);
    *(v4u*)p = a; *(v4u*)(p + 8) = b;
}
__device__ __forceinline__ void ld16f(const float* p, float (&x)[16]) {
#pragma unroll
    for (int j = 0; j < 4; ++j) { const f32x4 v = *(const f32x4*)(p + 4 * j); x[4 * j] = v.x; x[4 * j + 1] = v.y; x[4 * j + 2] = v.z; x[4 * j + 3] = v.w; }
}
__device__ __forceinline__ void shift16(const bf16* row, bool has_prev, int col, const float* mu, float (&x)[16]) {
    float p[16], q[16], m[16];
    ld16bf(row + col, p); ld16f(mu + col, m);
    if (has_prev) ld16bf(row - PJ + col, q); else {
#pragma unroll
        for (int i = 0; i < 16; ++i) q[i] = 0.f; }
#pragma unroll
    for (int i = 0; i < 16; ++i) x[i] = p[i] + m[i] * (q[i] - p[i]);
}

__device__ __forceinline__ void p0_transpose_item(const float* W, int Ks, int Ns, bf16* WT, int Kd, LAS float* scr, int kb, int nb, int lane) {
    const int k0 = 64 * kb, n0 = 32 * nb;
    float wv_[32];
#pragma unroll
    for (int i = 0; i < 32; ++i) { const int kk = 2 * i + (lane >> 5), k = k0 + kk, n = n0 + (lane & 31); wv_[i] = (k < Ks && n < Ns) ? W[(size_t)k * Ns + n] : 0.f; }
#pragma unroll
    for (int i = 0; i < 32; ++i) { const int kk = 2 * i + (lane >> 5); scr[kk * 33 + (lane & 31)] = wv_[i]; }
    LDS_WAIT(); asm volatile("" ::: "memory");
    const int c = lane & 7;
#pragma unroll
    for (int j = 0; j < 4; ++j) { const int n = (lane >> 3) + 8 * j; const LAS float* s = scr + (8 * c) * 33 + n;
        v4u o; o.x = pk2(s[0 * 33], s[1 * 33]); o.y = pk2(s[2 * 33], s[3 * 33]); o.z = pk2(s[4 * 33], s[5 * 33]); o.w = pk2(s[6 * 33], s[7 * 33]);
        *(GAS v4u*)(WT + (size_t)(n0 + n) * Kd + k0 + 8 * c) = o; }
    LDS_WAIT(); asm volatile("" ::: "memory");
}
struct TrItem { const float* W; bf16* WT; int Ks, Ns, Kd, kb, nb; };
struct TrRegs { f32x4 v[8]; };
__device__ __forceinline__ void tr_load(const TrItem& I, int tid, TrRegs& R) {
    const int k0 = 64 * I.kb, n0 = 256 * I.nb, r8 = tid >> 6, c = tid & 63;
#pragma unroll
    for (int i = 0; i < 8; ++i) { const int k = k0 + r8 + 8 * i, n = n0 + 4 * c; R.v[i] = (k < I.Ks && n < I.Ns) ? *(const f32x4*)(I.W + (size_t)k * I.Ns + n) : (f32x4){0.f, 0.f, 0.f, 0.f}; }
}
__device__ __forceinline__ void tr_finish(const TrItem& I, const TrRegs& R, LAS float* scr, int tid) {
    const int k0 = 64 * I.kb, n0 = 256 * I.nb, r8 = tid >> 6, c = tid & 63, lane = tid & 63, w = tid >> 6;
#pragma unroll
    for (int i = 0; i < 8; ++i) { LAS float* d = scr + (r8 + 8 * i) * 257 + 4 * c; d[0] = R.v[i].x; d[1] = R.v[i].y; d[2] = R.v[i].z; d[3] = R.v[i].w; }
    asm volatile("s_waitcnt lgkmcnt(0)\n\ts_barrier" ::: "memory");
    const int nl = lane >> 3, c8 = lane & 7;
#pragma unroll
    for (int jj = 0; jj < 4; ++jj) { const int n = 8 * (w * 4 + jj) + nl; const LAS float* s = scr + (8 * c8) * 257 + n;
        v4u o; o.x = pk2(s[0 * 257], s[1 * 257]); o.y = pk2(s[2 * 257], s[3 * 257]); o.z = pk2(s[4 * 257], s[5 * 257]); o.w = pk2(s[6 * 257], s[7 * 257]);
        *(GAS v4u*)(I.WT + (size_t)(n0 + n) * I.Kd + k0 + 8 * c8) = o; }
    asm volatile("s_waitcnt lgkmcnt(0)\n\ts_barrier" ::: "memory");
}
struct Row8 { f32x4 v[8]; };
__device__ __forceinline__ void ld_row8(const float* src, int lane, Row8& R) {
    const GAS f32x4* xr = (const GAS f32x4*)src + lane;
#pragma unroll
    for (int j = 0; j < 8; ++j) R.v[j] = xr[64 * j];
}
__device__ __forceinline__ void rms_finish(const Row8& R, const float* g, bf16* orow, int lane) {
    const GAS f32x4* gr = (const GAS f32x4*)g + lane; float s = 0.f;
#pragma unroll
    for (int j = 0; j < 8; ++j) s += (R.v[j].x * R.v[j].x + R.v[j].y * R.v[j].y) + (R.v[j].z * R.v[j].z + R.v[j].w * R.v[j].w);
    const float rs = 1.0f / sqrtf(wave_sum(s) * (1.f / DMODEL) + 1e-6f);
    GAS unsigned long long* o8 = (GAS unsigned long long*)orow + lane;
#pragma unroll
    for (int j = 0; j < 8; ++j) { const f32x4 gg = gr[64 * j];
        o8[64 * j] = (unsigned long long)pk2(R.v[j].x * rs * gg.x, R.v[j].y * rs * gg.y) | ((unsigned long long)pk2(R.v[j].z * rs * gg.z, R.v[j].w * rs * gg.w) << 32); }
}
struct Ptrs {
    const float *x, *norm1_g, *w_in, *mu, *w_decay_up, *w0, *w_iclr_up, *a0, *w_gate_up, *k_k, *k_a, *r_k, *lnx_g, *lnx_b, *fox_b_f, *q_norm_g, *k_norm_g, *w_out, *norm2_g, *w_q, *sub_keys, *peer_u, *peer_v;
    float* out;
    bf16 *WQT, *LWT, *WOT, *WINT, *LA, *XN, *PROJ, *MIXED, *KP, *AV, *BV, *QP, *G, *AIC;
    float *C2, *BON, *Y, *DEC, *GATE, *USC, *VSC, *SSQ;
    unsigned short* IDX; unsigned char *U8, *V8;
};
__device__ __forceinline__ void prepA_token(const Ptrs& P, int m, int lane) {
    bf16* row = P.PROJ + (size_t)m * PJ;
    const bool has_prev = (m % SEQ) != 0;
#pragma unroll
    for (int which = 0; which < 2; ++which) {
        bf16* p = row + (which == 0 ? C_FQ : C_FK) + lane * 16;
        float x[16], g[16]; ld16bf(p, x); ld16f((which == 0 ? P.q_norm_g : P.k_norm_g) + (lane & 3) * 16, g);
        float ss = 0.f;
#pragma unroll
        for (int i = 0; i < 16; ++i) ss += x[i] * x[i];
        ss += __shfl_xor(ss, 1); ss += __shfl_xor(ss, 2);
        const float rs = (1.0f / sqrtf(ss * (1.f / 64.f) + 1e-6f)) * (which == 0 ? C2Q : 1.f);
#pragma unroll
        for (int i = 0; i < 16; ++i) x[i] = x[i] * rs * g[i];
        st16bf(p, x);
    }
    {
        const bf16* prow = row - PJ;
        auto sh = [&](int col) -> float { const float p = bf1(row + col); const float q = has_prev ? bf1(prow + col) : 0.f; return p + P.mu[col] * (q - p); };
        bf16* la0 = P.LA + (size_t)m * 128; bf16* la1 = P.LA + (size_t)M * 128 + (size_t)m * 128; bf16* la2 = P.LA + (size_t)2 * M * 128 + (size_t)m * 128;
        const float wd = sh(C_WD + lane), ad = sh(C_AD + lane), g0 = sh(C_GD + lane), g1 = sh(C_GD + 64 + lane);
        const unsigned short o0 = (unsigned short)f2bf(tanhf(wd)), o1 = (unsigned short)f2bf(ad);
        asm volatile("" ::: "memory");
        la0[lane] = o0; la0[64 + lane] = 0;
        la1[lane] = o1; la1[64 + lane] = 0;
        la2[lane] = (bf16)f2bf(1.0f / (1.0f + __expf(-g0))); la2[64 + lane] = (bf16)f2bf(1.0f / (1.0f + __expf(-g1)));
    }
}
__device__ __forceinline__ void fox_cumsum(const Ptrs& P, int bh, LAS float* scr, int tid) {
    const int b = bh >> 4, h = bh & 15; const float bf_ = P.fox_b_f[h];
    const bf16* src = P.PROJ + (size_t)(b * SEQ + tid * 16) * PJ + C_FF + h;
    float v[16]; float run = 0.f;
#pragma unroll
    for (int i = 0; i < 16; ++i) { const float x = bf1(src + (size_t)i * PJ) + bf_;
        const float ls = (x >= 0.f) ? -log1pf(__expf(-x)) : (x - log1pf(__expf(x))); run += ls; v[i] = run; }
    float inc = run; const int lane = tid & 63, w = tid >> 6;
#pragma unroll
    for (int o = 1; o < 64; o <<= 1) { const float t = __shfl_up(inc, o); if (lane >= o) inc += t; }
    if (lane == 63) scr[w] = inc;
    __syncthreads();
    float off = inc - run;
    for (int j = 0; j < w; ++j) off += scr[j];
    float* dst = P.C2 + (size_t)bh * SEQ + tid * 16;
#pragma unroll
    for (int i = 0; i < 16; i += 4) *(f32x4*)(dst + i) = (f32x4){(off + v[i]) * LOG2E, (off + v[i + 1]) * LOG2E, (off + v[i + 2]) * LOG2E, (off + v[i + 3]) * LOG2E};
    __syncthreads();
}

#define DPP_ADD(x, ctrl) ((x) + __uint_as_float((unsigned)__builtin_amdgcn_update_dpp(0, (int)__float_as_uint(x), (ctrl), 0xf, 0xf, true)))
__device__ __forceinline__ float row16_sum(float x) {
    x = DPP_ADD(x, 0xB1);
    x = DPP_ADD(x, 0x4E);
    x = DPP_ADD(x, 0x141);
    x = DPP_ADD(x, 0x140);
    return x;
}
__device__ __forceinline__ void post_token(const Ptrs& P, int m, int lane) {
    const bf16* row = P.PROJ + (size_t)m * PJ;
    const bool has_prev = (m % SEQ) != 0;
    const int c = lane * 16, h = lane >> 2;
    float y[16], vs[16], g[16], lg[16], lb[16];
    ld16f(P.Y + (size_t)m * 1024 + c, y);
    float s = 0.f;
#pragma unroll
    for (int i = 0; i < 16; ++i) s += y[i];
    s += __shfl_xor(s, 1); s += __shfl_xor(s, 2);
    const float mean = s * (1.f / 64.f);
    float q = 0.f;
#pragma unroll
    for (int i = 0; i < 16; ++i) { y[i] -= mean; q += y[i] * y[i]; }
    q += __shfl_xor(q, 1); q += __shfl_xor(q, 2);
    const float rstd = 1.0f / sqrtf(q * (1.f / 64.f) + 64e-5f);
    shift16(row, has_prev, C_V + c, P.mu, vs);
    ld16bf(P.G + (size_t)m * 1024 + c, g); ld16f(P.lnx_g + c, lg); ld16f(P.lnx_b + c, lb);
    const float bon = P.BON[(size_t)m * 16 + h];
#pragma unroll
    for (int i = 0; i < 16; ++i) y[i] = (y[i] * rstd * lg[i] + lb[i] + bon * vs[i]) * g[i];
    st16bf(P.MIXED + (size_t)m * 2048 + c, y);
}
typedef float v16f __attribute__((ext_vector_type(16)));
typedef float v32f __attribute__((ext_vector_type(32)));
typedef unsigned v6u __attribute__((ext_vector_type(6)));
constexpr int ROW6 = 1024;
__device__ __forceinline__ void fp4_finish(const Row8& R, unsigned char* dst, float* mult, int lane) {
    const f32x4 (&v)[8] = R.v; float am = 0.f;
#pragma unroll
    for (int j = 0; j < 8; ++j) am = fmaxf(am, fmaxf(fmaxf(fabsf(v[j].x), fabsf(v[j].y)), fmaxf(fabsf(v[j].z), fabsf(v[j].w))));
    am = wave_max(am);
    const float sc = am > 0.f ? 6.0f / am : 1.0f;
    unsigned w[4];
#pragma unroll
    for (int d = 0; d < 4; ++d) { unsigned x = 0u;
        x = __builtin_amdgcn_cvt_scalef32_pk_fp4_f32(x, v[2 * d].x * sc, v[2 * d].y * sc, 1.0f, 0); x = __builtin_amdgcn_cvt_scalef32_pk_fp4_f32(x, v[2 * d].z * sc, v[2 * d].w * sc, 1.0f, 1);
        x = __builtin_amdgcn_cvt_scalef32_pk_fp4_f32(x, v[2 * d + 1].x * sc, v[2 * d + 1].y * sc, 1.0f, 2); x = __builtin_amdgcn_cvt_scalef32_pk_fp4_f32(x, v[2 * d + 1].z * sc, v[2 * d + 1].w * sc, 1.0f, 3);
        w[d] = x; }
    *(GAS v4u*)(dst + lane * 16) = (v4u){w[0], w[1], w[2], w[3]};
    if (lane == 0) *mult = am > 0.f ? am * (1.0f / 6.0f) : 1.0f;
}
namespace rk {
typedef float f32x16 __attribute__((ext_vector_type(16)));
constexpr int CS = 144;
constexpr int FS = 272;
constexpr int L_AT = 0, L_RT = 9216, L_BT = 18432, L_KT = 27648, L_PF = 18432, L_VT = 36864, L_BH = 46080, L_M1 = 55296, L_KH = 64512, L_Q1 = 55296,
              L_M3 = 73728, L_M4 = 82944, L_M2 = 92160, L_GL = 109568, L_WT = 109824, L_QF = 111872, L_M2B = 111872, L_PI = 121088, L_RTW = 36864, L_END = 129280;
__device__ __forceinline__ int crow(int r, int hi) { return (r & 3) + 8 * (r >> 2) + 4 * hi; }
typedef float f32x2c __attribute__((ext_vector_type(2))); typedef __bf16 bf16x2c __attribute__((ext_vector_type(2)));
__device__ __forceinline__ unsigned cvtpk_v(float lo, float hi) { const f32x2c v = {lo, hi}; const bf16x2c b = __builtin_convertvector(v, bf16x2c); return __builtin_bit_cast(unsigned, b); }
__device__ __forceinline__ int permcol(int j) { const int x = j & 15; return (j & ~15) + ((x >> 2) & 1) * 8 + (x >> 3) * 4 + (x & 3); }
__device__ __forceinline__ void mm32(f32x16& acc, const LAS unsigned char* A, const LAS unsigned char* Bt, int lane) {
    const int r = lane & 31, h = lane >> 5;
    const LAS unsigned char* pa = A + r * CS + h * 16; const LAS unsigned char* pb = Bt + r * CS + h * 16;
#pragma unroll
    for (int ks = 0; ks < 4; ++ks) { const bf16x8 a = *(const LAS bf16x8*)(pa + ks * 32), b = *(const LAS bf16x8*)(pb + ks * 32); acc = __builtin_amdgcn_mfma_f32_32x32x16_bf16(a, b, acc, 0, 0, 0); }
}
__device__ __forceinline__ void st_bf16(LAS unsigned char* p, float v) { *(LAS unsigned short*)p = (unsigned short)cvtpk_v(v, v); }

struct S1Regs { v4u rk, rkp, raic, rr, rrp, rv, rvp; f32x4 rw0, rw1; };
__device__ __forceinline__ void s1_load(const Ptrs& P, int unit, int tid, S1Regs& R) {
    const int c = unit >> 5, bh = unit & 31, b = bh >> 4, h = bh & 15, tt = tid >> 3, sg = tid & 7;
    const int t_ = c * 64 + tt; const size_t m_ = (size_t)b * SEQ + t_; const int cb = h * 64 + sg * 8;
    R.rk = *(const v4u*)(P.PROJ + m_ * PJ + C_K + cb); R.raic = *(const v4u*)(P.AIC + m_ * 1024 + cb);
    R.rw0 = *(const f32x4*)(P.DEC + m_ * 1024 + cb); R.rw1 = *(const f32x4*)(P.DEC + m_ * 1024 + cb + 4);
    R.rr = *(const v4u*)(P.PROJ + m_ * PJ + C_R + cb); R.rv = *(const v4u*)(P.PROJ + m_ * PJ + C_V + cb);
    if (t_ > 0) { R.rrp = *(const v4u*)(P.PROJ + (m_ - 1) * PJ + C_R + cb); R.rvp = *(const v4u*)(P.PROJ + (m_ - 1) * PJ + C_V + cb); R.rkp = *(const v4u*)(P.PROJ + (m_ - 1) * PJ + C_K + cb); }
    else { R.rrp = (v4u){0u, 0u, 0u, 0u}; R.rvp = (v4u){0u, 0u, 0u, 0u}; R.rkp = (v4u){0u, 0u, 0u, 0u}; }
}
__device__ __forceinline__ void unpk8(const v4u u, float (&x)[8]) { x[0] = bflo(u.x); x[1] = bfhi(u.x); x[2] = bflo(u.y); x[3] = bfhi(u.y); x[4] = bflo(u.z); x[5] = bfhi(u.z); x[6] = bflo(u.w); x[7] = bfhi(u.w); }
__device__ __forceinline__ v4u pk8(const float (&x)[8]) { v4u o; o.x = pk2(x[0], x[1]); o.y = pk2(x[2], x[3]); o.z = pk2(x[4], x[5]); o.w = pk2(x[6], x[7]); return o; }

#ifdef PROBE_MASK
#define S1T(k) do { if (blockIdx.x == 0 && wv == 0) { unsigned long long t_; __builtin_amdgcn_sched_barrier(0); asm volatile("s_memrealtime %0\n\ts_waitcnt lgkmcnt(0)" : "=s"(t_) :: "memory"); __builtin_amdgcn_sched_barrier(0); \
    volatile LAS unsigned* w_ = (volatile LAS unsigned*)(lds + MISC_OFF) + 96; if ((tid & 63) == 0) { w_[(k)] += (unsigned)t_ - w_[7]; w_[7] = (unsigned)t_; } } } while (0)
#else
#define S1T(k) do {} while (0)
#endif
#define S1_BAR() asm volatile("s_waitcnt lgkmcnt(0)\n\ts_barrier" ::: "memory")
__device__ __forceinline__ void s1_unit(const Ptrs& P, int unit, int next_unit, S1Regs& R, LAS unsigned char* lds, int tid_in, int wv) {
    int tid = tid_in; asm volatile("" : "+v"(tid));
    const int c = unit >> 5, bh = unit & 31, b = bh >> 4, h = bh & 15, tt = tid >> 3, sg = tid & 7, lane = tid & 63;
    const size_t m0 = (size_t)b * SEQ + c * 64;
    {
        float a8[8], b8[8], k8[8], r8[8], v8[8], p8[8], lw[8], cum[8];
        const int cb = h * 64 + sg * 8;
        float mu8[8], c8[8];
#define S1_LD8(dst, ptr) do { const f32x4 u0_ = *(const f32x4*)(ptr), u1_ = *(const f32x4*)((ptr) + 4); dst[0] = u0_.x; dst[1] = u0_.y; dst[2] = u0_.z; dst[3] = u0_.w; dst[4] = u1_.x; dst[5] = u1_.y; dst[6] = u1_.z; dst[7] = u1_.w; } while (0)
        unpk8(R.rk, k8); unpk8(R.rkp, p8); S1_LD8(mu8, P.mu + C_K + cb);
#pragma unroll
        for (int e = 0; e < 8; ++e) k8[e] = k8[e] + mu8[e] * (p8[e] - k8[e]);
        S1_LD8(c8, P.k_k + cb);
        float n2 = 0.f;
#pragma unroll
        for (int e = 0; e < 8; ++e) { a8[e] = k8[e] * c8[e]; n2 += a8[e] * a8[e]; }
        n2 = DPP_ADD(n2, 0xB1); n2 = DPP_ADD(n2, 0x4E); n2 = DPP_ADD(n2, 0x141);
        const float inv = 1.0f / fmaxf(sqrtf(n2), 1e-12f);
        unpk8(R.raic, b8); S1_LD8(c8, P.k_a + cb);
#pragma unroll
        for (int e = 0; e < 8; ++e) { const float ic = 1.0f / (1.0f + __expf(-b8[e])); const float kk = a8[e] * inv; k8[e] = k8[e] * (1.0f + (ic - 1.0f) * c8[e]); a8[e] = -kk; b8[e] = kk * ic; }
        unpk8(R.rr, r8); unpk8(R.rrp, p8); S1_LD8(mu8, P.mu + C_R + cb);
#pragma unroll
        for (int e = 0; e < 8; ++e) r8[e] = r8[e] + mu8[e] * (p8[e] - r8[e]);
        S1_LD8(c8, P.r_k + cb);
        float bon = 0.f;
#pragma unroll
        for (int e = 0; e < 8; ++e) bon += r8[e] * k8[e] * c8[e];
        bon = DPP_ADD(bon, 0xB1); bon = DPP_ADD(bon, 0x4E); bon = DPP_ADD(bon, 0x141);
        if (sg == 0) P.BON[(m0 + tt) * 16 + h] = bon;
        unpk8(R.rv, v8); unpk8(R.rvp, p8); S1_LD8(mu8, P.mu + C_V + cb);
#pragma unroll
        for (int e = 0; e < 8; ++e) v8[e] = v8[e] + mu8[e] * (p8[e] - v8[e]);
        const float z8[8] = {R.rw0.x, R.rw0.y, R.rw0.z, R.rw0.w, R.rw1.x, R.rw1.y, R.rw1.z, R.rw1.w};
#pragma unroll
        for (int e = 0; e < 8; ++e) { lw[e] = -__expf(-__logf(1.0f + __expf(-z8[e])) - 0.5f); cum[e] = lw[e]; }
#undef S1_LD8
#pragma unroll
        for (int o = 8; o < 64; o <<= 1)
#pragma unroll
            for (int e = 0; e < 8; ++e) { const float t = __shfl_up(cum[e], o); if (lane >= o) cum[e] += t; }
        LAS float* WT = (LAS float*)(lds + L_WT);
        if (lane >= 56) {
#pragma unroll
            for (int e = 0; e < 8; ++e) WT[wv * 64 + sg * 8 + e] = cum[e]; }
        S1_BAR(); S1T(0);
        float cL[8];
#pragma unroll
        for (int e = 0; e < 8; ++e) cL[e] = 0.f;
        {
            float off[8];
#pragma unroll
            for (int e = 0; e < 8; ++e) off[e] = 0.f;
#pragma unroll
            for (int w2 = 0; w2 < 8; ++w2) { const f32x4 x0 = *(const LAS f32x4*)(WT + w2 * 64 + sg * 8), x1 = *(const LAS f32x4*)(WT + w2 * 64 + sg * 8 + 4);
                const float xs[8] = {x0.x, x0.y, x0.z, x0.w, x1.x, x1.y, x1.z, x1.w};
#pragma unroll
                for (int e = 0; e < 8; ++e) { cL[e] += xs[e]; off[e] += (w2 < wv) ? xs[e] : 0.f; } }
#pragma unroll
            for (int e = 0; e < 8; ++e) cum[e] += off[e];
        }
        float o8[8];
#pragma unroll
        for (int e = 0; e < 8; ++e) o8[e] = a8[e] * __expf(cum[e] - lw[e]);
        *(LAS v4u*)(lds + L_AT + tt * CS + sg * 16) = pk8(o8);
#pragma unroll
        for (int e = 0; e < 8; ++e) o8[e] = r8[e] * __expf(cum[e]);
        *(LAS v4u*)(lds + L_RT + tt * CS + sg * 16) = pk8(o8);
        float gi[8];
#pragma unroll
        for (int e = 0; e < 8; ++e) { gi[e] = __expf(-cum[e]); o8[e] = b8[e] * gi[e]; }
        *(LAS v4u*)(lds + L_BT + tt * CS + sg * 16) = pk8(o8);
#pragma unroll
        for (int e = 0; e < 8; ++e) o8[e] = k8[e] * gi[e];
        *(LAS v4u*)(lds + L_KT + tt * CS + sg * 16) = pk8(o8);
#pragma unroll
        for (int e = 0; e < 8; ++e) { const float gl = __expf(cL[e] - cum[e]);
            st_bf16(lds + L_VT + (sg * 8 + e) * CS + tt * 2, v8[e]); st_bf16(lds + L_BH + (sg * 8 + e) * CS + tt * 2, b8[e] * gl); st_bf16(lds + L_KH + (sg * 8 + e) * CS + tt * 2, k8[e] * gl); }
        if (tt == 0) {
#pragma unroll
            for (int e = 0; e < 8; ++e) ((LAS float*)(lds + L_GL))[sg * 8 + e] = __expf(cL[e]); }
    }
    S1_BAR(); S1T(1);
    if (next_unit < 4096) s1_load(P, next_unit, tid, R);
    int lane2 = lane; asm volatile("" : "+v"(lane2));
    const int hl = lane2 >> 5, cl = lane2 & 31;
    {
        const int p = wv >> 1, mb = wv & 1;
        const LAS unsigned char* A = lds + ((p < 2) ? L_AT : L_RT) + mb * 32 * CS;
        const LAS unsigned char* B = lds + ((p == 0 || p == 3) ? L_KT : L_BT);
#pragma unroll
        for (int nb = 0; nb < 2; ++nb) {
            f32x16 acc = {}; mm32(acc, A, B + nb * 32 * CS, lane);
            const int col = nb * 32 + cl;
#pragma unroll
            for (int rg = 0; rg < 16; ++rg) { const int row = mb * 32 + crow(rg, hl);
                const bool keep = (p < 2) ? (col < row) : (col <= row); const float v = keep ? acc[rg] : 0.f;
                if (p == 1) { *(LAS float*)(lds + L_M2 + row * FS + col * 4) = v; st_bf16(lds + L_M2B + row * CS + col * 2, v); }
                else st_bf16(lds + ((p == 0) ? L_M1 : (p == 2) ? L_M3 : L_M4) + row * CS + col * 2, v); }
        }
    }
    S1_BAR(); S1T(2);
    f32x16 accQ = {}, accY = {};
    const int tb = (wv >> 1) & 1, ib = wv & 1;
    if (wv < 4) {
        f32x16 acc = {}; mm32(acc, lds + L_M1 + tb * 32 * CS, lds + L_VT + ib * 32 * CS, lane);
#pragma unroll
        for (int rg = 0; rg < 16; ++rg) *(LAS float*)(lds + L_PF + (ib * 32 + cl) * FS + (tb * 32 + crow(rg, hl)) * 4) = acc[rg];
        if (lane2 < 32) {
            const int I = wv; const LAS unsigned char* mdia = lds + L_M2 + I * 16 * FS + I * 64; LAS unsigned char* pib = lds + L_PI + I * 1024 + lane2 * 2;
            asm volatile("" : "+v"(mdia), "+v"(pib));
            float pc[16];
#pragma unroll
            for (int r2 = 0; r2 < 16; ++r2) {
                float s_ = (r2 == lane2) ? 1.0f : 0.0f;
#pragma unroll
                for (int g = 0; g < (r2 + 3) / 4; ++g) { const f32x4 m = *(const LAS f32x4*)(mdia + r2 * FS + g * 16);
                    s_ += m.x * pc[4 * g];
                    if (4 * g + 1 < r2) s_ += m.y * pc[4 * g + 1];
                    if (4 * g + 2 < r2) s_ += m.z * pc[4 * g + 2];
                    if (4 * g + 3 < r2) s_ += m.w * pc[4 * g + 3]; }
                pc[r2] = s_;
                st_bf16(pib + r2 * 64, s_);
            }
        }
    } else { mm32(accQ, lds + L_KH + tb * 32 * CS, lds + L_VT + ib * 32 * CS, lane); mm32(accY, lds + L_M4 + tb * 32 * CS, lds + L_VT + ib * 32 * CS, lane); }
    S1_BAR(); S1T(3);
    {
        typedef float f32x4m __attribute__((ext_vector_type(4)));
        const int c16 = lane2 & 15, kq = lane2 >> 4, n0 = wv * 16, n = n0 + c16;
        LAS unsigned char* q1w = lds + L_Q1 + n0 * CS;
        LAS unsigned char* rtw = lds + L_RTW + wv * 1024;
        {
            const v4u z = (v4u){0u, 0u, 0u, 0u};
            for (int o = lane2 * 16; o < 16 * CS; o += 1024) *(LAS v4u*)(q1w + o) = z;
            *(LAS v4u*)(rtw + lane2 * 16) = z;
        }
        const LAS unsigned char* a_m2 = lds + L_M2B + c16 * CS + kq * 16;
        const LAS unsigned char* b_q1 = q1w + c16 * CS + kq * 16;
        const LAS unsigned char* a_pi = lds + L_PI + c16 * 64 + kq * 16;
        const LAS unsigned char* b_rt = rtw + c16 * 64 + kq * 16;
        asm volatile("s_waitcnt lgkmcnt(0)" ::: "memory");
#pragma unroll
        for (int I = 0; I < 4; ++I) {
            f32x4m cacc;
            if (wv < 4) {
#pragma unroll
                for (int e = 0; e < 4; ++e) cacc[e] = __uint_as_float((unsigned)(*(const LAS unsigned short*)(lds + L_AT + (16 * I + 4 * kq + e) * CS + n * 2)) << 16);
            } else cacc = *(const LAS f32x4m*)(lds + L_PF + (n - 64) * FS + (16 * I + 4 * kq) * 4);
            if (I > 0) {
#pragma unroll
                for (int ks = 0; ks < 2; ++ks) { const bf16x8 a = *(const LAS bf16x8*)(a_m2 + I * 16 * CS + ks * 64), b2 = *(const LAS bf16x8*)(b_q1 + ks * 64);
                    cacc = __builtin_amdgcn_mfma_f32_16x16x32_bf16(a, b2, cacc, 0, 0, 0); }
            }
            { v4u w; w.x = cvtpk_v(cacc[0], cacc[1]); w.y = cvtpk_v(cacc[2], cacc[3]); *(LAS unsigned long long*)(rtw + c16 * 64 + kq * 8) = (unsigned long long)w.x | ((unsigned long long)w.y << 32); }
            asm volatile("s_waitcnt lgkmcnt(0)" ::: "memory");
            const bf16x8 pa = *(const LAS bf16x8*)(a_pi + I * 1024), rb = *(const LAS bf16x8*)(b_rt);
            f32x4m q = {0.f, 0.f, 0.f, 0.f};
            q = __builtin_amdgcn_mfma_f32_16x16x32_bf16(pa, rb, q, 0, 0, 0);
            { v4u w; w.x = cvtpk_v(q[0], q[1]); w.y = cvtpk_v(q[2], q[3]); *(LAS unsigned long long*)(q1w + c16 * CS + (16 * I + 4 * kq) * 2) = (unsigned long long)w.x | ((unsigned long long)w.y << 32); }
            asm volatile("s_waitcnt lgkmcnt(0)" ::: "memory");
        }
    }
    S1_BAR(); S1T(4);
    int lane3 = lane; asm volatile("" : "+v"(lane3));
    const int hl4 = lane3 >> 5, cl4 = lane3 & 31;
    if (wv < 4) {
        f32x16 aw = {}, as = {};
        mm32(aw, lds + L_M3 + tb * 32 * CS, lds + L_Q1 + ib * 32 * CS, lane3);
        mm32(as, lds + L_BH + tb * 32 * CS, lds + L_Q1 + ib * 32 * CS, lane3);
        const int j = ib * 32 + cl4; const float gl = ((const LAS float*)(lds + L_GL))[j]; const int pc = permcol(j);
#pragma unroll
        for (int rg = 0; rg < 16; ++rg) { const int row = tb * 32 + crow(rg, hl4);
            const float rt = __uint_as_float((unsigned)(*(const LAS unsigned short*)(lds + L_RT + row * CS + j * 2)) << 16);
            st_bf16(lds + L_PF + row * CS + pc * 2, aw[rg] + rt);
            st_bf16(lds + L_PF + 9216 + row * CS + pc * 2, as[rg] + ((row == j) ? gl : 0.f)); }
    } else {
        mm32(accY, lds + L_M3 + tb * 32 * CS, lds + L_Q1 + (64 + ib * 32) * CS, lane3);
        mm32(accQ, lds + L_BH + tb * 32 * CS, lds + L_Q1 + (64 + ib * 32) * CS, lane3);
        const size_t o0 = (m0 + tb * 32 + (lane3 >> 3)) * 1024 + h * 64 + ib * 32 + (lane3 & 7) * 4;
#pragma unroll
        for (int g = 0; g < 4; ++g) { *(f32x4*)(P.Y + o0 + (size_t)g * 8 * 1024) = (f32x4){accY[4 * g], accY[4 * g + 1], accY[4 * g + 2], accY[4 * g + 3]};
            *(f32x4*)(P.DEC + o0 + (size_t)g * 8 * 1024) = (f32x4){accQ[4 * g], accQ[4 * g + 1], accQ[4 * g + 2], accQ[4 * g + 3]}; }
    }
    S1_BAR(); S1T(5);
    { const int row = tid >> 3, pc8 = tid & 7;
      *(v4u*)(P.KP + (m0 + row) * 1024 + h * 64 + pc8 * 8) = *(const LAS v4u*)(lds + L_PF + row * CS + pc8 * 16);
      *(v4u*)(P.AV + (m0 + row) * 1024 + h * 64 + pc8 * 8) = *(const LAS v4u*)(lds + L_PF + 9216 + row * CS + pc8 * 16); }
    S1_BAR(); S1T(6);
}

constexpr int S2_WY = 0, S2_WS = 9216, S2_YI = 18432, S2_QS = 35840, S2_SLOT = 53248;
struct S2Set { v4u kp, av, y0, y1, d0, d1; };
__device__ __forceinline__ void s2_load(const Ptrs& P, int b, int h, int c, int tid, S2Set& G) {
    const size_t m0 = (size_t)b * SEQ + (size_t)c * 64; const int lr = tid >> 3, lp = tid & 7, yr = tid >> 4, yp = tid & 15;
    G.kp = *(const v4u*)(P.KP + (m0 + lr) * 1024 + h * 64 + lp * 8); G.av = *(const v4u*)(P.AV + (m0 + lr) * 1024 + h * 64 + lp * 8);
    G.y0 = *(const v4u*)(P.Y + (m0 + yr) * 1024 + h * 64 + yp * 4); G.y1 = *(const v4u*)(P.Y + (m0 + 32 + yr) * 1024 + h * 64 + yp * 4);
    G.d0 = *(const v4u*)(P.DEC + (m0 + yr) * 1024 + h * 64 + yp * 4); G.d1 = *(const v4u*)(P.DEC + (m0 + 32 + yr) * 1024 + h * 64 + yp * 4);
}
__device__ __forceinline__ void s2_write(LAS unsigned char* slot, int tid, const S2Set& G) {
    const int lr = tid >> 3, lp = tid & 7, yr = tid >> 4, yp = tid & 15;
    *(LAS v4u*)(slot + S2_WY + lr * CS + lp * 16) = G.kp; *(LAS v4u*)(slot + S2_WS + lr * CS + lp * 16) = G.av;
    *(LAS v4u*)(slot + S2_YI + yr * FS + yp * 16) = G.y0; *(LAS v4u*)(slot + S2_YI + (32 + yr) * FS + yp * 16) = G.y1;
    *(LAS v4u*)(slot + S2_QS + yr * FS + yp * 16) = G.d0; *(LAS v4u*)(slot + S2_QS + (32 + yr) * FS + yp * 16) = G.d1;
}
typedef float f32x8 __attribute__((ext_vector_type(8)));
#define S2_CAT(a, b, c2, d) __builtin_shufflevector(__builtin_shufflevector(a, b, 0, 1, 2, 3, 4, 5, 6, 7), __builtin_shufflevector(c2, d, 0, 1, 2, 3, 4, 5, 6, 7), 0, 1, 2, 3, 4, 5, 6, 7, 8, 9, 10, 11, 12, 13, 14, 15)
__device__ __forceinline__ void s2_compute(const Ptrs& P, int b, int h, int ib, int c, const LAS unsigned char* slot, int lane, f32x16& X0, f32x16& X1) {
    const int r = lane & 31, hl = lane >> 5;
    bf16x8 bf[2][2];
    {
        const f32x16* X[2] = {&X0, &X1};
#pragma unroll
        for (int jb = 0; jb < 2; ++jb)
#pragma unroll
            for (int ks = 0; ks < 2; ++ks) { const f32x16& x = *X[jb]; v4u w;
                w.x = cvtpk_v(x[8 * ks], x[8 * ks + 1]); w.y = cvtpk_v(x[8 * ks + 2], x[8 * ks + 3]); w.z = cvtpk_v(x[8 * ks + 4], x[8 * ks + 5]); w.w = cvtpk_v(x[8 * ks + 6], x[8 * ks + 7]);
                bf[jb][ks] = __builtin_bit_cast(bf16x8, w); }
    }
    const LAS unsigned char* pa = slot + r * CS + hl * 16;
    const LAS unsigned char* pc = slot + (lane >> 3) * FS + ib * 128 + (lane & 7) * 16;
#define S2_TILE(base, tb) S2_CAT(*(const LAS f32x4*)(pc + (base) + ((tb) * 32) * FS), *(const LAS f32x4*)(pc + (base) + ((tb) * 32 + 8) * FS), *(const LAS f32x4*)(pc + (base) + ((tb) * 32 + 16) * FS), *(const LAS f32x4*)(pc + (base) + ((tb) * 32 + 24) * FS))
#define S2_AF(base, rb, jb, ks) (*(const LAS bf16x8*)(pa + (base) + (rb) * 32 * CS + (jb) * 64 + (ks) * 32))
    f32x16 y0 = S2_TILE(S2_YI, 0), y1 = S2_TILE(S2_YI, 1);
#pragma unroll
    for (int jb = 0; jb < 2; ++jb)
#pragma unroll
        for (int ks = 0; ks < 2; ++ks) { y0 = __builtin_amdgcn_mfma_f32_32x32x16_bf16(S2_AF(S2_WY, 0, jb, ks), bf[jb][ks], y0, 0, 0, 0); y1 = __builtin_amdgcn_mfma_f32_32x32x16_bf16(S2_AF(S2_WY, 1, jb, ks), bf[jb][ks], y1, 0, 0, 0); }
    {
        float* cb_ = P.Y + ((size_t)b * SEQ + (size_t)c * 64) * 1024; const unsigned offY = (unsigned)((4 * hl) * 1024 + h * 64 + ib * 32 + r);
#pragma unroll
        for (int rg = 0; rg < 16; ++rg) { const int rr = (rg & 3) + 8 * (rg >> 2); float *pa_ = cb_ + rr * 1024, *pb_ = cb_ + (32 + rr) * 1024; asm volatile("" : "+s"(pa_), "+s"(pb_)); pa_[offY] = y0[rg]; pb_[offY] = y1[rg]; }
    }
    f32x16 q0 = S2_TILE(S2_QS, 0), q1 = S2_TILE(S2_QS, 1);
#pragma unroll
    for (int jb = 0; jb < 2; ++jb)
#pragma unroll
        for (int ks = 0; ks < 2; ++ks) { q0 = __builtin_amdgcn_mfma_f32_32x32x16_bf16(S2_AF(S2_WS, 0, jb, ks), bf[jb][ks], q0, 0, 0, 0); q1 = __builtin_amdgcn_mfma_f32_32x32x16_bf16(S2_AF(S2_WS, 1, jb, ks), bf[jb][ks], q1, 0, 0, 0); }
    X0 = q0; X1 = q1;
#undef S2_TILE
#undef S2_AF
}
__device__ __forceinline__ void s2_block(const Ptrs& P, int bh, LAS unsigned char* lds, int tid, int wv) {
    const int b = bh >> 4, h = bh & 15, lane = tid & 63;
    constexpr int NC = SEQ / 64;
    f32x16 X0 = {}, X1 = {};
    S2Set GA, GB;
    s2_load(P, b, h, 0, tid, GA); s2_load(P, b, h, 1, tid, GB);
    s2_write(lds, tid, GA);
    s2_load(P, b, h, 2, tid, GA);
    __syncthreads();
    for (int c = 0; c < NC; c += 2) {
        s2_write(lds + S2_SLOT, tid, GB);
        if (c + 3 < NC) s2_load(P, b, h, c + 3, tid, GB);
        if (wv < 2) s2_compute(P, b, h, wv, c, lds, lane, X0, X1);
        __syncthreads();
        if (c + 2 < NC) s2_write(lds, tid, GA);
        if (c + 4 < NC) s2_load(P, b, h, c + 4, tid, GA);
        if (wv < 2) s2_compute(P, b, h, wv, c + 1, lds + S2_SLOT, lane, X0, X1);
        __syncthreads();
    }
}
#undef S2_CAT
}
__device__ __forceinline__ unsigned enc_key(float s) { const unsigned b = __float_as_uint(s); return b ^ ((b >> 31) ? 0xFFFFFFFFu : 0x80000000u); }
__device__ __forceinline__ float dec_key(unsigned u) { const unsigned b = (u & 0x80000000u) ? (u ^ 0x80000000u) : ~u; return __uint_as_float(b); }
__device__ __forceinline__ void ins16(unsigned (&L)[16], unsigned x) {
#pragma unroll
    for (int i = 0; i < 16; ++i) { const unsigned hi = max(L[i], x); x = min(L[i], x); L[i] = hi; }
}
constexpr int TK_CS = 144, TK_LO = 36864;
__device__ __forceinline__ void topk_pass(const Ptrs& P, int h, int tok0, const LAS unsigned char* lds, const int p, int lane, int w, unsigned (&L0)[16], unsigned (&L1)[16]) {
    const int r = lane & 31, hi = lane >> 5;
#pragma unroll
    for (int i = 0; i < 16; ++i) { L0[i] = 0u; L1[i] = 0u; }
    bf16x8 qf[2][4];
#pragma unroll
    for (int tt = 0; tt < 2; ++tt)
#pragma unroll
        for (int ks = 0; ks < 4; ++ks) qf[tt][ks] = *(const bf16x8*)(P.QP + (size_t)(tok0 + w * 64 + tt * 32 + r) * 1024 + h * 128 + p * 64 + ks * 16 + hi * 8);
    const LAS unsigned char* ka = lds + (size_t)(p * 128 + r) * TK_CS + hi * 16;
#pragma unroll
    for (int nt = 0; nt < 4; ++nt) {
        bf16x8 ah[4], al[4];
#pragma unroll
        for (int ks = 0; ks < 4; ++ks) { ah[ks] = *(const LAS bf16x8*)(ka + nt * 32 * TK_CS + ks * 32); al[ks] = *(const LAS bf16x8*)(ka + TK_LO + nt * 32 * TK_CS + ks * 32); }
        rk::f32x16 acc0 = {}, acc1 = {};
#pragma unroll
        for (int ks = 0; ks < 4; ++ks) { acc0 = __builtin_amdgcn_mfma_f32_32x32x16_bf16(ah[ks], qf[0][ks], acc0, 0, 0, 0); acc0 = __builtin_amdgcn_mfma_f32_32x32x16_bf16(al[ks], qf[0][ks], acc0, 0, 0, 0);
            acc1 = __builtin_amdgcn_mfma_f32_32x32x16_bf16(ah[ks], qf[1][ks], acc1, 0, 0, 0); acc1 = __builtin_amdgcn_mfma_f32_32x32x16_bf16(al[ks], qf[1][ks], acc1, 0, 0, 0); }
#pragma unroll
        for (int rg = 0; rg < 16; ++rg) { const unsigned tag = (unsigned)(127 - (nt * 32 + (rg & 3) + 8 * (rg >> 2) + 4 * hi));
            ins16(L0, (enc_key(acc0[rg]) & ~0x7Fu) | tag); ins16(L1, (enc_key(acc1[rg]) & ~0x7Fu) | tag); }
    }
}
__device__ __forceinline__ void peer_topk(const Ptrs& P, int h, int tok0, LAS unsigned char* lds, int tid) {
    const int lane = tid & 63, w = tid >> 6, r = lane & 31, hi = lane >> 5;
    {
        const int row = tid >> 1, d0 = (tid & 1) * 32; const float* src = P.sub_keys + ((size_t)h * 256 + row) * 64 + d0;
#pragma unroll
        for (int j = 0; j < 4; ++j) { const f32x4 a = *(const f32x4*)(src + 8 * j), b = *(const f32x4*)(src + 8 * j + 4);
            const float x[8] = {a.x, a.y, a.z, a.w, b.x, b.y, b.z, b.w}; float lo[8]; v4u vh, vl;
#pragma unroll
            for (int e = 0; e < 8; ++e) { const float hb = __uint_as_float(f2bf(x[e]) << 16); lo[e] = x[e] - hb; }
            vh.x = pk2(x[0], x[1]); vh.y = pk2(x[2], x[3]); vh.z = pk2(x[4], x[5]); vh.w = pk2(x[6], x[7]);
            vl.x = pk2(lo[0], lo[1]); vl.y = pk2(lo[2], lo[3]); vl.z = pk2(lo[4], lo[5]); vl.w = pk2(lo[6], lo[7]);
            *(LAS v4u*)(lds + row * TK_CS + (d0 + 8 * j) * 2) = vh; *(LAS v4u*)(lds + TK_LO + row * TK_CS + (d0 + 8 * j) * 2) = vl; }
    }
    __syncthreads();
    unsigned L00[16], L01[16], L10[16], L11[16];
    topk_pass(P, h, tok0, lds, 0, lane, w, L00, L01);
    topk_pass(P, h, tok0, lds, 1, lane, w, L10, L11);
    unsigned M1[2][16];
#pragma unroll
    for (int i = 0; i < 16; ++i) { M1[0][i] = hi ? L01[i] : L00[i]; M1[1][i] = hi ? L11[i] : L10[i]; }
#pragma unroll
    for (int i = 0; i < 16; ++i) { const unsigned s0 = hi ? L00[i] : L01[i], s1 = hi ? L10[i] : L11[i]; ins16(M1[0], (unsigned)__shfl_xor((int)s0, 32)); ins16(M1[1], (unsigned)__shfl_xor((int)s1, 32)); }
    const int t = tok0 + w * 64 + hi * 32 + r;
    unsigned F[16];
#pragma unroll
    for (int i = 0; i < 16; ++i) F[i] = 0u;
    float v1[16], v2[16];
#pragma unroll
    for (int i = 0; i < 16; ++i) { v1[i] = dec_key((M1[0][i] & ~0x7Fu) | 0x40u); v2[i] = dec_key((M1[1][i] & ~0x7Fu) | 0x40u); }
#pragma unroll
    for (int a = 0; a < 16; ++a)
#pragma unroll
        for (int b = 0; b < 16; ++b)
            if ((a + 1) * (b + 1) <= 16) ins16(F, (enc_key(v1[a] + v2[b]) & ~0xFFu) | (unsigned)(255 - (16 * a + b)));
    float sv[16]; unsigned id[16];
#pragma unroll
    for (int i = 0; i < 16; ++i) {
        sv[i] = dec_key((F[i] & ~0xFFu) | 0x80u);
        const unsigned ab = 255u - (F[i] & 0xFFu), a = ab >> 4, b = ab & 15u;
        unsigned la = 0u, lb = 0u;
#pragma unroll
        for (int j = 0; j < 16; ++j) { la = (a == (unsigned)j) ? M1[0][j] : la; lb = (b == (unsigned)j) ? M1[1][j] : lb; }
        id[i] = (127u - (la & 0x7Fu)) * 128u + (127u - (lb & 0x7Fu));
    }
    float z = 0.f;
#pragma unroll
    for (int i = 0; i < 16; ++i) { sv[i] = __expf(sv[i] - sv[0]); z += sv[i]; }
    const float rz = 1.0f / z;
    float* gdst = P.GATE + (size_t)t * 128 + h * 16;
#pragma unroll
    for (int i = 0; i < 16; i += 4) *(f32x4*)(gdst + i) = (f32x4){sv[i] * rz, sv[i + 1] * rz, sv[i + 2] * rz, sv[i + 3] * rz};
    unsigned short* idst = P.IDX + (size_t)t * 128 + h * 16;
    *(v4u*)idst = (v4u){id[0] | (id[1] << 16), id[2] | (id[3] << 16), id[4] | (id[5] << 16), id[6] | (id[7] << 16)};
    *(v4u*)(idst + 8) = (v4u){id[8] | (id[9] << 16), id[10] | (id[11] << 16), id[12] | (id[13] << 16), id[14] | (id[15] << 16)};
    __syncthreads();
}

__device__ __forceinline__ float gelu_erf(float x) { return 0.5f * x * (1.0f + erff(x * 0.70710678118654752f)); }
typedef float f32x2v __attribute__((ext_vector_type(2)));
__device__ __forceinline__ void ld_row4(const unsigned char* row, int lane, float (&r)[32]) {
    const v4u u = *(const v4u*)(row + lane * 16); const unsigned w[4] = {u.x, u.y, u.z, u.w};
#pragma unroll
    for (int d = 0; d < 4; ++d) {
        const f32x2v a = __builtin_amdgcn_cvt_scalef32_pk_f32_fp4(w[d], 1.0f, 0), b = __builtin_amdgcn_cvt_scalef32_pk_f32_fp4(w[d], 1.0f, 1), c2 = __builtin_amdgcn_cvt_scalef32_pk_f32_fp4(w[d], 1.0f, 2), d2 = __builtin_amdgcn_cvt_scalef32_pk_f32_fp4(w[d], 1.0f, 3);
        r[8 * d] = a.x; r[8 * d + 1] = a.y; r[8 * d + 2] = b.x; r[8 * d + 3] = b.y; r[8 * d + 4] = c2.x; r[8 * d + 5] = c2.y; r[8 * d + 6] = d2.x; r[8 * d + 7] = d2.y; }
}
__device__ __forceinline__ void peer_token(const Ptrs& P, int t, int lane) {
    float x2[32];
    float ss_t = 0.f;
#pragma unroll
    for (int i = 0; i < 8; ++i) { const f32x4 s4 = *(const f32x4*)(P.SSQ + (size_t)t * 32 + 4 * i); ss_t += (s4.x + s4.y) + (s4.z + s4.w); }
    const float rs_t = 1.0f / sqrtf(ss_t * (1.0f / DMODEL) + 1e-6f);
    { const bf16* xr = P.XN + (size_t)t * 2048 + lane * 4;
#pragma unroll
      for (int j = 0; j < 8; ++j) { const unsigned long long u = *(const unsigned long long*)(xr + 256 * j); const unsigned lo = (unsigned)u, hi2 = (unsigned)(u >> 32);
          x2[4 * j] = bflo(lo) * rs_t; x2[4 * j + 1] = bfhi(lo) * rs_t; x2[4 * j + 2] = bflo(hi2) * rs_t; x2[4 * j + 3] = bfhi(hi2) * rs_t; } }
    unsigned idxv[2]; float wv[2];
#pragma unroll
    for (int kb = 0; kb < 2; ++kb) {
        idxv[kb] = P.IDX[(size_t)t * 128 + kb * 64 + lane];
        float p[64];
#pragma unroll
        for (int i = 0; i < 64; ++i) {
            const unsigned e = (unsigned)__builtin_amdgcn_readlane((int)idxv[kb], i);
            float r[32]; ld_row4(P.U8 + (size_t)e * ROW6, lane, r);
            float a0 = 0.f, a1 = 0.f, a2 = 0.f, a3 = 0.f;
#pragma unroll
            for (int q = 0; q < 8; ++q) { a0 += r[4 * q] * x2[4 * q]; a1 += r[4 * q + 1] * x2[4 * q + 1]; a2 += r[4 * q + 2] * x2[4 * q + 2]; a3 += r[4 * q + 3] * x2[4 * q + 3]; }
            p[i] = (a0 + a1) + (a2 + a3);
        }
#pragma unroll
        for (int o = 32, n = 64; o >= 1; o >>= 1, n >>= 1) {
            const bool up = (lane & o) != 0;
#pragma unroll
            for (int i = 0; i < n / 2; ++i) { const float keep = up ? p[i + n / 2] : p[i], send = up ? p[i] : p[i + n / 2]; p[i] = keep + __shfl_xor(send, o); }
        }
        const unsigned e = idxv[kb];
        const float hk = gelu_erf(p[0] * P.USC[e]);
        wv[kb] = P.GATE[(size_t)t * 128 + kb * 64 + lane] * hk * P.VSC[e];
    }
    float acc[32];
#pragma unroll
    for (int i = 0; i < 32; ++i) acc[i] = 0.f;
#pragma unroll
    for (int kb = 0; kb < 2; ++kb) {
#pragma unroll 16
        for (int i = 0; i < 64; ++i) {
            const unsigned e = (unsigned)__builtin_amdgcn_readlane((int)idxv[kb], i);
            const float wk = __uint_as_float((unsigned)__builtin_amdgcn_readlane((int)__float_as_uint(wv[kb]), i));
            float r[32]; ld_row4(P.V8 + (size_t)e * ROW6, lane, r);
#pragma unroll
            for (int q = 0; q < 32; ++q) acc[q] += wk * r[q];
        }
    }
    float* orow = P.out + (size_t)t * 2048 + lane * 4;
#pragma unroll
    for (int q = 0; q < 8; ++q) { f32x4* o = (f32x4*)(orow + 256 * q); f32x4 v = *o;
        v.x += acc[4 * q]; v.y += acc[4 * q + 1]; v.z += acc[4 * q + 2]; v.w += acc[4 * q + 3]; *o = v; }
}
struct AttnQueue {
    gu32* ctr; volatile LAS unsigned* slot; int tid; unsigned q0;
    __device__ __forceinline__ bool next(int i, attn_body::AttnUnit& u) const {
        if (tid == 0) {
            unsigned k = slot[2], v = 0xFFFFFFFFu;
            while (k < 8u) { const unsigned q = (q0 + k) & 7u; const unsigned t = __hip_atomic_fetch_add(ctr + 64 * q, 1u, RLX_AGENT); if (t < 128u) { v = (q << 16) | t; break; } ++k; }
            slot[2] = k; slot[i & 1] = v;
        }
        __syncthreads();
        const unsigned v = (unsigned)__builtin_amdgcn_readfirstlane((int)slot[i & 1]);
        if (v == 0xFFFFFFFFu) return false;
        const unsigned q = v >> 16, t = v & 0xFFFFu;
        u.qb = 31 - (int)(t >> 2); u.bh = (int)(q + 8u * (t & 3u)); return true;
    }
    __device__ __forceinline__ void a_ready(const attn_body::AttnUnit&) const {}
    __device__ __forceinline__ void done(const attn_body::AttnUnit&) const {}
};

struct Args { const float* in[23]; float* out; unsigned char* ws; };

__device__ __forceinline__ int lane_id_fresh() { int l; asm volatile("v_mbcnt_lo_u32_b32 %0, -1, 0\n\tv_mbcnt_hi_u32_b32 %0, -1, %0" : "=v"(l)); return l; }
__device__ __forceinline__ Frame make_frame(unsigned char* lds, int wv) {
    Frame F; F.lds = (LAS unsigned char*)lds; F.MISC = (volatile LAS unsigned*)(F.lds + MISC_OFF); F.ctl = nullptr;
    F.lane = lane_id_fresh(); F.wave = wv; F.tid = wv * 64 + F.lane;
    F.G = gridDim.x; { const int bx = blockIdx.x; F.vcu = (F.G % 8 == 0) ? (bx % 8) * (F.G / 8) + bx / 8 : bx; }
    return F;
}
typedef __attribute__((address_space(4))) const unsigned long long kau64;
__device__ __forceinline__ Ptrs make_ptrs(kau64* ka) {
    Ptrs P; struct { const float* in[23]; } args;
#pragma unroll
    for (int i = 0; i < 23; ++i) args.in[i] = (const float*)(GAS const float*)ka[i];
    float* outp = (float*)(GAS float*)ka[23]; unsigned char* ws = (unsigned char*)(GAS unsigned char*)ka[24];
    P.x = args.in[0]; P.norm1_g = args.in[1]; P.w_in = args.in[2]; P.mu = args.in[3]; P.w_decay_up = args.in[4]; P.w0 = args.in[5]; P.w_iclr_up = args.in[6]; P.a0 = args.in[7];
    P.w_gate_up = args.in[8]; P.k_k = args.in[9]; P.k_a = args.in[10]; P.r_k = args.in[11]; P.lnx_g = args.in[12]; P.lnx_b = args.in[13]; P.fox_b_f = args.in[14];
    P.q_norm_g = args.in[15]; P.k_norm_g = args.in[16]; P.w_out = args.in[17]; P.norm2_g = args.in[18]; P.w_q = args.in[19]; P.sub_keys = args.in[20]; P.peer_u = args.in[21]; P.peer_v = args.in[22];
    P.out = outp;
    P.WQT = (bf16*)(ws + WS_WQT); P.LWT = (bf16*)(ws + WS_LWT); P.WOT = (bf16*)(ws + WS_WOT); P.WINT = (bf16*)(ws + WS_WINT); P.LA = (bf16*)(ws + WS_LA);
    P.XN = (bf16*)(ws + WS_XN); P.PROJ = (bf16*)(ws + WS_PROJ); P.MIXED = (bf16*)(ws + WS_MIXED); P.KP = (bf16*)(ws + WS_KP); P.AV = (bf16*)(ws + WS_AV); P.BV = (bf16*)(ws + WS_BV);
    P.QP = (bf16*)(ws + WS_QP); P.G = (bf16*)((unsigned char*)outp + OUT_G); P.AIC = (bf16*)((unsigned char*)outp + OUT_AIC);
    P.C2 = (float*)(ws + WS_C2); P.BON = (float*)(ws + WS_BON); P.Y = (float*)(ws + WS_XN); P.DEC = (float*)((unsigned char*)outp + OUT_DEC);
    P.GATE = (float*)(ws + WS_GATE); P.USC = (float*)(ws + WS_USC); P.VSC = (float*)(ws + WS_VSC); P.SSQ = (float*)(ws + WS_SSQ);
    P.IDX = (unsigned short*)(ws + WS_IDX); P.U8 = ws + WS_U8; P.V8 = ws + WS_V8;
    return P;
}
#define PHASE_BEGIN() Frame F = make_frame(lds, wv_); const int gw = F.vcu * NWAVES + F.wave, NGW = F.G * NWAVES; (void)gw; (void)NGW; kau64* ka_ = (kau64*)__builtin_amdgcn_kernarg_segment_ptr(); asm volatile("" : "+s"(ka_)); \
    const Ptrs P = make_ptrs(ka_); unsigned char* ws_ = (unsigned char*)(GAS unsigned char*)ka_[24]; (void)ws_; \
    const int lane = F.lane, tid = F.tid; (void)lane; (void)tid
__global__ void __launch_bounds__(NWAVES * 64, 2) hymba_fwd(Args args) {
    extern __shared__ __attribute__((aligned(16))) unsigned char lds[];
    const int wv_ = __builtin_amdgcn_readfirstlane((int)threadIdx.x >> 6);
    { Frame F = make_frame(lds, wv_);
    for (int u = F.tid; u < (LDS_BYTES - LDSCTL_OFF) / 4; u += NWAVES * 64) ((LAS unsigned*)(F.lds + LDSCTL_OFF))[u] = 0u;
    __syncthreads();
    { kau64* kb_ = (kau64*)__builtin_amdgcn_kernarg_segment_ptr(); F.ctl = (gu32*)((GAS unsigned char*)kb_[24] + WS_CTL); }
    (void)xcd_barrier_post((unsigned*)(F.ctl + CW_BAR), F.MISC + 8, F.tid); }
#ifdef PROBE_MASK
#define STAMP(k) do { if (blockIdx.x == 0 && wv_ == 0) { unsigned long long t_; __builtin_amdgcn_sched_barrier(0); asm volatile("s_memrealtime %0\n\ts_waitcnt lgkmcnt(0)" : "=s"(t_) :: "memory"); __builtin_amdgcn_sched_barrier(0); if (lane_id_fresh() == 0) { ((volatile LAS unsigned*)((LAS unsigned char*)lds + MISC_OFF))[64 + (k)] = (unsigned)t_; } } } while (0)
#else
#define STAMP(k) do {} while (0)
#endif
#define GRID_BAR() do { kau64* kb_ = (kau64*)__builtin_amdgcn_kernarg_segment_ptr(); asm volatile("" : "+s"(kb_)); XcdBarrier b_; b_.bar = (unsigned*)((gu32*)((GAS unsigned char*)kb_[24] + WS_CTL) + CW_BAR); b_.x = xb_xcc_id(); b_.st = (volatile LAS unsigned*)((LAS unsigned char*)lds + MISC_OFF) + 8; xcd_barrier(b_, wv_ * 64 + lane_id_fresh()); } while (0)

    STAMP(0);
    { PHASE_BEGIN();
        LAS float* scr = (LAS float*)(F.lds + RING_OFF + F.wave * 16384);
        constexpr int B_IN = 32 * 26, B_O = 32 * 8, B_Q = 32 * 4, I_L = 2 * 32;
        {
            auto item_of = [&](int it) -> TrItem { int r = it;
                if (r < B_IN) return TrItem{P.w_in, P.WINT, 2048, NIN, 2048, r / 26, r % 26}; r -= B_IN;
                if (r < B_O) return TrItem{P.w_out, P.WOT, 2048, 2048, 2048, r / 8, r % 8}; r -= B_O;
                return TrItem{P.w_q, P.WQT, 2048, 1024, 2048, r / 4, r % 4}; };
            LAS float* bscr = (LAS float*)(F.lds + RING_OFF); TrRegs T0, T1; int it = (int)blockIdx.x;
            if (it < B_IN + B_O + B_Q) tr_load(item_of(it), tid, T0);
            for (; it < B_IN + B_O + B_Q; it += F.G) { const int nx = it + F.G;
                if (nx < B_IN + B_O + B_Q) tr_load(item_of(nx), tid, T1);
                tr_finish(item_of(it), T0, bscr, tid); T0 = T1; }
        }
        for (int it = gw; it < 3 * I_L; it += NGW) {
            int r = it;
            if (r < I_L) { p0_transpose_item(P.w_decay_up, 64, 1024, P.LWT, 128, scr, r / 32, r % 32, lane); continue; } r -= I_L;
            if (r < I_L) { p0_transpose_item(P.w_iclr_up, 64, 1024, P.LWT + 1024 * 128, 128, scr, r / 32, r % 32, lane); continue; } r -= I_L;
            p0_transpose_item(P.w_gate_up, 128, 1024, P.LWT + 2 * 1024 * 128, 128, scr, r / 32, r % 32, lane);
        }
        STAMP(16);
        {
            Row8 R0, R1; int e = gw;
            if (e < 2 * NEXP) ld_row8((e < NEXP ? P.peer_u : P.peer_v - (size_t)NEXP * 2048) + (size_t)e * 2048, lane, R0);
            for (; e < 2 * NEXP; e += NGW) {
                const int en = e + NGW;
                if (en < 2 * NEXP) ld_row8((en < NEXP ? P.peer_u : P.peer_v - (size_t)NEXP * 2048) + (size_t)en * 2048, lane, R1);
                if (e < NEXP) fp4_finish(R0, P.U8 + (size_t)e * ROW6, P.USC + e, lane); else fp4_finish(R0, P.V8 + (size_t)(e - NEXP) * ROW6, P.VSC + (e - NEXP), lane);
                R0 = R1;
            }
        }
        STAMP(17);
        {   Row8 R0, R1; int mr = gw;
            if (mr < M) ld_row8(P.x + (size_t)mr * DMODEL, lane, R0);
            for (; mr < M; mr += NGW) { const int mn = mr + NGW; if (mn < M) ld_row8(P.x + (size_t)mn * DMODEL, lane, R1);
                rms_finish(R0, P.norm1_g, P.XN + (size_t)mr * DMODEL, lane); R0 = R1; }
        }
    }
    GRID_BAR(); STAMP(1);
    { PHASE_BEGIN();
        pg8::Gemm g{P.XN, P.WINT, M, PJ, DMODEL}; pg8::StaticOrder S; S.init(M, PJ, F.G, (int)blockIdx.x);
        pg8::EpiBf16<0> E{P.PROJ, PJ, nullptr, 0, 0, 1.f};
        pg8::gemm_phase<pg8::EpiBf16<0>, pg8::StaticOrder, PG8_ALIGN, PG8_SP2>(F.lds + RING_OFF, g, S, E, tid);
    }
    GRID_BAR(); STAMP(2);
    { PHASE_BEGIN();
        if (blockIdx.x < 32) fox_cumsum(P, (int)blockIdx.x, (LAS float*)(F.lds + RING_OFF), tid);
        for (int m = gw; m < M; m += NGW) prepA_token(P, m, lane);
    }
    GRID_BAR(); STAMP(3);
    { PHASE_BEGIN();
        pg8::Gemm g{P.LA, P.LWT, M, 3072, 128, 4, (size_t)M * 128 * 2}; pg8::StaticOrder S; S.init(M, 3072, F.G, (int)blockIdx.x);
        pg8::EpiLora3 E{P.w0, P.a0, P.DEC, P.AIC, P.G};
        pg8::gemm_phase<pg8::EpiLora3, pg8::StaticOrder, PG8_ALIGN, PG8_SP2>(F.lds + RING_OFF, g, S, E, tid);
    }
    GRID_BAR(); STAMP(4);
    STAMP(5);
    { PHASE_BEGIN(); rk::S1Regs R; int u = (int)blockIdx.x; if (u < 4096) rk::s1_load(P, u, tid, R);
#ifdef PROBE_MASK
      if (blockIdx.x == 0 && F.wave == 0) { unsigned long long t_; asm volatile("s_memrealtime %0\n\ts_waitcnt lgkmcnt(0)" : "=s"(t_) :: "memory"); if (lane == 0) ((volatile LAS unsigned*)((LAS unsigned char*)lds + MISC_OFF))[103] = (unsigned)t_; }
#endif
      for (; u < 4096; u += F.G) rk::s1_unit(P, u, u + F.G, R, F.lds + RING_OFF, tid, F.wave); }
    GRID_BAR(); STAMP(13);
    { PHASE_BEGIN();
        if (blockIdx.x < 32) rk::s2_block(P, (int)blockIdx.x, F.lds + RING_OFF, tid, F.wave);
        {
            static_assert(attn_body::ATTN_LDS_BYTES <= RING_BYTES, "attention LDS");
            const attn_body::AttnTensors AT{(const attn_body::bf16*)(P.PROJ + C_FQ), (const attn_body::bf16*)(P.PROJ + C_FK), (const attn_body::bf16*)(P.PROJ + C_FV), (attn_body::bf16*)(P.MIXED + 1024), P.C2};
            const AttnQueue S{(gu32*)(ws_ + WS_CTL) + CW_QUEUE, F.MISC + 16, tid, xb_xcc_id() & 7u};
            attn_body::attn_phase<AttnQueue>((char*)lds + RING_OFF, AT, S, tid);
            STAMP(14);
        }
    }
    GRID_BAR(); STAMP(6);
    { PHASE_BEGIN();
        for (int m = gw; m < M; m += NGW) post_token(P, m, lane);
    }
    GRID_BAR(); STAMP(7);
    { PHASE_BEGIN();
        pg8::Gemm g{P.MIXED, P.WOT, M, DMODEL, DMODEL}; pg8::StaticOrder S; S.init(M, DMODEL, F.G, (int)blockIdx.x);
        pg8::EpiResNorm E{P.x, P.out, P.XN, P.norm2_g, (float*)(ws_ + WS_SSQ), DMODEL};
        pg8::gemm_phase<pg8::EpiResNorm, pg8::StaticOrder, PG8_ALIGN, PG8_SP2>(F.lds + RING_OFF, g, S, E, tid);
    }
    GRID_BAR(); STAMP(8);
    STAMP(9);
    { PHASE_BEGIN();
        pg8::Gemm g{P.XN, P.WQT, M, 1024, DMODEL}; pg8::StaticOrder S; S.init(M, 1024, F.G, (int)blockIdx.x);
        pg8::EpiBf16RowNorm E{P.QP, 1024, (const float*)(ws_ + WS_SSQ), 1.0f / DMODEL, 1e-6f};
        pg8::gemm_phase<pg8::EpiBf16RowNorm, pg8::StaticOrder, PG8_ALIGN, PG8_SP2>(F.lds + RING_OFF, g, S, E, tid);
    }
    GRID_BAR(); STAMP(10);
    { PHASE_BEGIN(); for (int it = (int)blockIdx.x; it < 8 * (M / 512); it += F.G) peer_topk(P, it & 7, (it >> 3) * 512, F.lds + RING_OFF, tid); }
    GRID_BAR(); STAMP(11);
    { PHASE_BEGIN(); for (int t = gw; t < M; t += NGW) peer_token(P, t, lane); }
#ifdef PROBE_MASK
    GRID_BAR();
    STAMP(12);
    if (blockIdx.x == 0 && wv_ == 0) { asm volatile("s_waitcnt lgkmcnt(0)" ::: "memory"); volatile LAS unsigned* ts_ = (volatile LAS unsigned*)((LAS unsigned char*)lds + MISC_OFF) + 64; unsigned tot = 0;
      for (int k = 0; k < 12; ++k) if ((PROBE_MASK >> k) & 1) tot += ts_[k + 1] - ts_[k];
      if ((PROBE_MASK >> 12) & 1) tot += ts_[13] - ts_[5];
      if ((PROBE_MASK >> 13) & 1) tot += ts_[6] - ts_[13];
      if ((PROBE_MASK >> 15) & 1) tot += ts_[15] - ts_[11];
      if ((PROBE_MASK >> 16) & 1) tot += ts_[12] - ts_[15];
      for (int k = 0; k < 7; ++k) if ((PROBE_MASK >> (17 + k)) & 1) tot += ((volatile LAS unsigned*)((LAS unsigned char*)lds + MISC_OFF))[96 + k];
      if ((PROBE_MASK >> 24) & 1) tot += ts_[16] - ts_[0];
      if ((PROBE_MASK >> 25) & 1) tot += ts_[17] - ts_[16];
      if ((PROBE_MASK >> 26) & 1) tot += ts_[1] - ts_[17];
      if ((PROBE_MASK >> 14) & 1) tot += ts_[14] - ts_[13];
      const unsigned long long t0_ = __builtin_amdgcn_s_memrealtime(); while ((unsigned)(__builtin_amdgcn_s_memrealtime() - t0_) < tot) __builtin_amdgcn_s_sleep(8); }
#endif
}

extern "C" void kernel_launch(void* const* d_in, const int* in_sizes, int n_in, void* d_out, int out_size, void* d_ws, size_t ws_size, hipStream_t stream) {
    static int grid = 0;
    if (grid == 0) {
        if (n_in != 23 || out_size != M * DMODEL || ws_size < WS_END) { fprintf(stderr, "kernel_launch: unexpected shapes (n_in %d, out %d, ws %zu); nothing launched\n", n_in, out_size, ws_size); grid = -1; return; }
        int dev = 0, cus = 0;
        if (hipGetDevice(&dev) != hipSuccess || hipDeviceGetAttribute(&cus, hipDeviceAttributeMultiprocessorCount, dev) != hipSuccess) { grid = -1; return; }
        if (hipFuncSetAttribute((const void*)hymba_fwd, hipFuncAttributeMaxDynamicSharedMemorySize, LDS_BYTES) != hipSuccess) { fprintf(stderr, "kernel_launch: hipFuncSetAttribute failed\n"); grid = -1; return; }
        int per_cu = 0;
        if (hipOccupancyMaxActiveBlocksPerMultiprocessor(&per_cu, (const void*)hymba_fwd, NWAVES * 64, LDS_BYTES) != hipSuccess || per_cu < 1) fprintf(stderr, "kernel_launch: occupancy query reports %d\n", per_cu);
        (void)hipGetLastError();
        grid = cus;
    }
    if (grid < 0) return;
    if (hipMemsetAsync((char*)d_ws + WS_CTL, 0, CTL_ZERO_BYTES, stream) != hipSuccess) return;
    Args a{};
    for (int i = 0; i < 23; ++i) a.in[i] = (const float*)d_in[i];
    a.out = (float*)d_out; a.ws = (unsigned char*)d_ws;
    hipLaunchKernelGGL(hymba_fwd, dim3(grid), dim3(NWAVES * 64), LDS_BYTES, stream, a);
}
```

```cpp
#include <hip/hip_runtime.h>
#include <cstdio>
#include <cstdint>
namespace pg8 {
#define PG8_LAS __attribute__((address_space(3)))
typedef unsigned short bf16_t;
typedef short bf16x8 __attribute__((ext_vector_type(8)));
typedef float f32x4 __attribute__((ext_vector_type(4)));
typedef unsigned u32x4 __attribute__((ext_vector_type(4)));
constexpr int BM = 256, BK = 64, HALF = 128, HTB = HALF * BK * 2  , STAGE_BYTES = 8 * HTB, NXCD = 8, WGM = 8;

__host__ __device__ __forceinline__ int lds_byte(int r, int c) { const int st = (r >> 4) * 2 + (c >> 5), rr = r & 15, cc = c & 31, ob = rr * 64 + cc * 2; return st * 1024 + (ob ^ (((ob >> 9) & 1) << 5)); }
__host__ __device__ __forceinline__ void stage_rc(int b, int& R, int& C) { const int st = b / 1024, sb = b % 1024, swz = sb ^ (((sb >> 9) & 1) << 5); R = (st >> 1) * 16 + swz / 64; C = (st & 1) * 32 + (swz % 64) / 2; }
__host__ __device__ __forceinline__ int perm32(int rho) { const int n = rho >> 4, i = rho & 15; return 8 * (i >> 2) + 4 * n + (i & 3); }

struct Unit { int pm, pn; };
struct Gemm { const bf16_t* A; const bf16_t* Bt; int M, N, K; int adiv = 1 << 20; size_t astride = 0; };

struct StaticOrder {
    int nM, nN, nwg, G, c;
    __host__ __device__ void init(int M, int N, int G_, int c_) { nM = M / BM; nN = N / BM; nwg = nM * nN; G = G_; c = c_; }
    __host__ __device__ bool next(int i, Unit& u) const {
        const long L = (long)i * G + c; if (L >= nwg) return false;
        int wgid = (int)L; { const int q = nwg / NXCD, r = nwg % NXCD, xcd = wgid % NXCD, off = wgid / NXCD; wgid = (xcd < r ? xcd * (q + 1) : r * (q + 1) + (xcd - r) * q) + off; }
        const int nig = WGM * nN, gid = wgid / nig, fm = gid * WGM, gsz = (nM - fm) < WGM ? (nM - fm) : WGM;
        u.pm = fm + ((wgid % nig) % gsz); u.pn = (wgid % nig) / gsz; return true;
    }
    __device__ __forceinline__ void a_ready(const Unit&) const {}
    __device__ __forceinline__ void done(const Unit&) const {}
};

__device__ __forceinline__ unsigned cvt_pk_bf16(float lo, float hi) { unsigned r; asm volatile("v_cvt_pk_bf16_f32 %0, %1, %2" : "=v"(r) : "v"(lo), "v"(hi)); return r; }
typedef float f32x2 __attribute__((ext_vector_type(2)));
__device__ __forceinline__ f32x2 gelu_pk(f32x2 v) {
    const f32x2 av = __builtin_elementwise_abs(v), d = av * 0.2316418882f + 1.0f;
    f32x2 t; t.x = __builtin_amdgcn_rcpf(d.x); t.y = __builtin_amdgcn_rcpf(d.y);
    f32x2 q = t * 0.5307027145f + (-0.7265760135f); q = q * t + 0.7107068705f; q = q * t + (-0.142248368f); q = q * t + 0.127414796f; q = q * t;
    const f32x2 s = (v * v) * (-0.72134752044f);
    f32x2 e; e.x = __builtin_amdgcn_exp2f(s.x); e.y = __builtin_amdgcn_exp2f(s.y);
    const f32x2 m = v * (q * e), r = v - m;
    f32x2 o; o.x = v.x < 0.f ? m.x : r.x; o.y = v.y < 0.f ? m.y : r.y; return o;
}

template <int ACT  > struct EpiBf16 {
    static constexpr bool PERM = true, AFTER_DRAIN = false; static_assert(ACT == 0 || ACT == 1, "EpiBf16: ACT is 0 (none) or 1 (gelu_pk)");
    bf16_t* O; int ldc; const float* bias; int split_cols; size_t split_stride; float scale0;
    __device__ __forceinline__ void operator()(const f32x4 (&acc)[2][2][4][2], const Unit& u, int wr, int wc, int fr, int fq) const {
        const int row0 = u.pm * BM + wr * 64 + fr; int colt = u.pn * BM; bf16_t* base = O;
        float sc = 1.f; if (split_cols) { const int t = colt / split_cols; base += (size_t)t * split_stride; colt -= t * split_cols; if (t == 0) sc = scale0; }
        const int col0 = colt + wc * 32 + 8 * fq, bcol0 = u.pn * BM + wc * 32 + 8 * fq;
        f32x4 bv[2][2];
#pragma unroll
        for (int bj = 0; bj < 2; ++bj)
#pragma unroll
            for (int n = 0; n < 2; ++n) bv[bj][n] = bias ? *(const f32x4*)(bias + bcol0 + bj * HALF + 4 * n) : (f32x4){0.f, 0.f, 0.f, 0.f};
#pragma unroll
        for (int ai = 0; ai < 2; ++ai)
#pragma unroll
            for (int m = 0; m < 4; ++m) { bf16_t* rowp = base + (size_t)(row0 + ai * HALF + m * 16) * ldc + col0;
#pragma unroll
                for (int bj = 0; bj < 2; ++bj) { f32x4 v0 = acc[ai][bj][m][0] + bv[bj][0], v1 = acc[ai][bj][m][1] + bv[bj][1];
                    if (ACT == 1) { f32x2 a = gelu_pk((f32x2){v0[0], v0[1]}), b = gelu_pk((f32x2){v0[2], v0[3]}), c = gelu_pk((f32x2){v1[0], v1[1]}), d = gelu_pk((f32x2){v1[2], v1[3]});
                        v0 = (f32x4){a.x, a.y, b.x, b.y}; v1 = (f32x4){c.x, c.y, d.x, d.y}; }
                    v0 = v0 * sc; v1 = v1 * sc; u32x4 w; w.x = cvt_pk_bf16(v0[0], v0[1]); w.y = cvt_pk_bf16(v0[2], v0[3]); w.z = cvt_pk_bf16(v1[0], v1[1]); w.w = cvt_pk_bf16(v1[2], v1[3]);
                    *(u32x4*)(rowp + bj * HALF) = w; } }
    }
};

typedef unsigned u32x2 __attribute__((ext_vector_type(2)));
struct EpiResF32 {
    static constexpr bool PERM = false, AFTER_DRAIN = false;
    const float* base; float* out; int ldc;
    __device__ __forceinline__ void operator()(const f32x4 (&acc)[2][2][4][2], const Unit& u, int wr, int wc, int fr, int fq) const {
        const int col0 = u.pn * BM + wc * 32 + 4 * fq;
#pragma unroll
        for (int ai = 0; ai < 2; ++ai)
#pragma unroll
            for (int m = 0; m < 4; ++m) { const size_t off = (size_t)(u.pm * BM + ai * HALF + wr * 64 + m * 16 + fr) * ldc + col0;
#pragma unroll
                for (int bj = 0; bj < 2; ++bj)
#pragma unroll
                    for (int n = 0; n < 2; ++n) { const f32x4 b = *(const f32x4*)(base + off + bj * HALF + n * 16); *(f32x4*)(out + off + bj * HALF + n * 16) = b + acc[ai][bj][m][n]; }
                asm volatile("" ::: "memory"); }
    }
};
struct EpiLora3 {
    static constexpr bool PERM = false, AFTER_DRAIN = false;
    const float* w0; const float* a0; float* dec; bf16_t* aic; bf16_t* gg;
    __device__ __forceinline__ void operator()(const f32x4 (&acc)[2][2][4][2], const Unit& u, int wr, int wc, int fr, int fq) const {
        const int br = u.pn >> 2; const int col0 = (u.pn & 3) * BM + wc * 32 + 4 * fq;
        const float* vec = (br == 0) ? w0 : (br == 1) ? a0 : nullptr; bf16_t* outh = (br == 1) ? aic : gg;
#pragma unroll
        for (int bj = 0; bj < 2; ++bj)
#pragma unroll
            for (int n = 0; n < 2; ++n) { const int col = col0 + bj * HALF + n * 16;
                f32x4 p = (f32x4){0.f, 0.f, 0.f, 0.f}; if (vec) p = *(const f32x4*)(vec + col);
#pragma unroll
                for (int ai = 0; ai < 2; ++ai)
#pragma unroll
                    for (int m = 0; m < 4; ++m) { const size_t off = (size_t)(u.pm * BM + ai * HALF + wr * 64 + m * 16 + fr) * 1024 + col;
                        const f32x4 z = acc[ai][bj][m][n] + p;
                        if (br == 0) *(f32x4*)(dec + off) = z;
                        else { u32x2 w; w.x = cvt_pk_bf16(z[0], z[1]); w.y = cvt_pk_bf16(z[2], z[3]); *(u32x2*)(outh + off) = w; } } }
    }
};
struct EpiResNorm {
    static constexpr bool PERM = false, AFTER_DRAIN = false;
    const float* base; float* out; bf16_t* hb; const float* g; float* ssq; int ldc;
    __device__ __forceinline__ void operator()(const f32x4 (&acc)[2][2][4][2], const Unit& u, int wr, int wc, int fr, int fq) const {
        const int col0 = u.pn * BM + wc * 32 + 4 * fq;
        f32x4 gv[2][2];
#pragma unroll
        for (int bj = 0; bj < 2; ++bj)
#pragma unroll
            for (int n = 0; n < 2; ++n) gv[bj][n] = *(const f32x4*)(g + col0 + bj * HALF + n * 16);
        const int rowb = u.pm * BM + wr * 64 + fr;
        f32x4 xb[3][2][2];
#pragma unroll
        for (int pf = 0; pf < 2; ++pf) { const size_t off = (size_t)(rowb + (pf >> 2) * HALF + (pf & 3) * 16) * ldc + col0;
#pragma unroll
            for (int bj = 0; bj < 2; ++bj)
#pragma unroll
                for (int n = 0; n < 2; ++n) xb[pf][bj][n] = __builtin_nontemporal_load((const f32x4*)(base + off + bj * HALF + n * 16)); }
#pragma unroll
        for (int it = 0; it < 8; ++it) { const int ai = it >> 2, m = it & 3; const int row = rowb + ai * HALF + m * 16; const size_t off = (size_t)row * ldc + col0; float sq = 0.f;
            if (it + 2 < 8) { const size_t offn = (size_t)(rowb + ((it + 2) >> 2) * HALF + ((it + 2) & 3) * 16) * ldc + col0;
#pragma unroll
                for (int bj = 0; bj < 2; ++bj)
#pragma unroll
                    for (int n = 0; n < 2; ++n) xb[(it + 2) % 3][bj][n] = __builtin_nontemporal_load((const f32x4*)(base + offn + bj * HALF + n * 16)); }
#pragma unroll
            for (int bj = 0; bj < 2; ++bj)
#pragma unroll
                for (int n = 0; n < 2; ++n) { const f32x4 hv = xb[it % 3][bj][n] + acc[ai][bj][m][n]; __builtin_nontemporal_store(hv, (f32x4*)(out + off + bj * HALF + n * 16));
                    sq += (hv[0] * hv[0] + hv[1] * hv[1]) + (hv[2] * hv[2] + hv[3] * hv[3]);
                    const f32x4 hg = hv * gv[bj][n]; u32x2 w; w.x = cvt_pk_bf16(hg[0], hg[1]); w.y = cvt_pk_bf16(hg[2], hg[3]); *(u32x2*)(hb + off + bj * HALF + n * 16) = w; }
            sq += __shfl_xor(sq, 16); sq += __shfl_xor(sq, 32);
            if (fq == 0) ssq[(size_t)row * 32 + u.pn * 4 + wc] = sq;
            asm volatile("" ::: "memory"); }
    }
};
struct EpiBf16RowNorm {
    static constexpr bool PERM = true, AFTER_DRAIN = false;
    bf16_t* O; int ldc; const float* ssq; float inv_n, eps;
    __device__ __forceinline__ void operator()(const f32x4 (&acc)[2][2][4][2], const Unit& u, int wr, int wc, int fr, int fq) const {
        const int row0 = u.pm * BM + wr * 64 + fr, col0 = u.pn * BM + wc * 32 + 8 * fq;
#pragma unroll
        for (int ai = 0; ai < 2; ++ai)
#pragma unroll
            for (int m = 0; m < 4; ++m) { const int row = row0 + ai * HALF + m * 16; const f32x4 s0 = *(const f32x4*)(ssq + (size_t)row * 32 + fq * 8), s1 = *(const f32x4*)(ssq + (size_t)row * 32 + fq * 8 + 4); float ss = ((s0[0] + s0[1]) + (s0[2] + s0[3])) + ((s1[0] + s1[1]) + (s1[2] + s1[3]));
                ss += __shfl_xor(ss, 16); ss += __shfl_xor(ss, 32); const float rs = 1.0f / sqrtf(ss * inv_n + eps); bf16_t* rowp = O + (size_t)row * ldc + col0;
#pragma unroll
                for (int bj = 0; bj < 2; ++bj) { const f32x4 v0 = acc[ai][bj][m][0] * rs, v1 = acc[ai][bj][m][1] * rs;
                    u32x4 w; w.x = cvt_pk_bf16(v0[0], v0[1]); w.y = cvt_pk_bf16(v0[2], v0[3]); w.z = cvt_pk_bf16(v1[0], v1[1]); w.w = cvt_pk_bf16(v1[2], v1[3]);
                    *(u32x4*)(rowp + bj * HALF) = w; } }
    }
};
template <class Epi, class Sched, bool ALIGN_EPI = false, bool SP2 = false>
__device__ __forceinline__ void gemm_phase(PG8_LAS unsigned char* lds, const Gemm g, const Sched& S, const Epi& E, int tid_in) {
    int tid_ = tid_in; asm volatile("" : "+v"(tid_));
    const int tid = tid_, wid = __builtin_amdgcn_readfirstlane(tid >> 6), lane = tid & 63, wr = wid >> 2, wc = wid & 3, fr = lane & 15, fq = lane >> 4;
    const int K = g.K, nt = K / BK;
    unsigned voffA[2], voffB[2];
#pragma unroll
    for (int i = 0; i < 2; ++i) { int R, C; stage_rc(tid * 16 + i * 8192, R, C); const int Rb = Epi::PERM ? ((R & ~31) + perm32(R & 31)) : R;
        voffA[i] = (unsigned)(R * K + C) * 2u; voffB[i] = (unsigned)(Rb * K + C) * 2u; }
    const size_t kstep = (size_t)(BK * 2);
    const size_t hstep = (size_t)HALF * K * 2;
    const size_t tstep = 2 * hstep;
    const unsigned ldsw = (unsigned)wid * 1024u;
    const int aoff = lds_byte(wr * 64 + fr, fq * 8), boff = lds_byte(wc * 32 + fr, fq * 8);
#define PG8_SA(b, h) (((b) * 2 + (h)) * HTB)
#define PG8_SB(b, h) ((4 + (b) * 2 + (h)) * HTB)
#define PG8_STAGE(bufoff, gbase, voff) do { _Pragma("unroll") for (int _i = 0; _i < 2; ++_i) \
        __builtin_amdgcn_global_load_lds((const unsigned*)((const char*)(gbase) + (voff)[_i]), (PG8_LAS unsigned*)(lds + (bufoff) + ldsw + _i * 8192), 16, 0, 0); } while (0)
#define PG8_LDA(dst, b, h) do { _Pragma("unroll") for (int m = 0; m < 4; ++m) _Pragma("unroll") for (int k = 0; k < 2; ++k) dst[m][k] = *(const PG8_LAS bf16x8*)(lds + PG8_SA(b, h) + aoff + m * 2048 + k * 1024); } while (0)
#define PG8_LDB(dst, b, h) do { _Pragma("unroll") for (int n = 0; n < 2; ++n) _Pragma("unroll") for (int k = 0; k < 2; ++k) dst[n][k] = *(const PG8_LAS bf16x8*)(lds + PG8_SB(b, h) + boff + n * 2048 + k * 1024); } while (0)
#define PG8_MMA(ai, bj, At, Bt) do { __builtin_amdgcn_s_setprio(1); _Pragma("unroll") for (int m = 0; m < 4; ++m) _Pragma("unroll") for (int n = 0; n < 2; ++n) _Pragma("unroll") for (int k = 0; k < 2; ++k) \
        acc[ai][bj][m][n] = __builtin_amdgcn_mfma_f32_16x16x32_bf16(Bt[n][k], At[m][k], acc[ai][bj][m][n], 0, 0, 0); __builtin_amdgcn_s_setprio(0); } while (0)
#define PG8_WAIT_V(n) asm volatile("s_waitcnt vmcnt(" #n ")" ::: "memory")
#define PG8_WAIT_L(n) asm volatile("s_waitcnt lgkmcnt(" #n ")" ::: "memory")
#define PG8_BAR __builtin_amdgcn_s_barrier()
#define PG8_SCHED __builtin_amdgcn_sched_barrier(0)
    Unit cur, nxt; int ui = 0;
    if (!S.next(0, cur)) return;
    f32x4 acc[2][2][4][2];
#pragma unroll
    for (int a = 0; a < 2; ++a)
#pragma unroll
        for (int b = 0; b < 2; ++b)
#pragma unroll
            for (int m = 0; m < 4; ++m)
#pragma unroll
                for (int n = 0; n < 2; ++n) acc[a][b][m][n] = (f32x4){0.f, 0.f, 0.f, 0.f};
    bf16x8 At[4][2], B0[2][2], B1[2][2];
    const char* cA = (const char*)g.A + (size_t)cur.pm * tstep + (size_t)(cur.pn / g.adiv) * g.astride; const char* cB = (const char*)g.Bt + (size_t)cur.pn * tstep;
    S.a_ready(cur);
    if constexpr (SP2) {
        PG8_STAGE(PG8_SB(0, 0), cB, voffB); PG8_STAGE(PG8_SB(0, 1), cB + hstep, voffB); PG8_STAGE(PG8_SA(0, 0), cA, voffA); PG8_STAGE(PG8_SA(0, 1), cA + hstep, voffA);
        if (wr == 1) PG8_BAR;
        PG8_WAIT_V(2); PG8_BAR;
        PG8_STAGE(PG8_SB(1, 0), cB + kstep, voffB); PG8_STAGE(PG8_SA(1, 0), cA + kstep, voffA); PG8_STAGE(PG8_SB(1, 1), cB + hstep + kstep, voffB);
        PG8_WAIT_V(6); PG8_BAR;
    } else {
        PG8_STAGE(PG8_SB(0, 0), cB, voffB); PG8_STAGE(PG8_SA(0, 0), cA, voffA); PG8_STAGE(PG8_SB(0, 1), cB + hstep, voffB); PG8_STAGE(PG8_SA(0, 1), cA + hstep, voffA);
        if (wr == 1) PG8_BAR;
        PG8_WAIT_V(4); PG8_BAR;
        PG8_STAGE(PG8_SB(1, 0), cB + kstep, voffB); PG8_STAGE(PG8_SA(1, 0), cA + kstep, voffA); PG8_STAGE(PG8_SB(1, 1), cB + hstep + kstep, voffB);
        PG8_WAIT_V(6); PG8_BAR;
    }
    for (;;) {
        const bool has_next = S.next(ui + 1, nxt);
        const char* nA = has_next ? (const char*)g.A + (size_t)nxt.pm * tstep + (size_t)(nxt.pn / g.adiv) * g.astride : cA; const char* nB = has_next ? (const char*)g.Bt + (size_t)nxt.pn * tstep : cB;
        for (int t = 0; t < nt; t += 2) {
            const bool last = (t == nt - 2);
            const char* a1 = cA + (size_t)(t + 1) * kstep;
            const char* a2 = last ? nA : cA + (size_t)(t + 2) * kstep; const char* b2 = last ? nB : cB + (size_t)(t + 2) * kstep;
            const char* a3 = a2 + kstep; const char* b3 = b2 + kstep;
            if (last && has_next) S.a_ready(nxt);
            if constexpr (SP2) {
            PG8_LDB(B0, 0, 0); PG8_LDB(B1, 0, 1); PG8_SCHED; PG8_LDA(At, 0, 0); PG8_STAGE(PG8_SA(1, 1), a1 + hstep, voffA);
            PG8_WAIT_V(8); PG8_WAIT_L(0); PG8_BAR; PG8_MMA(0, 0, At, B0); PG8_MMA(0, 1, At, B1); PG8_BAR; PG8_SCHED;
            PG8_LDA(At, 0, 1); PG8_STAGE(PG8_SB(0, 0), b2, voffB); PG8_STAGE(PG8_SB(0, 1), b2 + hstep, voffB); PG8_STAGE(PG8_SA(0, 0), a2, voffA);
            PG8_WAIT_V(8); PG8_WAIT_L(0); PG8_BAR; PG8_MMA(1, 0, At, B0); PG8_MMA(1, 1, At, B1); PG8_BAR; PG8_SCHED;
            PG8_LDB(B0, 1, 0); PG8_LDB(B1, 1, 1); PG8_SCHED; PG8_LDA(At, 1, 0); PG8_STAGE(PG8_SA(0, 1), a2 + hstep, voffA);
            PG8_WAIT_V(8); PG8_WAIT_L(0); PG8_BAR; PG8_MMA(0, 0, At, B0); PG8_MMA(0, 1, At, B1); PG8_BAR; PG8_SCHED;
            PG8_LDA(At, 1, 1); PG8_STAGE(PG8_SB(1, 0), b3, voffB); PG8_STAGE(PG8_SB(1, 1), b3 + hstep, voffB); PG8_STAGE(PG8_SA(1, 0), a3, voffA);
            PG8_WAIT_V(8); PG8_WAIT_L(0); PG8_BAR; PG8_MMA(1, 0, At, B0); PG8_MMA(1, 1, At, B1); PG8_BAR; PG8_SCHED;
            } else {
            PG8_LDB(B0, 0, 0); PG8_SCHED; PG8_LDA(At, 0, 0); PG8_STAGE(PG8_SA(1, 1), a1 + hstep, voffA);
            PG8_WAIT_L(8); PG8_BAR; PG8_WAIT_L(0); PG8_MMA(0, 0, At, B0); PG8_BAR; PG8_SCHED;
            PG8_LDB(B1, 0, 1); PG8_STAGE(PG8_SB(0, 0), b2, voffB);
            PG8_BAR; PG8_WAIT_L(0); PG8_MMA(0, 1, At, B1); PG8_BAR;
            PG8_LDA(At, 0, 1); PG8_STAGE(PG8_SA(0, 0), a2, voffA);
            PG8_BAR; PG8_WAIT_L(0); PG8_MMA(1, 0, At, B0); PG8_BAR; PG8_SCHED;
            PG8_STAGE(PG8_SB(0, 1), b2 + hstep, voffB);
            PG8_WAIT_V(6); PG8_BAR; PG8_MMA(1, 1, At, B1); PG8_BAR;
            PG8_LDB(B0, 1, 0); PG8_SCHED; PG8_LDA(At, 1, 0); PG8_STAGE(PG8_SA(0, 1), a2 + hstep, voffA);
            PG8_WAIT_L(8); PG8_BAR; PG8_WAIT_L(0); PG8_MMA(0, 0, At, B0); PG8_BAR; PG8_SCHED;
            PG8_LDB(B1, 1, 1); PG8_STAGE(PG8_SB(1, 0), b3, voffB);
            PG8_BAR; PG8_WAIT_L(0); PG8_MMA(0, 1, At, B1); PG8_BAR;
            PG8_LDA(At, 1, 1); PG8_STAGE(PG8_SA(1, 0), a3, voffA);
            PG8_BAR; PG8_WAIT_L(0); PG8_MMA(1, 0, At, B0); PG8_BAR; PG8_SCHED;
            PG8_STAGE(PG8_SB(1, 1), b3 + hstep, voffB);
            PG8_WAIT_V(6); PG8_BAR; PG8_MMA(1, 1, At, B1); PG8_BAR;
            }
        }
        if constexpr (ALIGN_EPI) { if (wr == 0) PG8_BAR; }
        if constexpr (!Epi::AFTER_DRAIN) { E(acc, cur, wr, wc, fr, fq); S.done(cur); }
        if (!has_next) break;
#pragma unroll
        for (int a = 0; a < 2; ++a)
#pragma unroll
            for (int b = 0; b < 2; ++b)
#pragma unroll
                for (int m = 0; m < 4; ++m)
#pragma unroll
                    for (int n = 0; n < 2; ++n) acc[a][b][m][n] = (f32x4){0.f, 0.f, 0.f, 0.f};
        cur = nxt; cA = nA; cB = nB; ++ui;
        if constexpr (ALIGN_EPI) { if (wr == 1) PG8_BAR; }
    }
    PG8_WAIT_V(0);
    if constexpr (!ALIGN_EPI) { if (wr == 0) PG8_BAR; }
    PG8_BAR;
    if constexpr (Epi::AFTER_DRAIN) { E.fused(acc, cur, wr, wc, fr, fq, lds, wid, lane); S.done(cur); }
#undef PG8_SA
#undef PG8_SB
#undef PG8_STAGE
#undef PG8_LDA
#undef PG8_LDB
#undef PG8_MMA
#undef PG8_WAIT_V
#undef PG8_WAIT_L
#undef PG8_BAR
#undef PG8_SCHED
}
}

#ifndef PG8_SP2
#define PG8_SP2 true
#endif
#ifndef PG8_ALIGN
#define PG8_ALIGN true
#endif
#include <hip/hip_bf16.h>
#include <cmath>
namespace attn_body {
using bf16=__hip_bfloat16;
using bf16x8=__attribute__((ext_vector_type(8)))short;
using s16x4=__attribute__((ext_vector_type(4)))short;
using f32x16=__attribute__((ext_vector_type(16)))float;
using u32x4=__attribute__((ext_vector_type(4)))unsigned;
constexpr int BATCH=2,NHEAD=16,SEQ=8192,D=64,DM=6656,DMO=2048;
constexpr int NW=8,QBLK=32,QB=QBLK*NW,KVBLK=64,NQB=SEQ/QB;
constexpr int ATTN_UNIT_ROWS=QB;
__device__ __forceinline__ int crow(int r,int hi){return (r&3)+8*(r>>2)+4*hi;}
#define SBAR() __builtin_amdgcn_sched_barrier(0)
__device__ __forceinline__ void cmask(f32x16&p0,f32x16&p1,int jb,int qrel,int hi){
  const float NEG=-INFINITY; int kb=64*jb+4*hi;
  #pragma unroll
  for(int r=0;r<16;++r){int kv=kb+(r&3)+8*(r>>2); if(kv>qrel)p0[r]=NEG; if(kv+32>qrel)p1[r]=NEG;}
}

constexpr int NSLOT=3, SLOTB=8192;
constexpr int LDS_K=0, LDS_V=NSLOT*SLOTB, LDS_WS=2*NSLOT*SLOTB, LDS_OST=LDS_WS+NW*64*4, LDS_CK=LDS_OST+NW*4096, LDS_BYTES=LDS_CK+SEQ*4;
constexpr int ATTN_QG_ARG=15;
constexpr float C2=0.125f*1.4426950408889634f;
__device__ __forceinline__ void glds16(const void*gsrc,unsigned lds_dst){unsigned keep;
  asm volatile("s_mov_b32 %0, m0\n\ts_mov_b32 m0, %2\n\ts_nop 0\n\tglobal_load_lds_dwordx4 %1, off\n\ts_mov_b32 m0, %0":"=&s"(keep):"v"(gsrc),"s"(lds_dst):"memory");}
__device__ __forceinline__ void glds16s(const void*sbase,unsigned voff,unsigned lds_dst){unsigned keep;
  asm volatile("s_mov_b32 %0, m0\n\ts_mov_b32 m0, %3\n\ts_nop 0\n\tglobal_load_lds_dwordx4 %1, %2\n\ts_mov_b32 m0, %0":"=&s"(keep):"v"(voff),"s"(sbase),"s"(lds_dst):"memory");}
__device__ __forceinline__ float max3f(float a,float b,float c){float r;asm("v_max3_f32 %0, %1, %2, %3":"=v"(r):"v"(a),"v"(b),"v"(c));return r;}
__device__ __forceinline__ float max2f(float a,float b){float r;asm("v_max_f32_e32 %0, %1, %2":"=v"(r):"v"(a),"v"(b));return r;}
__device__ __forceinline__ float fadd_s(float a,float b){float r;asm("v_add_f32_e32 %0, %1, %2":"=v"(r):"v"(a),"v"(b));return r;}
__device__ __forceinline__ float fsub_s(float a,float b){float r;asm("v_sub_f32_e32 %0, %1, %2":"=v"(r):"v"(a),"v"(b));return r;}
typedef float f32x2_t __attribute__((ext_vector_type(2))); typedef __bf16 bf16x2_t __attribute__((ext_vector_type(2)));
__device__ __forceinline__ unsigned cvtpk_s(float lo,float hi){f32x2_t v={lo,hi};bf16x2_t b=__builtin_convertvector(v,bf16x2_t);return __builtin_bit_cast(unsigned,b);}
#define WAIT_BAR(N) asm volatile("s_waitcnt vmcnt(" #N ") lgkmcnt(0)\n\ts_barrier":::"memory")

__device__ __forceinline__ void qkt(f32x16&p0,f32x16&p1,const char*Kslot,const bf16x8*qr,int r32,int hi){
  const char*kb=Kslot+hi*1024+r32*16;
  #pragma unroll
  for(int d0=0;d0<4;++d0){
    const bf16x8 b0=*reinterpret_cast<const bf16x8*>(kb+d0*2048);
    const bf16x8 b1=*reinterpret_cast<const bf16x8*>(kb+d0*2048+512);
    p0=__builtin_amdgcn_mfma_f32_32x32x16_bf16(b0,qr[d0],p0,0,0,0);p1=__builtin_amdgcn_mfma_f32_32x32x16_bf16(b1,qr[d0],p1,0,0,0);}
}
typedef __attribute__((address_space(3))) const char* lds_cptr;
typedef short v4i16_t __attribute__((ext_vector_type(4)));
__device__ __forceinline__ void kload8(bf16x8*kf,lds_cptr kp){
  kf[0]=*(const __attribute__((address_space(3))) bf16x8*)(kp);      kf[1]=*(const __attribute__((address_space(3))) bf16x8*)(kp+512);
  kf[2]=*(const __attribute__((address_space(3))) bf16x8*)(kp+2048); kf[3]=*(const __attribute__((address_space(3))) bf16x8*)(kp+2560);
  kf[4]=*(const __attribute__((address_space(3))) bf16x8*)(kp+4096); kf[5]=*(const __attribute__((address_space(3))) bf16x8*)(kp+4608);
  kf[6]=*(const __attribute__((address_space(3))) bf16x8*)(kp+6144); kf[7]=*(const __attribute__((address_space(3))) bf16x8*)(kp+6656);
}
__device__ __forceinline__ void kload2(bf16x8*kf,lds_cptr kp,int j){ kf[2*j]=*(const __attribute__((address_space(3))) bf16x8*)(kp+j*2048); kf[2*j+1]=*(const __attribute__((address_space(3))) bf16x8*)(kp+j*2048+512); }
__device__ __forceinline__ s16x4 vtr(lds_cptr p){ return __builtin_bit_cast(s16x4,__builtin_amdgcn_ds_read_tr16_b64_v4i16((__attribute__((address_space(3))) v4i16_t*)p)); }
typedef float f32x4c __attribute__((ext_vector_type(4)));
__device__ __forceinline__ void ldck(f32x16&c0,f32x16&c1,lds_cptr ckt){
  #pragma unroll
  for(int g=0;g<4;++g){ const f32x4c a=*(const __attribute__((address_space(3))) f32x4c*)(ckt+32*g); const f32x4c b=*(const __attribute__((address_space(3))) f32x4c*)(ckt+128+32*g);
    c0[4*g]=a[0];c0[4*g+1]=a[1];c0[4*g+2]=a[2];c0[4*g+3]=a[3]; c1[4*g]=b[0];c1[4*g+1]=b[1];c1[4*g+2]=b[2];c1[4*g+3]=b[3]; }
}
__device__ __forceinline__ float rowmax(const f32x16&p0,const f32x16&p1){
  float a=max3f(p0[0],p0[1],p1[0]),b=max3f(p0[2],p0[3],p1[1]);a=max3f(a,p1[2],p1[3]);
  #pragma unroll
  for(int r=4;r<16;r+=4){a=max3f(a,p0[r],p0[r+1]);b=max3f(b,p0[r+2],p0[r+3]);a=max3f(a,p1[r],p1[r+1]);b=max3f(b,p1[r+2],p1[r+3]);}
  const float m=max2f(a,b);
  auto rr=__builtin_amdgcn_permlane32_swap(__float_as_uint(m),__float_as_uint(m),false,false);
  return max2f(__uint_as_float(rr[0]),__uint_as_float(rr[1]));
}
__device__ __forceinline__ void pv(f32x16*o,int vb,bf16x8 pa0,bf16x8 pa1,bf16x8 pa2,bf16x8 pa3){
  #pragma unroll
  for(int d0=0;d0<2;++d0){s16x4 lo[4],hi[4];
    #pragma unroll
    for(int ks=0;ks<4;++ks){
      asm volatile("ds_read_b64_tr_b16 %0,%1 offset:%c2":"=&v"(lo[ks]):"v"(vb),"i"(d0*4096+ks*1024):"memory");
      asm volatile("ds_read_b64_tr_b16 %0,%1 offset:%c2":"=&v"(hi[ks]):"v"(vb),"i"(d0*4096+ks*1024+512):"memory");}
    asm volatile("s_waitcnt lgkmcnt(0)":::"memory");SBAR();
    #define PK(k) (bf16x8){lo[k][0],lo[k][1],lo[k][2],lo[k][3],hi[k][0],hi[k][1],hi[k][2],hi[k][3]}
    o[d0]=__builtin_amdgcn_mfma_f32_32x32x16_bf16(pa0,PK(0),o[d0],0,0,0);
    o[d0]=__builtin_amdgcn_mfma_f32_32x32x16_bf16(pa1,PK(1),o[d0],0,0,0);
    o[d0]=__builtin_amdgcn_mfma_f32_32x32x16_bf16(pa2,PK(2),o[d0],0,0,0);
    o[d0]=__builtin_amdgcn_mfma_f32_32x32x16_bf16(pa3,PK(3),o[d0],0,0,0);
    #undef PK
  }
}

#ifndef ATTN_STORE16
#define ATTN_STORE16(p,v) (*(u32x4*)(p)=(v))
#endif
template<int THRL> __device__ __forceinline__ void attn_unit(int b,int h,int qb,const bf16*Q,const bf16*K,const bf16*V,bf16*O,const float*C2G,char*shm,int tid_in){
  int tid_=tid_in; asm volatile("":"+v"(tid_)); const int tid=tid_,lane=tid&63,r32=lane&31,hi=lane>>5; const int wid=__builtin_amdgcn_readfirstlane(tid>>6);
  const long rowbase=(long)b*SEQ; const int q0=qb*QB;
  const bf16*Qw=Q+(rowbase+q0+wid*QBLK)*DM+h*D;
  const bf16*Kh0=K+rowbase*DM+h*D,*Vh0=V+rowbase*DM+h*D;
  const unsigned lds0=(unsigned)(uintptr_t)shm;
  float*wsf=(float*)(shm+LDS_WS)+wid*64;
  const unsigned koff=(unsigned)(lane*DM+wid*8)*2u;
  const unsigned voff=(unsigned)((16*(wid&3)+(lane>>2))*DM+(wid>>2)*32+(lane&3)*8)*2u;
  const unsigned kdst=lds0+LDS_K+wid*1024, vdst=lds0+LDS_V+wid*1024;
  #define DMA_K(t,slot) glds16s(Kh+(long)(t)*KVBLK*DM,koff,(unsigned)__builtin_amdgcn_readfirstlane(kdst+(slot)))
  #define DMA_V(t,slot) glds16s(Vh+(long)(t)*KVBLK*DM,voff,(unsigned)__builtin_amdgcn_readfirstlane(vdst+(slot)))
  const int vb0=(int)(lds0+LDS_V)+((lane>>4)&1)*32+(lane&3)*8+(4*hi+((lane&15)>>2))*64;
  const char*Kbase=shm+LDS_K; bf16x8 kf[8];
  const lds_cptr shm3=(lds_cptr)shm; const lds_cptr kp0=shm3+LDS_K+hi*1024+r32*16; const lds_cptr vp0=shm3+LDS_V+((lane>>4)&1)*32+(lane&3)*8+(4*hi+((lane&15)>>2))*64;
  const int NT0=(q0+QB)/KVBLK;
  { const float*csrc=C2G+(long)(b*NHEAD+h)*SEQ; const int n4=(q0+QB)/4;
    for(int i4=tid;i4<n4;i4+=NW*64){ const f32x4c v=*(const f32x4c*)(csrc+4*i4); *(__attribute__((address_space(3))) f32x4c*)(shm3+LDS_CK+16*i4)=v; } }
  asm volatile("s_waitcnt vmcnt(0) lgkmcnt(0)\n\ts_barrier":::"memory");
  const float cq2=*(const __attribute__((address_space(3))) float*)(shm3+LDS_CK+4*(q0+wid*QBLK+r32));
  int t0;
  { const float thr=*(const __attribute__((address_space(3))) float*)(shm3+LDS_CK+4*q0)+164.0f; int lo=0,hi_=NT0-4;
    while(lo<hi_){ const int mid=(lo+hi_)>>1; if(*(const __attribute__((address_space(3))) float*)(shm3+LDS_CK+4*(64*mid+63))>thr)lo=mid+1; else hi_=mid; }
    t0=__builtin_amdgcn_readfirstlane(lo&~1); }
  const int NT=NT0-t0;
  const bf16*Kh=Kh0+(long)t0*KVBLK*DM,*Vh=Vh0+(long)t0*KVBLK*DM;
  const lds_cptr ckp0=shm3+LDS_CK+16*hi+256*t0;
  DMA_K(0,0);DMA_V(0,0);DMA_K(1,SLOTB);
  bf16x8 qr[4];
  #pragma unroll
  for(int d0=0;d0<4;++d0)qr[d0]=*reinterpret_cast<const bf16x8*>(&Qw[(long)r32*DM+d0*16+hi*8]);
  {
    typedef unsigned u32x4q __attribute__((ext_vector_type(4)));
    typedef __attribute__((address_space(4))) const unsigned long long kargq; kargq* ka_=(kargq*)__builtin_amdgcn_kernarg_segment_ptr(); asm volatile("":"+s"(ka_));
    const __attribute__((address_space(1))) float* QG=(const __attribute__((address_space(1))) float*)ka_[ATTN_QG_ARG];
    float ss=0.f;
    #pragma unroll
    for(int d0=0;d0<4;++d0){ const u32x4q u=__builtin_bit_cast(u32x4q,qr[d0]);
      #pragma unroll
      for(int c=0;c<4;++c){ const float lo=__uint_as_float(u[c]<<16),hi_=__uint_as_float(u[c]&0xffff0000u); ss+=lo*lo+hi_*hi_; } }
    ss+=__shfl_xor(ss,32);
    const float rs=(1.0f/sqrtf(ss*(1.f/64.f)+1e-6f))*C2;
    #pragma unroll
    for(int d0=0;d0<4;++d0){ u32x4q u=__builtin_bit_cast(u32x4q,qr[d0]);
      #pragma unroll
      for(int hf=0;hf<2;++hf){ const f32x4c g=*(const __attribute__((address_space(1))) f32x4c*)(QG+d0*16+hi*8+4*hf);
        #pragma unroll
        for(int c=0;c<2;++c){ const unsigned x=u[2*hf+c]; u[2*hf+c]=cvtpk_s(__uint_as_float(x<<16)*rs*g[2*c],__uint_as_float(x&0xffff0000u)*rs*g[2*c+1]); } }
      qr[d0]=__builtin_bit_cast(bf16x8,u); }
    __builtin_amdgcn_sched_barrier(0); }
  float l_reg=0.f;f32x16 o[2];o[0]=f32x16{};o[1]=f32x16{};
  const int qrel=wid*QBLK+r32;
  #define CMASK(P0,P1,t) do{int jb_=(t)-(NT-4); if(jb_>=0)cmask(P0,P1,jb_,qrel,hi);}while(0)
  #define CINIT(X) do{ _Pragma("unroll") for(int r=0;r<16;++r)X[r]=cq2-X[r]; }while(0)
  f32x16 pA0,pA1,pB0,pB1;
  int sl_prev=0,sl_cur=0,sl_next=SLOTB;
  #define ROT() do{sl_prev=sl_cur;sl_cur=sl_next;sl_next=(sl_next==(NSLOT-1)*SLOTB)?0:sl_next+SLOTB;}while(0)
  DMA_K(2,2*SLOTB);
  WAIT_BAR(3);
  ldck(pA0,pA1,ckp0); CINIT(pA0); CINIT(pA1);
  qkt(pA0,pA1,Kbase,qr,r32,hi);asm volatile("s_nop 15\n\ts_nop 7":"+v"(pA0),"+v"(pA1));CMASK(pA0,pA1,0);
  _Pragma("unroll") for(int r=0;r<16;++r){pA0[r]=__builtin_amdgcn_exp2f(pA0[r]);pA1[r]=__builtin_amdgcn_exp2f(pA1[r]);}
  ldck(pB0,pB1,ckp0+256);
  WAIT_BAR(0);
  DMA_K(3,0);DMA_V(1,SLOTB);
  ROT();
  kload8(kf,kp0+sl_cur);
  WAIT_BAR(2);
  s16x4 vlo[8],vhi[8]; u32x4 pw0,pw1,pw2,pw3;
  #define PKW(P,B) cvtpk_s(P[B],P[B+1])
  #define PAF(k) __builtin_bit_cast(bf16x8,pw##k)
  #define VFR(i) (bf16x8){vlo[i][0],vlo[i][1],vlo[i][2],vlo[i][3],vhi[i][0],vhi[i][1],vhi[i][2],vhi[i][3]}
  #define PIN(x) asm volatile("":"+v"(x))
  #define MX3(a,b,c) __builtin_fmaxf(__builtin_fmaxf((a),(b)),(c))
  #define GAPA(MF,A0,A1,A2,A3,W0,W1,PW) do{ MF; sacc+=A0; sacc+=A1; sacc+=A2; sacc+=A3; PIN(sacc); W0; W1; PIN(PW); SBAR(); }while(0)
  #define EX(v) __builtin_amdgcn_exp2f(v)
  #define GAPB(MF,X,B) do{ MF; X[B]=EX(X[B]); X[B+1]=EX(X[B+1]); X[B+2]=EX(X[B+2]); X[B+3]=EX(X[B+3]); PIN(X); SBAR(); }while(0)
  #define VRD(i) do{ vlo[i]=vtr(vp_+(((i)>>2)*4096+((i)&3)*1024)); vhi[i]=vtr(vp_+(((i)>>2)*4096+((i)&3)*1024+512)); }while(0)
  #define KRD(G,j) do{ if(G){ kload2(kf,kp0+sl_next,j); SBAR(); } }while(0)
  #define STEP(C0,C1,P0,P1,t,GK,GV,GL,GC) do{ SBAR(); \
    const lds_cptr vp_=vp0+sl_prev; \
    CINIT(C0); CINIT(C1); SBAR(); \
    VRD(0); SBAR(); float sacc=(P0[0]+P0[1]); \
    GAPA(C0=__builtin_amdgcn_mfma_f32_32x32x16_bf16(kf[0],qr[0],C0,0,0,0), P0[2],P0[3],P0[4],P0[5],     pw0[0]=PKW(P0,0), pw0[1]=PKW(P0,2), pw0); \
    VRD(4); SBAR(); GAPA(C1=__builtin_amdgcn_mfma_f32_32x32x16_bf16(kf[1],qr[0],C1,0,0,0), P0[6],P0[7],P0[8],P0[9],     pw0[2]=PKW(P0,4), pw0[3]=PKW(P0,6), pw0); \
    VRD(1); SBAR(); GAPA(C0=__builtin_amdgcn_mfma_f32_32x32x16_bf16(kf[2],qr[1],C0,0,0,0),   P0[10],P0[11],P0[12],P0[13], pw1[0]=PKW(P0,8), pw1[1]=PKW(P0,10), pw1); \
    VRD(5); SBAR(); GAPA(C1=__builtin_amdgcn_mfma_f32_32x32x16_bf16(kf[3],qr[1],C1,0,0,0),   P0[14],P0[15],P1[0],P1[1],   pw1[2]=PKW(P0,12),pw1[3]=PKW(P0,14), pw1); \
    VRD(2); SBAR(); GAPA(C0=__builtin_amdgcn_mfma_f32_32x32x16_bf16(kf[4],qr[2],C0,0,0,0),   P1[2],P1[3],P1[4],P1[5],     pw2[0]=PKW(P1,0), pw2[1]=PKW(P1,2), pw2); \
    VRD(6); SBAR(); GAPA(C1=__builtin_amdgcn_mfma_f32_32x32x16_bf16(kf[5],qr[2],C1,0,0,0),   P1[6],P1[7],P1[8],P1[9],     pw2[2]=PKW(P1,4), pw2[3]=PKW(P1,6), pw2); \
    VRD(3); SBAR(); GAPA(C0=__builtin_amdgcn_mfma_f32_32x32x16_bf16(kf[6],qr[3],C0,0,0,0),   P1[10],P1[11],P1[12],P1[13], pw3[0]=PKW(P1,8), pw3[1]=PKW(P1,10), pw3); \
    VRD(7); SBAR(); GAPA(C1=__builtin_amdgcn_mfma_f32_32x32x16_bf16(kf[7],qr[3],C1,0,0,0),   P1[14],P1[15],0.f,0.f,       pw3[2]=PKW(P1,12),pw3[3]=PKW(P1,14), pw3); \
    l_reg+=sacc; \
    if(GK){DMA_K((t)+3,sl_cur);} if(GV){DMA_V((t)+1,sl_next);} \
    CMASK(C0,C1,t); \
    SBAR(); \
    GAPB(o[0]=__builtin_amdgcn_mfma_f32_32x32x16_bf16(PAF(0),VFR(0),o[0],0,0,0), C0,0); \
    GAPB(o[1]=__builtin_amdgcn_mfma_f32_32x32x16_bf16(PAF(0),VFR(4),o[1],0,0,0), C0,4); \
    KRD(GL,0); GAPB(o[0]=__builtin_amdgcn_mfma_f32_32x32x16_bf16(PAF(1),VFR(1),o[0],0,0,0), C0,8); \
    KRD(GL,1); GAPB(o[1]=__builtin_amdgcn_mfma_f32_32x32x16_bf16(PAF(1),VFR(5),o[1],0,0,0), C0,12); \
    KRD(GL,2); GAPB(o[0]=__builtin_amdgcn_mfma_f32_32x32x16_bf16(PAF(2),VFR(2),o[0],0,0,0), C1,0); \
    KRD(GL,3); GAPB(o[1]=__builtin_amdgcn_mfma_f32_32x32x16_bf16(PAF(2),VFR(6),o[1],0,0,0), C1,4); \
    GAPB(o[0]=__builtin_amdgcn_mfma_f32_32x32x16_bf16(PAF(3),VFR(3),o[0],0,0,0), C1,8); \
    GAPB(o[1]=__builtin_amdgcn_mfma_f32_32x32x16_bf16(PAF(3),VFR(7),o[1],0,0,0), C1,12); \
    if(GC){ ldck(P0,P1,ckp0+((t)+1)*256); } \
    }while(0)
  int t=1;
  #undef CMASK
  #define CMASK(P0,P1,t) do{}while(0)
  for(;t+5<NT;t+=2){
    STEP(pB0,pB1,pA0,pA1,t,true,true,true,true);     WAIT_BAR(2); ROT();
    STEP(pA0,pA1,pB0,pB1,t+1,true,true,true,true);   WAIT_BAR(2); ROT();
  }
  #undef CMASK
  #define CMASK(P0,P1,t) do{int jb_=(t)-(NT-4); if(jb_>=0)cmask(P0,P1,jb_,qrel,hi);}while(0)
  #define ENDW(tt) do{ if((tt)+3<NT){WAIT_BAR(2);} else if((tt)+2<NT){WAIT_BAR(1);} else {WAIT_BAR(0);} }while(0)
  for(;t+1<NT;t+=2){
    STEP(pB0,pB1,pA0,pA1,t,(t+3<NT),(t+1<NT),(t+1<NT),(t+1<NT));       ENDW(t);   ROT();
    STEP(pA0,pA1,pB0,pB1,t+1,(t+4<NT),(t+2<NT),(t+2<NT),(t+2<NT));     ENDW(t+1); ROT();
  }
  STEP(pB0,pB1,pA0,pA1,NT-1,false,false,false,false);
  { float sacc=pB0[0]+pB0[1]; _Pragma("unroll") for(int r=2;r<16;++r)sacc+=pB0[r]; _Pragma("unroll") for(int r=0;r<16;++r)sacc+=pB1[r]; l_reg+=sacc;
    pw0=(u32x4){PKW(pB0,0),PKW(pB0,2),PKW(pB0,4),PKW(pB0,6)};pw1=(u32x4){PKW(pB0,8),PKW(pB0,10),PKW(pB0,12),PKW(pB0,14)};pw2=(u32x4){PKW(pB1,0),PKW(pB1,2),PKW(pB1,4),PKW(pB1,6)};pw3=(u32x4){PKW(pB1,8),PKW(pB1,10),PKW(pB1,12),PKW(pB1,14)};
    SBAR(); pv(o,vb0+sl_cur,PAF(0),PAF(1),PAF(2),PAF(3)); }
  #undef PKW
  #undef PAF
  #undef VFR
  #undef PIN
  #undef MX3
  #undef GAPA
  #undef GAPB
  #undef EX
  #undef VRD
  #undef KRD
  #undef STEP
  #undef ENDW
  {auto rr=__builtin_amdgcn_permlane32_swap(__float_as_uint(l_reg),__float_as_uint(l_reg),false,false);l_reg=__uint_as_float(rr[0])+__uint_as_float(rr[1]);}
  if(hi==0)wsf[32+r32]=l_reg;asm volatile("s_waitcnt lgkmcnt(0)":::"memory");
  float rli[16];
  #pragma unroll
  for(int r=0;r<16;++r)rli[r]=__builtin_amdgcn_rcpf(wsf[32+crow(r,hi)]);
  bf16*Ow=O+(rowbase+q0+wid*QBLK)*DMO+h*D;
  { bf16*stg=(bf16*)(shm+LDS_OST)+wid*2048;
    #pragma unroll
    for(int r=0;r<16;++r){const int orow=crow(r,hi);
      #pragma unroll
      for(int d0=0;d0<2;++d0)stg[orow*64+d0*32+r32]=__float2bfloat16(o[d0][r]*rli[r]);}
    asm volatile("s_waitcnt lgkmcnt(0)":::"memory");
    #pragma unroll
    for(int i=0;i<4;++i){const int row=i*8+(lane>>3),ch=lane&7; const u32x4 v=*(const u32x4*)(stg+row*64+ch*8); ATTN_STORE16(Ow+(long)row*DMO+ch*8,v);} }
  asm volatile("s_waitcnt lgkmcnt(0)\n\ts_barrier":::"memory");
  #undef DMA_K
  #undef DMA_V
  #undef CMASK
  #undef CINIT
  #undef ROT
}
constexpr int ATTN_LDS_BYTES=LDS_BYTES;
struct AttnTensors { const bf16* Q; const bf16* K; const bf16* V; bf16* O; const float* C2G; };
struct AttnUnit { int bh; int qb; };
struct StaticOrder {
  int vcu;
  __device__ __forceinline__ explicit StaticOrder(int grid,int block):vcu((block%8)*(grid/8)+block/8){}
  __device__ __forceinline__ bool next(int i,AttnUnit&u)const{ if(i>=4)return false; const int s=vcu&7; u.bh=vcu>>3; u.qb=(i==0)?s:(i==1)?15-s:(i==2)?16+s:31-s; return true; }
  __device__ __forceinline__ void a_ready(const AttnUnit&)const{}
  __device__ __forceinline__ void done(const AttnUnit&)const{}
};
template<class Sched,int THRL=8> __device__ __forceinline__ void attn_phase(char*lds,const AttnTensors&T,const Sched&S,int tid_in){
  AttnUnit u;
  for(int i=0;S.next(i,u);++i){ S.a_ready(u); attn_unit<THRL>(u.bh/NHEAD,u.bh%NHEAD,u.qb,T.Q,T.K,T.V,T.O,T.C2G,lds,tid_in); S.done(u); }
}
#undef SBAR
#undef WAIT_BAR
}
constexpr int NWAVES = 8;
constexpr int SEQ = 8192, NB = 2, M = NB * SEQ, DMODEL = 2048;
constexpr int PJ = 6656;
constexpr int NIN = 6416;
constexpr int C_R = 0, C_K = 1024, C_V = 2048, C_WD = 3072, C_AD = 3136, C_GD = 3200;
constexpr int C_FQ = 3328, C_FK = 4352, C_FV = 5376, C_FF = 6400;
constexpr int NEXP = 16384;
constexpr float C2Q = 0.125f * 1.4426950408889634f;
constexpr float LOG2E = 1.4426950408889634f;

constexpr size_t MiB = 1u << 20;
constexpr size_t WS_CTL = 0, CTL_ZERO_BYTES = 1 * MiB;
constexpr size_t WS_SSQ = 42 * MiB;
constexpr size_t WS_WQT = 1 * MiB;
constexpr size_t WS_LWT = 5 * MiB;
constexpr size_t WS_C2 = 6 * MiB;
constexpr size_t WS_BON = 7 * MiB;
constexpr size_t WS_WOT = 8 * MiB;
constexpr size_t WS_WINT = 16 * MiB;
constexpr size_t WS_LA = 42 * MiB;
constexpr size_t WS_XN = 64 * MiB;
constexpr size_t WS_PROJ = 128 * MiB;
constexpr size_t WS_MIXED = 336 * MiB;
constexpr size_t WS_KP = 400 * MiB, WS_AV = 432 * MiB, WS_BV = 464 * MiB;
constexpr size_t WS_END = 497 * MiB;
constexpr size_t WS_GATE = 128 * MiB;
constexpr size_t WS_IDX = 136 * MiB;
constexpr size_t WS_QP = 140 * MiB;
constexpr size_t WS_U8 = 464 * MiB, WS_V8 = 480 * MiB;
constexpr size_t WS_USC = 496 * MiB, WS_VSC = 496 * MiB + 65536;
constexpr size_t OUT_DEC = 0, OUT_G = 64 * MiB, OUT_AIC = 96 * MiB;
constexpr int CW_TMO = 0, CW_BAR = 4096, CW_QUEUE = 16384, CW_QU = 32768, CW_QV = 36864;
constexpr size_t WS_W = 238 * MiB;

constexpr int RING_OFF = 0, RING_BYTES = 131072;
constexpr int LDSCTL_OFF = RING_BYTES, MISC_OFF = LDSCTL_OFF + 320;
constexpr int LDS_BYTES = 147456;

#define GAS __attribute__((address_space(1)))
#define LAS __attribute__((address_space(3)))
typedef unsigned short bf16;
typedef unsigned v4u __attribute__((ext_vector_type(4)));
typedef float f32x4 __attribute__((ext_vector_type(4)));
typedef short bf16x8 __attribute__((ext_vector_type(8)));
typedef GAS unsigned gu32;
typedef GAS unsigned long long gu64;
#define RLX_AGENT __ATOMIC_RELAXED, __HIP_MEMORY_SCOPE_AGENT
#define LDS_WAIT() asm volatile("s_waitcnt lgkmcnt(0)" ::: "memory")
#define VM_WAIT() asm volatile("s_waitcnt vmcnt(0)" ::: "memory")
__device__ __forceinline__ unsigned long long rt() { return __builtin_amdgcn_s_memrealtime(); }
__device__ __forceinline__ unsigned f2bf(float f) { unsigned u = __builtin_bit_cast(unsigned, f); return (u + 0x7fffu + ((u >> 16) & 1u)) >> 16; }
__device__ __forceinline__ unsigned pk2(float lo, float hi) { return f2bf(lo) | (f2bf(hi) << 16); }

#define XB_TMO      128
#define XB_XCNT(j)  (256  + 64 * (j))
#define XB_XSUB(j)  (1280 + 64 * (j))
#define XB_XGEN(j)  (2304 + 64 * (j))
#define XB_TOP      3328
#define XB_TOPGEN   3392
#define XCD_BAR_WORDS 3456
#define XB_SPIN_CAP (1u << 18)

__device__ __forceinline__ unsigned xb_ld(unsigned* p)              { return __hip_atomic_load(p, __ATOMIC_RELAXED, __HIP_MEMORY_SCOPE_AGENT); }
__device__ __forceinline__ unsigned xb_add(unsigned* p, unsigned v) { return __hip_atomic_fetch_add(p, v, __ATOMIC_RELAXED, __HIP_MEMORY_SCOPE_AGENT); }
__device__ __forceinline__ unsigned xb_xcc_id() { return (unsigned)__builtin_amdgcn_s_getreg((3 << 11) | 20) & 0xFu; }
#define XB_SPIN(cond, bar) do { unsigned _sp = 0; while (cond) { __builtin_amdgcn_s_sleep(1); \
    if ((++_sp & 255u) == 0u) { if (xb_ld(&(bar)[XB_TMO])) break; if (_sp > XB_SPIN_CAP) { atomicAdd(&(bar)[XB_TMO], 1u); break; } } } } while (0)

struct XcdBarrier {
    unsigned* bar; unsigned x;
    volatile LAS unsigned* st;
};

__device__ __forceinline__ XcdBarrier xcd_barrier_post(unsigned* bar, volatile LAS unsigned* st, int tid) {
    XcdBarrier b; b.bar = bar; b.x = xb_xcc_id(); b.st = st;
    if (tid == 0) (void)xb_add(&bar[XB_XCNT(b.x)], 1u);
    return b;
}
__device__ __forceinline__ void xcd_barrier_complete(unsigned* bar, unsigned x, unsigned& nloc, unsigned& nx) {
    const unsigned G = gridDim.x * gridDim.y * gridDim.z;
    unsigned sum, cnt, mine, sp = 0u;
    for (;;) {
        sum = 0u; cnt = 0u; mine = 0u;
#pragma unroll
        for (unsigned j = 0; j < 16; ++j) { const unsigned c = xb_ld(&bar[XB_XCNT(j)]); sum += c; cnt += (c > 0u) ? 1u : 0u; mine = (j == x) ? c : mine; }
        if (sum == G) break;
        __builtin_amdgcn_s_sleep(1);
        if ((++sp & 255u) == 0u) { if (xb_ld(&bar[XB_TMO])) break; if (sp > XB_SPIN_CAP) { atomicAdd(&bar[XB_TMO], 1u); break; } }
    }
    nloc = mine > 0u ? mine : 1u; nx = cnt > 0u ? cnt : 1u;
}

__device__ __forceinline__ void xcd_barrier(const XcdBarrier& b, int tid) {
    asm volatile("s_waitcnt vmcnt(0)" ::: "memory");
    __syncthreads();
    if (tid == 0) {
        unsigned* bar = b.bar;
        __builtin_amdgcn_s_waitcnt(0);
        unsigned nloc = b.st[0], nx = b.st[1];
        if (nloc == 0u) { xcd_barrier_complete(bar, b.x, nloc, nx); b.st[0] = nloc; b.st[1] = nx; }
        const unsigned old = xb_add(&bar[XB_XSUB(b.x)], 1u);
        const unsigned gen = old / nloc;
        if (old + 1u == (gen + 1u) * nloc) {
            __builtin_amdgcn_fence(__ATOMIC_RELEASE, "agent");
            asm volatile("s_waitcnt vmcnt(0)" ::: "memory");
            const unsigned og = xb_add(&bar[XB_TOP], 1u);
            const unsigned tg = og / nx;
            if (og + 1u == (tg + 1u) * nx) xb_add(&bar[XB_TOPGEN], 1u);
            else XB_SPIN(xb_ld(&bar[XB_TOPGEN]) == tg, bar);
            __builtin_amdgcn_fence(__ATOMIC_ACQUIRE, "agent");
            xb_add(&bar[XB_XGEN(b.x)], 1u);
            asm volatile("s_waitcnt vmcnt(0)" ::: "memory");
        } else {
            XB_SPIN(xb_ld(&bar[XB_XGEN(b.x)]) == gen, bar);
            __builtin_amdgcn_fence(__ATOMIC_ACQUIRE, "agent");
            asm volatile("s_waitcnt vmcnt(0)" ::: "memory");
        }
    }
    __syncthreads();
}


struct Frame {
    LAS unsigned char* lds;
    volatile LAS unsigned* MISC;
    gu32* ctl;
    int tid, lane, wave, vcu, G;
};
__device__ __forceinline__ float wave_sum(float v) {
#pragma unroll
    for (int o = 1; o < 64; o <<= 1) v += __shfl_xor(v, o);
    return v;
}
__device__ __forceinline__ float wave_max(float v) {
#pragma unroll
    for (int o = 1; o < 64; o <<= 1) v = fmaxf(v, __shfl_xor(v, o));
    return v;
}
__device__ __forceinline__ float bflo(unsigned u) { return __uint_as_float(u << 16); }
__device__ __forceinline__ float bfhi(unsigned u) { return __uint_as_float(u & 0xffff0000u); }
__device__ __forceinline__ float bf1(const bf16* p) { return __uint_as_float((unsigned)(*p) << 16); }
__device__ __forceinline__ void ld16bf(const bf16* p, float (&x)[16]) {
    const v4u a = *(const v4u*)p, b = *(const v4u*)(p + 8);
    x[0] = bflo(a.x); x[1] = bfhi(a.x); x[2] = bflo(a.y); x[3] = bfhi(a.y); x[4] = bflo(a.z); x[5] = bfhi(a.z); x[6] = bflo(a.w); x[7] = bfhi(a.w);
    x[8] = bflo(b.x); x[9] = bfhi(b.x); x[10] = bflo(b.y); x[11] = bfhi(b.y); x[12] = bflo(b.z); x[13] = bfhi(b.z); x[14] = bflo(b.w); x[15] = bfhi(b.w);
}
__device__ __forceinline__ void st16bf(bf16* p, const float (&x)[16]) {
    v4u a, b;
    a.x = pk2(x[0], x[1]); a.y = pk2(x[2], x[3]); a.z = pk2(x[4], x[5]); a.w = pk2(x[6], x[7]);
    b.x = pk2(x[8], x[9]); b.y = pk2(x[10], x[11]); b.z = pk2(x[12], x[13]); b.w = pk2(x[14], x[15]);
    *(v4u*)p = a; *(v4u*)(p + 8) = b;
}
__device__ __forceinline__ void ld16f(const float* p, float (&x)[16]) {
#pragma unroll
    for (int j = 0; j < 4; ++j) { const f32x4 v = *(const f32x4*)(p + 4 * j); x[4 * j] = v.x; x[4 * j + 1] = v.y; x[4 * j + 2] = v.z; x[4 * j + 3] = v.w; }
}
__device__ __forceinline__ void shift16(const bf16* row, bool has_prev, int col, const float* mu, float (&x)[16]) {
    float p[16], q[16], m[16];
    ld16bf(row + col, p); ld16f(mu + col, m);
    if (has_prev) ld16bf(row - PJ + col, q); else {
#pragma unroll
        for (int i = 0; i < 16; ++i) q[i] = 0.f; }
#pragma unroll
    for (int i = 0; i < 16; ++i) x[i] = p[i] + m[i] * (q[i] - p[i]);
}

__device__ __forceinline__ void p0_transpose_item(const float* W, int Ks, int Ns, bf16* WT, int Kd, LAS float* scr, int kb, int nb, int lane) {
    const int k0 = 64 * kb, n0 = 32 * nb;
    float wv_[32];
#pragma unroll
    for (int i = 0; i < 32; ++i) { const int kk = 2 * i + (lane >> 5), k = k0 + kk, n = n0 + (lane & 31); wv_[i] = (k < Ks && n < Ns) ? W[(size_t)k * Ns + n] : 0.f; }
#pragma unroll
    for (int i = 0; i < 32; ++i) { const int kk = 2 * i + (lane >> 5); scr[kk * 33 + (lane & 31)] = wv_[i]; }
    LDS_WAIT(); asm volatile("" ::: "memory");
    const int c = lane & 7;
#pragma unroll
    for (int j = 0; j < 4; ++j) { const int n = (lane >> 3) + 8 * j; const LAS float* s = scr + (8 * c) * 33 + n;
        v4u o; o.x = pk2(s[0 * 33], s[1 * 33]); o.y = pk2(s[2 * 33], s[3 * 33]); o.z = pk2(s[4 * 33], s[5 * 33]); o.w = pk2(s[6 * 33], s[7 * 33]);
        *(GAS v4u*)(WT + (size_t)(n0 + n) * Kd + k0 + 8 * c) = o; }
    LDS_WAIT(); asm volatile("" ::: "memory");
}
struct TrItem { const float* W; bf16* WT; int Ks, Ns, Kd, kb, nb; };
struct TrRegs { f32x4 v[8]; };
__device__ __forceinline__ void tr_load(const TrItem& I, int tid, TrRegs& R) {
    const int k0 = 64 * I.kb, n0 = 256 * I.nb, r8 = tid >> 6, c = tid & 63;
#pragma unroll
    for (int i = 0; i < 8; ++i) { const int k = k0 + r8 + 8 * i, n = n0 + 4 * c; R.v[i] = (k < I.Ks && n < I.Ns) ? __builtin_nontemporal_load((const f32x4*)(I.W + (size_t)k * I.Ns + n)) : (f32x4){0.f, 0.f, 0.f, 0.f}; }
}
__device__ __forceinline__ void tr_finish(const TrItem& I, const TrRegs& R, LAS float* scr, int tid) {
    const int k0 = 64 * I.kb, n0 = 256 * I.nb, r8 = tid >> 6, c = tid & 63, lane = tid & 63, w = tid >> 6;
#pragma unroll
    for (int i = 0; i < 8; ++i) { LAS float* d = scr + (r8 + 8 * i) * 257 + 4 * c; d[0] = R.v[i].x; d[1] = R.v[i].y; d[2] = R.v[i].z; d[3] = R.v[i].w; }
    asm volatile("s_waitcnt lgkmcnt(0)\n\ts_barrier" ::: "memory");
    const int nl = lane >> 3, c8 = lane & 7;
#pragma unroll
    for (int jj = 0; jj < 4; ++jj) { const int n = 8 * (w * 4 + jj) + nl; const LAS float* s = scr + (8 * c8) * 257 + n;
        v4u o; o.x = pk2(s[0 * 257], s[1 * 257]); o.y = pk2(s[2 * 257], s[3 * 257]); o.z = pk2(s[4 * 257], s[5 * 257]); o.w = pk2(s[6 * 257], s[7 * 257]);
        *(GAS v4u*)(I.WT + (size_t)(n0 + n) * I.Kd + k0 + 8 * c8) = o; }
    asm volatile("s_waitcnt lgkmcnt(0)\n\ts_barrier" ::: "memory");
}
struct Row8 { f32x4 v[8]; };
__device__ __forceinline__ void ld_row8(const float* src, int lane, Row8& R) {
    const GAS f32x4* xr = (const GAS f32x4*)src + lane;
#pragma unroll
    for (int j = 0; j < 8; ++j) R.v[j] = xr[64 * j];
}
__device__ __forceinline__ void rms_finish(const Row8& R, const float* g, bf16* orow, int lane) {
    const GAS f32x4* gr = (const GAS f32x4*)g + lane; float s = 0.f;
#pragma unroll
    for (int j = 0; j < 8; ++j) s += (R.v[j].x * R.v[j].x + R.v[j].y * R.v[j].y) + (R.v[j].z * R.v[j].z + R.v[j].w * R.v[j].w);
    const float rs = 1.0f / sqrtf(wave_sum(s) * (1.f / DMODEL) + 1e-6f);
    GAS unsigned long long* o8 = (GAS unsigned long long*)orow + lane;
#pragma unroll
    for (int j = 0; j < 8; ++j) { const f32x4 gg = gr[64 * j];
        o8[64 * j] = (unsigned long long)pk2(R.v[j].x * rs * gg.x, R.v[j].y * rs * gg.y) | ((unsigned long long)pk2(R.v[j].z * rs * gg.z, R.v[j].w * rs * gg.w) << 32); }
}
struct Ptrs {
    const float *x, *norm1_g, *w_in, *mu, *w_decay_up, *w0, *w_iclr_up, *a0, *w_gate_up, *k_k, *k_a, *r_k, *lnx_g, *lnx_b, *fox_b_f, *q_norm_g, *k_norm_g, *w_out, *norm2_g, *w_q, *sub_keys, *peer_u, *peer_v;
    float* out;
    bf16 *WQT, *LWT, *WOT, *WINT, *LA, *XN, *PROJ, *MIXED, *KP, *AV, *BV, *QP, *G, *AIC;
    float *C2, *BON, *Y, *DEC, *GATE, *USC, *VSC, *SSQ;
    unsigned short* IDX; unsigned char *U8, *V8;
};
__device__ __forceinline__ void prepA_token(const Ptrs& P, int m, int lane) {
    bf16* row = P.PROJ + (size_t)m * PJ;
    const bool has_prev = (m % SEQ) != 0;
#pragma unroll
    for (int which = 0; which < 2; ++which) {
        bf16* p = row + (which == 0 ? C_FQ : C_FK) + lane * 16;
        float x[16], g[16]; ld16bf(p, x); ld16f((which == 0 ? P.q_norm_g : P.k_norm_g) + (lane & 3) * 16, g);
        float ss = 0.f;
#pragma unroll
        for (int i = 0; i < 16; ++i) ss += x[i] * x[i];
        ss += __shfl_xor(ss, 1); ss += __shfl_xor(ss, 2);
        const float rs = (1.0f / sqrtf(ss * (1.f / 64.f) + 1e-6f)) * (which == 0 ? C2Q : 1.f);
#pragma unroll
        for (int i = 0; i < 16; ++i) x[i] = x[i] * rs * g[i];
        st16bf(p, x);
    }
    {
        const bf16* prow = row - PJ;
        auto sh = [&](int col) -> float { const float p = bf1(row + col); const float q = has_prev ? bf1(prow + col) : 0.f; return p + P.mu[col] * (q - p); };
        bf16* la0 = P.LA + (size_t)m * 128; bf16* la1 = P.LA + (size_t)M * 128 + (size_t)m * 128; bf16* la2 = P.LA + (size_t)2 * M * 128 + (size_t)m * 128;
        const float wd = sh(C_WD + lane), ad = sh(C_AD + lane), g0 = sh(C_GD + lane), g1 = sh(C_GD + 64 + lane);
        const unsigned short o0 = (unsigned short)f2bf(tanhf(wd)), o1 = (unsigned short)f2bf(ad);
        asm volatile("" ::: "memory");
        la0[lane] = o0; la0[64 + lane] = 0;
        la1[lane] = o1; la1[64 + lane] = 0;
        la2[lane] = (bf16)f2bf(1.0f / (1.0f + __expf(-g0))); la2[64 + lane] = (bf16)f2bf(1.0f / (1.0f + __expf(-g1)));
    }
}
__device__ __forceinline__ void fox_cumsum(const Ptrs& P, int bh, LAS float* scr, int tid) {
    const int b = bh >> 4, h = bh & 15; const float bf_ = P.fox_b_f[h];
    const bf16* src = P.PROJ + (size_t)(b * SEQ + tid * 16) * PJ + C_FF + h;
    float v[16]; float run = 0.f;
#pragma unroll
    for (int i = 0; i < 16; ++i) { const float x = bf1(src + (size_t)i * PJ) + bf_;
        const float ls = (x >= 0.f) ? -log1pf(__expf(-x)) : (x - log1pf(__expf(x))); run += ls; v[i] = run; }
    float inc = run; const int lane = tid & 63, w = tid >> 6;
#pragma unroll
    for (int o = 1; o < 64; o <<= 1) { const float t = __shfl_up(inc, o); if (lane >= o) inc += t; }
    if (lane == 63) scr[w] = inc;
    __syncthreads();
    float off = inc - run;
    for (int j = 0; j < w; ++j) off += scr[j];
    float* dst = P.C2 + (size_t)bh * SEQ + tid * 16;
#pragma unroll
    for (int i = 0; i < 16; i += 4) *(f32x4*)(dst + i) = (f32x4){(off + v[i]) * LOG2E, (off + v[i + 1]) * LOG2E, (off + v[i + 2]) * LOG2E, (off + v[i + 3]) * LOG2E};
    __syncthreads();
}

#define DPP_ADD(x, ctrl) ((x) + __uint_as_float((unsigned)__builtin_amdgcn_update_dpp(0, (int)__float_as_uint(x), (ctrl), 0xf, 0xf, true)))
__device__ __forceinline__ float row16_sum(float x) {
    x = DPP_ADD(x, 0xB1);
    x = DPP_ADD(x, 0x4E);
    x = DPP_ADD(x, 0x141);
    x = DPP_ADD(x, 0x140);
    return x;
}
__device__ __forceinline__ void post_token(const Ptrs& P, int m, int lane) {
    const bf16* row = P.PROJ + (size_t)m * PJ;
    const bool has_prev = (m % SEQ) != 0;
    const int c = lane * 16, h = lane >> 2;
    float y[16], vs[16], g[16], lg[16], lb[16];
    ld16f(P.Y + (size_t)m * 1024 + c, y);
    float s = 0.f;
#pragma unroll
    for (int i = 0; i < 16; ++i) s += y[i];
    s += __shfl_xor(s, 1); s += __shfl_xor(s, 2);
    const float mean = s * (1.f / 64.f);
    float q = 0.f;
#pragma unroll
    for (int i = 0; i < 16; ++i) { y[i] -= mean; q += y[i] * y[i]; }
    q += __shfl_xor(q, 1); q += __shfl_xor(q, 2);
    const float rstd = 1.0f / sqrtf(q * (1.f / 64.f) + 64e-5f);
    shift16(row, has_prev, C_V + c, P.mu, vs);
    ld16bf(P.G + (size_t)m * 1024 + c, g); ld16f(P.lnx_g + c, lg); ld16f(P.lnx_b + c, lb);
    const float bon = P.BON[(size_t)m * 16 + h];
#pragma unroll
    for (int i = 0; i < 16; ++i) y[i] = (y[i] * rstd * lg[i] + lb[i] + bon * vs[i]) * g[i];
    st16bf(P.MIXED + (size_t)m * 2048 + c, y);
}

constexpr int FOX_NCH = M / 64;
__device__ __forceinline__ float* fox_totals(const Ptrs& P) { return (float*)(P.LWT + 3 * 1024 * 128); }
__device__ __forceinline__ void fox_scan_local(const Ptrs& P, int c, int w, int lane) {
    const int m = c * 64 + lane, b = m / SEQ, t = m % SEQ;
    const unsigned fv = *(const unsigned*)(P.PROJ + (size_t)m * PJ + C_FF + 2 * w);
    const float b0 = P.fox_b_f[2 * w], b1 = P.fox_b_f[2 * w + 1];
    float* T = fox_totals(P) + c * 16 + 2 * w;
    float inc[2] = {bflo(fv) + b0, bfhi(fv) + b1};
#pragma unroll
    for (int e = 0; e < 2; ++e) { const float xv = inc[e]; inc[e] = (xv >= 0.f) ? -log1pf(__expf(-xv)) : (xv - log1pf(__expf(xv))); }
#pragma unroll
    for (int o = 1; o < 64; o <<= 1) { const float u0 = __shfl_up(inc[0], o), u1 = __shfl_up(inc[1], o); if (lane >= o) { inc[0] += u0; inc[1] += u1; } }
    P.C2[(size_t)(b * 16 + 2 * w) * SEQ + t] = inc[0]; P.C2[(size_t)(b * 16 + 2 * w + 1) * SEQ + t] = inc[1];
    if (lane == 63) { T[0] = inc[0]; T[1] = inc[1]; }
}
__device__ __forceinline__ void fox_scan_fix(const Ptrs& P, int c, int w, int lane) {
    const float* T = fox_totals(P) + 2 * w;
    const int cb = c & ~(SEQ / 64 - 1), n = c - cb;
    float off0 = 0.f, off1 = 0.f;
    for (int cc = lane; cc < n; cc += 64) { off0 += T[(size_t)(cb + cc) * 16]; off1 += T[(size_t)(cb + cc) * 16 + 1]; }
#pragma unroll
    for (int o = 32; o >= 1; o >>= 1) { off0 += __shfl_xor(off0, o); off1 += __shfl_xor(off1, o); }
    const int m = c * 64 + lane, b = m / SEQ, t = m % SEQ;
    float* p0 = P.C2 + (size_t)(b * 16 + 2 * w) * SEQ + t; float* p1 = p0 + SEQ;
    const float v0 = *p0, v1 = *p1;
    *p0 = (v0 + off0) * LOG2E; *p1 = (v1 + off1) * LOG2E;
}
struct PrepRaw { v4u q[2], k[2]; unsigned c[4], p[4]; };
__device__ __forceinline__ void prep_load(const Ptrs& P, int m, int lane, PrepRaw& R) {
    const bf16* row = P.PROJ + (size_t)m * PJ; const bf16* prow = row - (((m % SEQ) != 0) ? PJ : 0);
    R.q[0] = (v4u){0u, 0u, 0u, 0u}; R.q[1] = R.q[0];
    R.k[0] = *(const v4u*)(row + C_FK + lane * 16); R.k[1] = *(const v4u*)(row + C_FK + lane * 16 + 8);
    constexpr int COL[4] = {C_WD, C_AD, C_GD, C_GD + 64};
#pragma unroll
    for (int i = 0; i < 4; ++i) { R.c[i] = row[COL[i] + lane]; R.p[i] = prow[COL[i] + lane]; }
}
__device__ __forceinline__ void unpack16(const v4u (&r)[2], float (&x)[16]) {
    x[0] = bflo(r[0].x); x[1] = bfhi(r[0].x); x[2] = bflo(r[0].y); x[3] = bfhi(r[0].y); x[4] = bflo(r[0].z); x[5] = bfhi(r[0].z); x[6] = bflo(r[0].w); x[7] = bfhi(r[0].w);
    x[8] = bflo(r[1].x); x[9] = bfhi(r[1].x); x[10] = bflo(r[1].y); x[11] = bfhi(r[1].y); x[12] = bflo(r[1].z); x[13] = bfhi(r[1].z); x[14] = bflo(r[1].w); x[15] = bfhi(r[1].w);
}
__device__ __forceinline__ void prep_finish(const Ptrs& P, int m, int lane, const PrepRaw& R, const float (&gq)[16], const float (&gk)[16], const float (&mu4)[4]) {
    bf16* row = P.PROJ + (size_t)m * PJ; const bool has_prev = (m % SEQ) != 0;
#pragma unroll
    for (int which = 1; which < 2; ++which) {
        float x[16]; if (which == 0) unpack16(R.q, x); else unpack16(R.k, x);
        float ss = 0.f;
#pragma unroll
        for (int i = 0; i < 16; ++i) ss += x[i] * x[i];
        ss += __shfl_xor(ss, 1); ss += __shfl_xor(ss, 2);
        const float rs = (1.0f / sqrtf(ss * (1.f / 64.f) + 1e-6f)) * (which == 0 ? C2Q : 1.f);
#pragma unroll
        for (int i = 0; i < 16; ++i) x[i] = x[i] * rs * (which == 0 ? gq[i] : gk[i]);
        st16bf(row + (which == 0 ? C_FQ : C_FK) + lane * 16, x);
    }
    float s[4];
#pragma unroll
    for (int i = 0; i < 4; ++i) { const float pc = __uint_as_float(R.c[i] << 16), pp = has_prev ? __uint_as_float(R.p[i] << 16) : 0.f; s[i] = pc + mu4[i] * (pp - pc); }
    bf16* la0 = P.LA + (size_t)m * 128; bf16* la1 = P.LA + (size_t)M * 128 + (size_t)m * 128; bf16* la2 = P.LA + (size_t)2 * M * 128 + (size_t)m * 128;
    la0[lane] = (bf16)f2bf(tanhf(s[0])); la0[64 + lane] = 0;
    la1[lane] = (bf16)f2bf(s[1]); la1[64 + lane] = 0;
    la2[lane] = (bf16)f2bf(1.0f / (1.0f + __expf(-s[2]))); la2[64 + lane] = (bf16)f2bf(1.0f / (1.0f + __expf(-s[3])));
}
__device__ __forceinline__ void prep_phase(const Ptrs& P, int gw, int ngw, int lane) {
    float gq[16], gk[16], mu4[4];
    ld16f(P.q_norm_g + (lane & 3) * 16, gq); ld16f(P.k_norm_g + (lane & 3) * 16, gk);
    mu4[0] = P.mu[C_WD + lane]; mu4[1] = P.mu[C_AD + lane]; mu4[2] = P.mu[C_GD + lane]; mu4[3] = P.mu[C_GD + 64 + lane];
    if (M % (4 * ngw) == 0) {
        PrepRaw R0, R1, R2, R3;
        auto cl = [&](int mm) { return mm < M ? mm : gw; };
#define PFENCE() asm volatile("" ::: "memory")
        prep_load(P, gw, lane, R0); PFENCE(); prep_load(P, gw + ngw, lane, R1); PFENCE(); prep_load(P, gw + 2 * ngw, lane, R2); PFENCE();
        for (int m = gw; m < M; m += 4 * ngw) {
            prep_load(P, m + 3 * ngw, lane, R3); PFENCE(); prep_finish(P, m, lane, R0, gq, gk, mu4); PFENCE();
            prep_load(P, cl(m + 4 * ngw), lane, R0); PFENCE(); prep_finish(P, m + ngw, lane, R1, gq, gk, mu4); PFENCE();
            prep_load(P, cl(m + 5 * ngw), lane, R1); PFENCE(); prep_finish(P, m + 2 * ngw, lane, R2, gq, gk, mu4); PFENCE();
            prep_load(P, cl(m + 6 * ngw), lane, R2); PFENCE(); prep_finish(P, m + 3 * ngw, lane, R3, gq, gk, mu4); PFENCE();
        }
    } else {
        for (int m = gw; m < M; m += ngw) { PrepRaw R; prep_load(P, m, lane, R); prep_finish(P, m, lane, R, gq, gk, mu4); }
    }
}
struct PostRaw { f32x4 y[4]; v4u vc[2], vp[2], g[2]; float bon; };
__device__ __forceinline__ void post_load(const Ptrs& P, int m, int lane, PostRaw& R) {
    const bf16* row = P.PROJ + (size_t)m * PJ; const bf16* prow = row - (((m % SEQ) != 0) ? PJ : 0); const int c = lane * 16;
#pragma unroll
    for (int j = 0; j < 4; ++j) R.y[j] = *(const f32x4*)(P.Y + (size_t)m * 1024 + c + 4 * j);
    R.vc[0] = *(const v4u*)(row + C_V + c); R.vc[1] = *(const v4u*)(row + C_V + c + 8);
    R.vp[0] = *(const v4u*)(prow + C_V + c); R.vp[1] = *(const v4u*)(prow + C_V + c + 8);
    R.g[0] = *(const v4u*)(P.G + (size_t)m * 1024 + c); R.g[1] = *(const v4u*)(P.G + (size_t)m * 1024 + c + 8);
    R.bon = P.BON[(size_t)m * 16 + (lane >> 2)];
}
__device__ __forceinline__ void post_finish(const Ptrs& P, int m, int lane, const PostRaw& R, const float (&lg)[16], const float (&lb)[16], const float (&mu)[16]) {
    float y[16], vc[16], vp[16], g[16]; const bool has_prev = (m % SEQ) != 0;
#pragma unroll
    for (int j = 0; j < 4; ++j) { y[4 * j] = R.y[j].x; y[4 * j + 1] = R.y[j].y; y[4 * j + 2] = R.y[j].z; y[4 * j + 3] = R.y[j].w; }
    float s = 0.f;
#pragma unroll
    for (int i = 0; i < 16; ++i) s += y[i];
    s += __shfl_xor(s, 1); s += __shfl_xor(s, 2);
    const float mean = s * (1.f / 64.f);
    float q = 0.f;
#pragma unroll
    for (int i = 0; i < 16; ++i) { y[i] -= mean; q += y[i] * y[i]; }
    q += __shfl_xor(q, 1); q += __shfl_xor(q, 2);
    const float rstd = 1.0f / sqrtf(q * (1.f / 64.f) + 64e-5f);
    unpack16(R.vc, vc); unpack16(R.vp, vp); unpack16(R.g, g);
#pragma unroll
    for (int i = 0; i < 16; ++i) { const float vs = vc[i] + mu[i] * ((has_prev ? vp[i] : 0.f) - vc[i]); y[i] = (y[i] * rstd * lg[i] + lb[i] + R.bon * vs) * g[i]; }
    st16bf(P.MIXED + (size_t)m * 2048 + lane * 16, y);
}
__device__ __forceinline__ void post_phase(const Ptrs& P, int gw, int ngw, int lane) {
    float lg[16], lb[16], mu[16];
    ld16f(P.lnx_g + lane * 16, lg); ld16f(P.lnx_b + lane * 16, lb); ld16f(P.mu + C_V + lane * 16, mu);
    PostRaw A, B;
    int m = gw;
    if (m < M) post_load(P, m, lane, A);
    for (; m < M; m += 2 * ngw) {
        const int m1 = m + ngw, m2 = m1 + ngw;
        post_load(P, m1 < M ? m1 : m, lane, B);
        post_finish(P, m, lane, A, lg, lb, mu);
        post_load(P, m2 < M ? m2 : m, lane, A);
        if (m1 < M) post_finish(P, m1, lane, B, lg, lb, mu);
    }
}
typedef float v16f __attribute__((ext_vector_type(16)));
typedef float v32f __attribute__((ext_vector_type(32)));
typedef unsigned v6u __attribute__((ext_vector_type(6)));
constexpr int ROW6 = 1024;
__device__ __forceinline__ void fp4_finish(const Row8& R, unsigned char* dst, float* mult, int lane) {
    const f32x4 (&v)[8] = R.v; float am = 0.f;
#pragma unroll
    for (int j = 0; j < 8; ++j) am = fmaxf(am, fmaxf(fmaxf(fabsf(v[j].x), fabsf(v[j].y)), fmaxf(fabsf(v[j].z), fabsf(v[j].w))));
    am = wave_max(am);
    const float sc = am > 0.f ? 6.0f / am : 1.0f;
    unsigned w[4];
#pragma unroll
    for (int d = 0; d < 4; ++d) { unsigned x = 0u;
        x = __builtin_amdgcn_cvt_scalef32_pk_fp4_f32(x, v[2 * d].x * sc, v[2 * d].y * sc, 1.0f, 0); x = __builtin_amdgcn_cvt_scalef32_pk_fp4_f32(x, v[2 * d].z * sc, v[2 * d].w * sc, 1.0f, 1);
        x = __builtin_amdgcn_cvt_scalef32_pk_fp4_f32(x, v[2 * d + 1].x * sc, v[2 * d + 1].y * sc, 1.0f, 2); x = __builtin_amdgcn_cvt_scalef32_pk_fp4_f32(x, v[2 * d + 1].z * sc, v[2 * d + 1].w * sc, 1.0f, 3);
        w[d] = x; }
    *(GAS v4u*)(dst + lane * 16) = (v4u){w[0], w[1], w[2], w[3]};
    if (lane == 0) *mult = am > 0.f ? am * (1.0f / 6.0f) : 1.0f;
}

__device__ __forceinline__ void ld_row8_nt(const float* src, int lane, Row8& R) {
    const GAS f32x4* xr = (const GAS f32x4*)src + lane;
#pragma unroll
    for (int j = 0; j < 8; ++j) R.v[j] = __builtin_nontemporal_load(xr + 64 * j);
}
__device__ __forceinline__ void table_rows(const Ptrs& P, int e0, int e1, int wi, int nw, int lane) {
    auto src = [&](int e) -> const float* { const int ec = e < e1 ? e : e1 - 1; return (ec < NEXP ? P.peer_u : P.peer_v - (size_t)NEXP * 2048) + (size_t)ec * 2048; };
    auto fin = [&](const Row8& R, int e) { if (e < NEXP) fp4_finish(R, P.U8 + (size_t)e * ROW6, P.USC + 2 * e, lane); else fp4_finish(R, P.V8 + (size_t)(e - NEXP) * ROW6, P.USC + 2 * (e - NEXP) + 1, lane); };
    int e = e0 + wi; if (e >= e1) return;
    Row8 R0, R1, R2, R3;
    ld_row8_nt(src(e), lane, R0); PFENCE(); ld_row8_nt(src(e + nw), lane, R1); PFENCE(); ld_row8_nt(src(e + 2 * nw), lane, R2); PFENCE();
    for (;; e += 4 * nw) {
        ld_row8_nt(src(e + 3 * nw), lane, R3); PFENCE(); fin(R0, e); PFENCE();
        if (e + nw >= e1) break;
        ld_row8_nt(src(e + 4 * nw), lane, R0); PFENCE(); fin(R1, e + nw); PFENCE();
        if (e + 2 * nw >= e1) break;
        ld_row8_nt(src(e + 5 * nw), lane, R1); PFENCE(); fin(R2, e + 2 * nw); PFENCE();
        if (e + 3 * nw >= e1) break;
        ld_row8_nt(src(e + 6 * nw), lane, R2); PFENCE(); fin(R3, e + 3 * nw); PFENCE();
        if (e + 4 * nw >= e1) break;
    }
}

__device__ __forceinline__ void xn_rows(const Ptrs& P, int wi, int nw, int lane) {
    auto src = [&](int m) -> const float* { const int mc = m < M ? m : M - 1; return P.x + (size_t)mc * DMODEL; };
    auto fin = [&](const Row8& R, int m) { rms_finish(R, P.norm1_g, P.XN + (size_t)m * DMODEL, lane); };
    int m = wi; if (m >= M) return;
    Row8 R0, R1, R2, R3;
    ld_row8_nt(src(m), lane, R0); PFENCE(); ld_row8_nt(src(m + nw), lane, R1); PFENCE(); ld_row8_nt(src(m + 2 * nw), lane, R2); PFENCE();
    for (;; m += 4 * nw) {
        ld_row8_nt(src(m + 3 * nw), lane, R3); PFENCE(); fin(R0, m); PFENCE();
        if (m + nw >= M) break;
        ld_row8_nt(src(m + 4 * nw), lane, R0); PFENCE(); fin(R1, m + nw); PFENCE();
        if (m + 2 * nw >= M) break;
        ld_row8_nt(src(m + 5 * nw), lane, R1); PFENCE(); fin(R2, m + 2 * nw); PFENCE();
        if (m + 3 * nw >= M) break;
        ld_row8_nt(src(m + 6 * nw), lane, R2); PFENCE(); fin(R3, m + 3 * nw); PFENCE();
        if (m + 4 * nw >= M) break;
    }
}
namespace rk {
typedef float f32x16 __attribute__((ext_vector_type(16)));
constexpr int CS = 144;
constexpr int FS = 272;
constexpr int L_AT = 0, L_RT = 9216, L_BT = 18432, L_KT = 27648, L_PF = 18432, L_VT = 36864, L_BH = 46080, L_M1 = 55296, L_KH = 64512, L_Q1 = 55296,
              L_M3 = 73728, L_M4 = 82944, L_M2 = 92160, L_GL = 109568, L_WT = 109824, L_QF = 111872, L_M2B = 111872, L_PI = 121088, L_RTW = 36864, L_END = 129280;
__device__ __forceinline__ int crow(int r, int hi) { return (r & 3) + 8 * (r >> 2) + 4 * hi; }
typedef float f32x2c __attribute__((ext_vector_type(2))); typedef __bf16 bf16x2c __attribute__((ext_vector_type(2)));
__device__ __forceinline__ unsigned cvtpk_v(float lo, float hi) { const f32x2c v = {lo, hi}; const bf16x2c b = __builtin_convertvector(v, bf16x2c); return __builtin_bit_cast(unsigned, b); }
__device__ __forceinline__ int permcol(int j) { const int x = j & 15; return (j & ~15) + ((x >> 2) & 1) * 8 + (x >> 3) * 4 + (x & 3); }
__device__ __forceinline__ void mm32(f32x16& acc, const LAS unsigned char* A, const LAS unsigned char* Bt, int lane) {
    const int r = lane & 31, h = lane >> 5;
    const LAS unsigned char* pa = A + r * CS + h * 16; const LAS unsigned char* pb = Bt + r * CS + h * 16;
#pragma unroll
    for (int ks = 0; ks < 4; ++ks) { const bf16x8 a = *(const LAS bf16x8*)(pa + ks * 32), b = *(const LAS bf16x8*)(pb + ks * 32); acc = __builtin_amdgcn_mfma_f32_32x32x16_bf16(a, b, acc, 0, 0, 0); }
}
__device__ __forceinline__ void st_bf16(LAS unsigned char* p, float v) { *(LAS unsigned short*)p = (unsigned short)cvtpk_v(v, v); }

struct S1Regs { v4u rk, rkp, raic, rr, rrp, rv, rvp; f32x4 rw0, rw1; };
__device__ __forceinline__ void s1_load(const Ptrs& P, int unit, int tid, S1Regs& R) {
    const int c = unit >> 5, bh = unit & 31, b = bh >> 4, h = bh & 15, tt = tid >> 3, sg = tid & 7;
    const int t_ = c * 64 + tt; const size_t m_ = (size_t)b * SEQ + t_; const int cb = h * 64 + sg * 8;
    R.rk = *(const v4u*)(P.PROJ + m_ * PJ + C_K + cb); R.raic = *(const v4u*)(P.AIC + m_ * 1024 + cb);
    R.rw0 = *(const f32x4*)(P.DEC + m_ * 1024 + cb); R.rw1 = *(const f32x4*)(P.DEC + m_ * 1024 + cb + 4);
    R.rr = *(const v4u*)(P.PROJ + m_ * PJ + C_R + cb); R.rv = *(const v4u*)(P.PROJ + m_ * PJ + C_V + cb);
    if (t_ > 0) { R.rrp = *(const v4u*)(P.PROJ + (m_ - 1) * PJ + C_R + cb); R.rvp = *(const v4u*)(P.PROJ + (m_ - 1) * PJ + C_V + cb); R.rkp = *(const v4u*)(P.PROJ + (m_ - 1) * PJ + C_K + cb); }
    else { R.rrp = (v4u){0u, 0u, 0u, 0u}; R.rvp = (v4u){0u, 0u, 0u, 0u}; R.rkp = (v4u){0u, 0u, 0u, 0u}; }
}
__device__ __forceinline__ void unpk8(const v4u u, float (&x)[8]) { x[0] = bflo(u.x); x[1] = bfhi(u.x); x[2] = bflo(u.y); x[3] = bfhi(u.y); x[4] = bflo(u.z); x[5] = bfhi(u.z); x[6] = bflo(u.w); x[7] = bfhi(u.w); }
__device__ __forceinline__ v4u pk8(const float (&x)[8]) { v4u o; o.x = pk2(x[0], x[1]); o.y = pk2(x[2], x[3]); o.z = pk2(x[4], x[5]); o.w = pk2(x[6], x[7]); return o; }

#ifdef PROBE_MASK
#define S1T(k) do { if (blockIdx.x == 0 && wv == 0) { unsigned long long t_; __builtin_amdgcn_sched_barrier(0); asm volatile("s_memrealtime %0\n\ts_waitcnt lgkmcnt(0)" : "=s"(t_) :: "memory"); __builtin_amdgcn_sched_barrier(0); \
    volatile LAS unsigned* w_ = (volatile LAS unsigned*)(lds + MISC_OFF) + 96; if ((tid & 63) == 0) { w_[(k)] += (unsigned)t_ - w_[7]; w_[7] = (unsigned)t_; } } } while (0)
#else
#define S1T(k) do {} while (0)
#endif
#define S1_BAR() asm volatile("s_waitcnt lgkmcnt(0)\n\ts_barrier" ::: "memory")
__device__ __forceinline__ void s1_unit(const Ptrs& P, int unit, int next_unit, S1Regs& R, LAS unsigned char* lds, int tid_in, int wv) {
    int tid = tid_in; asm volatile("" : "+v"(tid));
    const int c = unit >> 5, bh = unit & 31, b = bh >> 4, h = bh & 15, tt = tid >> 3, sg = tid & 7, lane = tid & 63;
    const size_t m0 = (size_t)b * SEQ + c * 64;
    {
        float a8[8], b8[8], k8[8], r8[8], v8[8], p8[8], lw[8], cum[8];
        const int cb = h * 64 + sg * 8;
        float mu8[8], c8[8];
#define S1_LD8(dst, ptr) do { const f32x4 u0_ = *(const f32x4*)(ptr), u1_ = *(const f32x4*)((ptr) + 4); dst[0] = u0_.x; dst[1] = u0_.y; dst[2] = u0_.z; dst[3] = u0_.w; dst[4] = u1_.x; dst[5] = u1_.y; dst[6] = u1_.z; dst[7] = u1_.w; } while (0)
        unpk8(R.rk, k8); unpk8(R.rkp, p8); S1_LD8(mu8, P.mu + C_K + cb);
#pragma unroll
        for (int e = 0; e < 8; ++e) k8[e] = k8[e] + mu8[e] * (p8[e] - k8[e]);
        S1_LD8(c8, P.k_k + cb);
        float n2 = 0.f;
#pragma unroll
        for (int e = 0; e < 8; ++e) { a8[e] = k8[e] * c8[e]; n2 += a8[e] * a8[e]; }
        n2 = DPP_ADD(n2, 0xB1); n2 = DPP_ADD(n2, 0x4E); n2 = DPP_ADD(n2, 0x141);
        const float inv = 1.0f / fmaxf(sqrtf(n2), 1e-12f);
        unpk8(R.raic, b8); S1_LD8(c8, P.k_a + cb);
#pragma unroll
        for (int e = 0; e < 8; ++e) { const float ic = __builtin_amdgcn_rcpf(1.0f + __expf(-b8[e])); const float kk = a8[e] * inv; k8[e] = k8[e] * (1.0f + (ic - 1.0f) * c8[e]); a8[e] = -kk; b8[e] = kk * ic; }
        unpk8(R.rr, r8); unpk8(R.rrp, p8); S1_LD8(mu8, P.mu + C_R + cb);
#pragma unroll
        for (int e = 0; e < 8; ++e) r8[e] = r8[e] + mu8[e] * (p8[e] - r8[e]);
        S1_LD8(c8, P.r_k + cb);
        float bon = 0.f;
#pragma unroll
        for (int e = 0; e < 8; ++e) bon += r8[e] * k8[e] * c8[e];
        bon = DPP_ADD(bon, 0xB1); bon = DPP_ADD(bon, 0x4E); bon = DPP_ADD(bon, 0x141);
        if (sg == 0) P.BON[(m0 + tt) * 16 + h] = bon;
        unpk8(R.rv, v8); unpk8(R.rvp, p8); S1_LD8(mu8, P.mu + C_V + cb);
#pragma unroll
        for (int e = 0; e < 8; ++e) v8[e] = v8[e] + mu8[e] * (p8[e] - v8[e]);
        const float z8[8] = {R.rw0.x, R.rw0.y, R.rw0.z, R.rw0.w, R.rw1.x, R.rw1.y, R.rw1.z, R.rw1.w};
#pragma unroll
        for (int e = 0; e < 8; ++e) { lw[e] = -0.60653065971263342f * __builtin_amdgcn_rcpf(1.0f + __expf(-z8[e])); cum[e] = lw[e]; }
#undef S1_LD8
#pragma unroll
        for (int o = 8; o < 64; o <<= 1)
#pragma unroll
            for (int e = 0; e < 8; ++e) { const float t = __shfl_up(cum[e], o); if (lane >= o) cum[e] += t; }
        LAS float* WT = (LAS float*)(lds + L_WT);
        if (lane >= 56) {
#pragma unroll
            for (int e = 0; e < 8; ++e) WT[wv * 64 + sg * 8 + e] = cum[e]; }
        S1_BAR(); S1T(0);
        float cL[8];
#pragma unroll
        for (int e = 0; e < 8; ++e) cL[e] = 0.f;
        {
            float off[8];
#pragma unroll
            for (int e = 0; e < 8; ++e) off[e] = 0.f;
#pragma unroll
            for (int w2 = 0; w2 < 8; ++w2) { const f32x4 x0 = *(const LAS f32x4*)(WT + w2 * 64 + sg * 8), x1 = *(const LAS f32x4*)(WT + w2 * 64 + sg * 8 + 4);
                const float xs[8] = {x0.x, x0.y, x0.z, x0.w, x1.x, x1.y, x1.z, x1.w};
#pragma unroll
                for (int e = 0; e < 8; ++e) { cL[e] += xs[e]; off[e] += (w2 < wv) ? xs[e] : 0.f; } }
#pragma unroll
            for (int e = 0; e < 8; ++e) cum[e] += off[e];
        }
        float o8[8];
#pragma unroll
        for (int e = 0; e < 8; ++e) o8[e] = a8[e] * __expf(cum[e] - lw[e]);
        *(LAS v4u*)(lds + L_AT + tt * CS + sg * 16) = pk8(o8);
#pragma unroll
        for (int e = 0; e < 8; ++e) o8[e] = r8[e] * __expf(cum[e]);
        *(LAS v4u*)(lds + L_RT + tt * CS + sg * 16) = pk8(o8);
        float gi[8];
#pragma unroll
        for (int e = 0; e < 8; ++e) { gi[e] = __expf(-cum[e]); o8[e] = b8[e] * gi[e]; }
        *(LAS v4u*)(lds + L_BT + tt * CS + sg * 16) = pk8(o8);
#pragma unroll
        for (int e = 0; e < 8; ++e) o8[e] = k8[e] * gi[e];
        *(LAS v4u*)(lds + L_KT + tt * CS + sg * 16) = pk8(o8);
#pragma unroll
        for (int e = 0; e < 8; ++e) { const float gl = __expf(cL[e] - cum[e]);
            st_bf16(lds + L_VT + (sg * 8 + e) * CS + tt * 2, v8[e]); st_bf16(lds + L_BH + (sg * 8 + e) * CS + tt * 2, b8[e] * gl); st_bf16(lds + L_KH + (sg * 8 + e) * CS + tt * 2, k8[e] * gl); }
        if (tt == 0) {
#pragma unroll
            for (int e = 0; e < 8; ++e) ((LAS float*)(lds + L_GL))[sg * 8 + e] = __expf(cL[e]); }
    }
    S1_BAR(); S1T(1);
    if (next_unit < 4096) s1_load(P, next_unit, tid, R);
    int lane2 = lane; asm volatile("" : "+v"(lane2));
    const int hl = lane2 >> 5, cl = lane2 & 31;
    {
        const int p = wv >> 1, mb = wv & 1;
        const LAS unsigned char* A = lds + ((p < 2) ? L_AT : L_RT) + mb * 32 * CS;
        const LAS unsigned char* B = lds + ((p == 0 || p == 3) ? L_KT : L_BT);
#pragma unroll
        for (int nb = 0; nb < 2; ++nb) {
            f32x16 acc = {}; mm32(acc, A, B + nb * 32 * CS, lane);
            const int col = nb * 32 + cl;
#pragma unroll
            for (int rg = 0; rg < 16; ++rg) { const int row = mb * 32 + crow(rg, hl);
                const bool keep = (p < 2) ? (col < row) : (col <= row); const float v = keep ? acc[rg] : 0.f;
                if (p == 1) { *(LAS float*)(lds + L_M2 + row * FS + col * 4) = v; st_bf16(lds + L_M2B + row * CS + col * 2, v); }
                else st_bf16(lds + ((p == 0) ? L_M1 : (p == 2) ? L_M3 : L_M4) + row * CS + col * 2, v); }
        }
    }
    S1_BAR(); S1T(2);
    f32x16 accQ = {}, accY = {};
    const int tb = (wv >> 1) & 1, ib = wv & 1;
    if (wv < 4) {
        f32x16 acc = {}; mm32(acc, lds + L_M1 + tb * 32 * CS, lds + L_VT + ib * 32 * CS, lane);
#pragma unroll
        for (int rg = 0; rg < 16; ++rg) *(LAS float*)(lds + L_PF + (ib * 32 + cl) * FS + (tb * 32 + crow(rg, hl)) * 4) = acc[rg];
        if (lane2 < 32) {
            const int I = wv; const LAS unsigned char* mdia = lds + L_M2 + I * 16 * FS + I * 64; LAS unsigned char* pib = lds + L_PI + I * 1024 + lane2 * 2;
            asm volatile("" : "+v"(mdia), "+v"(pib));
            float pc[16];
#pragma unroll
            for (int r2 = 0; r2 < 16; ++r2) {
                float s_ = (r2 == lane2) ? 1.0f : 0.0f;
#pragma unroll
                for (int g = 0; g < (r2 + 3) / 4; ++g) { const f32x4 m = *(const LAS f32x4*)(mdia + r2 * FS + g * 16);
                    s_ += m.x * pc[4 * g];
                    if (4 * g + 1 < r2) s_ += m.y * pc[4 * g + 1];
                    if (4 * g + 2 < r2) s_ += m.z * pc[4 * g + 2];
                    if (4 * g + 3 < r2) s_ += m.w * pc[4 * g + 3]; }
                pc[r2] = s_;
                st_bf16(pib + r2 * 64, s_);
            }
        }
    } else { mm32(accQ, lds + L_KH + tb * 32 * CS, lds + L_VT + ib * 32 * CS, lane); mm32(accY, lds + L_M4 + tb * 32 * CS, lds + L_VT + ib * 32 * CS, lane); }
    S1_BAR(); S1T(3);
    {
        typedef float f32x4m __attribute__((ext_vector_type(4)));
        const int c16 = lane2 & 15, kq = lane2 >> 4, n0 = wv * 16, n = n0 + c16;
        LAS unsigned char* q1w = lds + L_Q1 + n0 * CS;
        LAS unsigned char* rtw = lds + L_RTW + wv * 1024;
        {
            const v4u z = (v4u){0u, 0u, 0u, 0u};
            for (int o = lane2 * 16; o < 16 * CS; o += 1024) *(LAS v4u*)(q1w + o) = z;
            *(LAS v4u*)(rtw + lane2 * 16) = z;
        }
        const LAS unsigned char* a_m2 = lds + L_M2B + c16 * CS + kq * 16;
        const LAS unsigned char* b_q1 = q1w + c16 * CS + kq * 16;
        const LAS unsigned char* a_pi = lds + L_PI + c16 * 64 + kq * 16;
        const LAS unsigned char* b_rt = rtw + c16 * 64 + kq * 16;
        asm volatile("s_waitcnt lgkmcnt(0)" ::: "memory");
#pragma unroll
        for (int I = 0; I < 4; ++I) {
            f32x4m cacc;
            if (wv < 4) {
#pragma unroll
                for (int e = 0; e < 4; ++e) cacc[e] = __uint_as_float((unsigned)(*(const LAS unsigned short*)(lds + L_AT + (16 * I + 4 * kq + e) * CS + n * 2)) << 16);
            } else cacc = *(const LAS f32x4m*)(lds + L_PF + (n - 64) * FS + (16 * I + 4 * kq) * 4);
            if (I > 0) {
#pragma unroll
                for (int ks = 0; ks < 2; ++ks) { const bf16x8 a = *(const LAS bf16x8*)(a_m2 + I * 16 * CS + ks * 64), b2 = *(const LAS bf16x8*)(b_q1 + ks * 64);
                    cacc = __builtin_amdgcn_mfma_f32_16x16x32_bf16(a, b2, cacc, 0, 0, 0); }
            }
            { v4u w; w.x = cvtpk_v(cacc[0], cacc[1]); w.y = cvtpk_v(cacc[2], cacc[3]); *(LAS unsigned long long*)(rtw + c16 * 64 + kq * 8) = (unsigned long long)w.x | ((unsigned long long)w.y << 32); }
            asm volatile("s_waitcnt lgkmcnt(0)" ::: "memory");
            const bf16x8 pa = *(const LAS bf16x8*)(a_pi + I * 1024), rb = *(const LAS bf16x8*)(b_rt);
            f32x4m q = {0.f, 0.f, 0.f, 0.f};
            q = __builtin_amdgcn_mfma_f32_16x16x32_bf16(pa, rb, q, 0, 0, 0);
            { v4u w; w.x = cvtpk_v(q[0], q[1]); w.y = cvtpk_v(q[2], q[3]); *(LAS unsigned long long*)(q1w + c16 * CS + (16 * I + 4 * kq) * 2) = (unsigned long long)w.x | ((unsigned long long)w.y << 32); }
            asm volatile("s_waitcnt lgkmcnt(0)" ::: "memory");
        }
    }
    S1_BAR(); S1T(4);
    int lane3 = lane; asm volatile("" : "+v"(lane3));
    const int hl4 = lane3 >> 5, cl4 = lane3 & 31;
    if (wv < 4) {
        f32x16 aw = {}, as = {};
        mm32(aw, lds + L_M3 + tb * 32 * CS, lds + L_Q1 + ib * 32 * CS, lane3);
        mm32(as, lds + L_BH + tb * 32 * CS, lds + L_Q1 + ib * 32 * CS, lane3);
        const int j = ib * 32 + cl4; const float gl = ((const LAS float*)(lds + L_GL))[j]; const int pc = permcol(j);
#pragma unroll
        for (int rg = 0; rg < 16; ++rg) { const int row = tb * 32 + crow(rg, hl4);
            const float rt = __uint_as_float((unsigned)(*(const LAS unsigned short*)(lds + L_RT + row * CS + j * 2)) << 16);
            st_bf16(lds + L_PF + row * CS + pc * 2, aw[rg] + rt);
            st_bf16(lds + L_PF + 9216 + row * CS + pc * 2, as[rg] + ((row == j) ? gl : 0.f)); }
    } else {
        mm32(accY, lds + L_M3 + tb * 32 * CS, lds + L_Q1 + (64 + ib * 32) * CS, lane3);
        mm32(accQ, lds + L_BH + tb * 32 * CS, lds + L_Q1 + (64 + ib * 32) * CS, lane3);
        const size_t o0 = (m0 + tb * 32 + (lane3 >> 3)) * 1024 + h * 64 + ib * 32 + (lane3 & 7) * 4;
#pragma unroll
        for (int g = 0; g < 4; ++g) { *(f32x4*)(P.Y + o0 + (size_t)g * 8 * 1024) = (f32x4){accY[4 * g], accY[4 * g + 1], accY[4 * g + 2], accY[4 * g + 3]};
            *(f32x4*)(P.DEC + o0 + (size_t)g * 8 * 1024) = (f32x4){accQ[4 * g], accQ[4 * g + 1], accQ[4 * g + 2], accQ[4 * g + 3]}; }
    }
    S1_BAR(); S1T(5);
    { const int row = tid >> 3, pc8 = tid & 7;
      *(v4u*)(P.KP + (m0 + row) * 1024 + h * 64 + pc8 * 8) = *(const LAS v4u*)(lds + L_PF + row * CS + pc8 * 16);
      *(v4u*)(P.AV + (m0 + row) * 1024 + h * 64 + pc8 * 8) = *(const LAS v4u*)(lds + L_PF + 9216 + row * CS + pc8 * 16); }
    S1_BAR(); S1T(6);
}

constexpr int S2_WY = 0, S2_WS = 9216, S2_YI = 18432, S2_QS = 35840, S2_SLOT = 53248;
struct S2Set { v4u p[8]; };
struct S2Role { const unsigned char* gsrc; unsigned gstep; int loff, lstep, np; };
__device__ __forceinline__ S2Role s2_role(const Ptrs& P, int b, int h, int ib, int tid, int wv) {
    S2Role R; const size_t r0 = (size_t)b * SEQ;
    if (wv < 6) { const int t2 = tid & 127, row = t2 >> 3, lp = t2 & 7; const bf16* src = (wv < 4) ? P.KP : P.AV;
        R.gsrc = (const unsigned char*)(src + (r0 + row) * 1024 + h * 64 + lp * 8); R.gstep = 16u * 1024u * 2u; R.loff = ((wv < 4) ? S2_WY : S2_WS) + row * CS + lp * 16; R.lstep = 16 * CS; R.np = 4; }
    else { const int t1 = tid & 63, row = t1 >> 3, yp = t1 & 7; const float* src = (wv == 6) ? P.Y : P.DEC;
        R.gsrc = (const unsigned char*)(src + (r0 + row) * 1024 + h * 64 + ib * 32 + yp * 4); R.gstep = 8u * 1024u * 4u; R.loff = ((wv == 6) ? S2_YI : S2_QS) + row * FS + ib * 128 + yp * 16; R.lstep = 8 * FS; R.np = 8; }
    return R;
}
__device__ __forceinline__ void s2_load(const S2Role& R, int c, S2Set& G) {
    const unsigned char* g = R.gsrc + (size_t)c * 64 * 1024 * ((R.np == 4) ? 2 : 4);
#pragma unroll
    for (int i = 0; i < 8; ++i) G.p[i] = (i < R.np) ? *(const v4u*)(g + (size_t)i * R.gstep) : (v4u){0u, 0u, 0u, 0u};
}
__device__ __forceinline__ void s2_write(LAS unsigned char* slot, const S2Role& R, const S2Set& G) {
#pragma unroll
    for (int i = 0; i < 8; ++i) if (i < R.np) *(LAS v4u*)(slot + R.loff + i * R.lstep) = G.p[i];
}
typedef float f32x8 __attribute__((ext_vector_type(8)));
#define S2_CAT(a, b, c2, d) __builtin_shufflevector(__builtin_shufflevector(a, b, 0, 1, 2, 3, 4, 5, 6, 7), __builtin_shufflevector(c2, d, 0, 1, 2, 3, 4, 5, 6, 7), 0, 1, 2, 3, 4, 5, 6, 7, 8, 9, 10, 11, 12, 13, 14, 15)
constexpr int S2_XCHG = 2 * S2_SLOT;
__device__ __forceinline__ void s2_compute(const Ptrs& P, int b, int h, int ib, int tb, int c, const LAS unsigned char* slot, LAS unsigned char* lds, int lane) {
    const int r = lane & 31, hl = lane >> 5;
    bf16x8 bf[2][2];
    { const LAS unsigned char* xr = lds + S2_XCHG + (c & 1) * 4096 + lane * 16;
#pragma unroll
      for (int jb = 0; jb < 2; ++jb)
#pragma unroll
          for (int ks = 0; ks < 2; ++ks) bf[jb][ks] = *(const LAS bf16x8*)(xr + (jb * 2 + ks) * 1024); }
    const LAS unsigned char* pa = slot + (tb * 32 + r) * CS + hl * 16;
    const LAS unsigned char* pc = slot + (tb * 32 + (lane >> 3)) * FS + ib * 128 + (lane & 7) * 16;
#define S2_TILE(base) S2_CAT(*(const LAS f32x4*)(pc + (base)), *(const LAS f32x4*)(pc + (base) + 8 * FS), *(const LAS f32x4*)(pc + (base) + 16 * FS), *(const LAS f32x4*)(pc + (base) + 24 * FS))
#define S2_AF(base, jb, ks) (*(const LAS bf16x8*)(pa + (base) + (jb) * 64 + (ks) * 32))
    f32x16 y = S2_TILE(S2_YI);
#pragma unroll
    for (int jb = 0; jb < 2; ++jb)
#pragma unroll
        for (int ks = 0; ks < 2; ++ks) y = __builtin_amdgcn_mfma_f32_32x32x16_bf16(S2_AF(S2_WY, jb, ks), bf[jb][ks], y, 0, 0, 0);
    {
        float* cb_ = P.Y + ((size_t)b * SEQ + (size_t)c * 64 + tb * 32) * 1024; const unsigned offY = (unsigned)((4 * hl) * 1024 + h * 64 + ib * 32 + r);
#pragma unroll
        for (int rg = 0; rg < 16; ++rg) { const int rr = (rg & 3) + 8 * (rg >> 2); GAS float* pa_ = (GAS float*)(cb_ + rr * 1024); asm volatile("" : "+s"(pa_)); pa_[offY] = y[rg]; }
    }
    f32x16 q = S2_TILE(S2_QS);
#pragma unroll
    for (int jb = 0; jb < 2; ++jb)
#pragma unroll
        for (int ks = 0; ks < 2; ++ks) q = __builtin_amdgcn_mfma_f32_32x32x16_bf16(S2_AF(S2_WS, jb, ks), bf[jb][ks], q, 0, 0, 0);
    {
        LAS unsigned char* xw = lds + S2_XCHG + ((c + 1) & 1) * 4096 + lane * 16;
#pragma unroll
        for (int ks = 0; ks < 2; ++ks) { v4u w; w.x = cvtpk_v(q[8 * ks], q[8 * ks + 1]); w.y = cvtpk_v(q[8 * ks + 2], q[8 * ks + 3]); w.z = cvtpk_v(q[8 * ks + 4], q[8 * ks + 5]); w.w = cvtpk_v(q[8 * ks + 6], q[8 * ks + 7]);
            *(LAS v4u*)(xw + (tb * 2 + ks) * 1024) = w; }
    }
#undef S2_TILE
#undef S2_AF
}
__device__ __forceinline__ void s2_block(const Ptrs& P, int bh, int ib, LAS unsigned char* lds, int tid, int wv) {
    const int b = bh >> 4, h = bh & 15, lane = tid & 63;
    constexpr int NC = SEQ / 64;
    if (wv < 2) {
        { const v4u z = (v4u){0u, 0u, 0u, 0u}; LAS unsigned char* x0 = lds + S2_XCHG + lane * 16;
#pragma unroll
          for (int ks = 0; ks < 2; ++ks) *(LAS v4u*)(x0 + (wv * 2 + ks) * 1024) = z; }
        S1_BAR();
        for (int c = 0; c < NC; ++c) { s2_compute(P, b, h, ib, wv, c, lds + (c & 1) * S2_SLOT, lds, lane); S1_BAR(); }
    } else {
        S2Set G0, G1, G2; const S2Role R = s2_role(P, b, h, ib, tid, wv);
        s2_load(R, 0, G0); s2_load(R, 1, G1); s2_load(R, 2, G2);
        s2_write(lds, R, G0);
        s2_load(R, 3, G0);
        S1_BAR();
#define S2_STEP(c_, GN) do { if ((c_) + 1 < NC) s2_write(lds + (((c_) + 1) & 1) * S2_SLOT, R, GN); if ((c_) + 4 < NC) s2_load(R, (c_) + 4, GN); S1_BAR(); } while (0)
        int c = 0;
        for (; c + 2 < NC; c += 3) { S2_STEP(c, G1); S2_STEP(c + 1, G2); S2_STEP(c + 2, G0); }
        if (c < NC) { S2_STEP(c, G1); ++c; }
        if (c < NC) { S2_STEP(c, G2); ++c; }
#undef S2_STEP
    }
}
#undef S2_CAT
}
__device__ __forceinline__ unsigned enc_key(float s) { const unsigned b = __float_as_uint(s); return b ^ ((b >> 31) ? 0xFFFFFFFFu : 0x80000000u); }
__device__ __forceinline__ float dec_key(unsigned u) { const unsigned b = (u & 0x80000000u) ? (u ^ 0x80000000u) : ~u; return __uint_as_float(b); }
__device__ __forceinline__ void ins16(unsigned (&L)[16], unsigned x) {
#pragma unroll
    for (int i = 0; i < 16; ++i) { const unsigned hi = max(L[i], x); x = min(L[i], x); L[i] = hi; }
}
__device__ __forceinline__ void ce_asc(unsigned& a, unsigned& b) { const unsigned lo = a < b ? a : b, hi = a < b ? b : a; a = lo; b = hi; }
__device__ __forceinline__ void sort16_asc(unsigned (&x)[16]) {
    constexpr unsigned char CA[63] = {0,2,4,6,0,1,4,5,1,5,0,3,1,2,1,3,2,3,3, 8,10,12,14,8,9,12,13,9,13,8,11,9,10,9,11,10,11,11, 0,4,4,2,6,6,2,6,10,1,5,5,3,7,7,3,7,11,1,3,5,7,9,11,13};
    constexpr unsigned char CB[63] = {1,3,5,7,2,3,6,7,2,6,4,7,5,6,4,6,4,5,4, 9,11,13,15,10,11,14,15,10,14,12,15,13,14,12,14,12,13,12, 8,12,8,10,14,10,4,8,12,9,13,9,11,15,11,5,9,13,2,4,6,8,10,12,14};
#pragma unroll
    for (int i = 0; i < 63; ++i) ce_asc(x[CA[i]], x[CB[i]]);
}
__device__ __forceinline__ void merge16_desc(unsigned (&L)[16], const unsigned (&Basc)[16]) {
#pragma unroll
    for (int i = 0; i < 16; ++i) L[i] = L[i] > Basc[i] ? L[i] : Basc[i];
#pragma unroll
    for (int j = 8; j > 0; j >>= 1)
#pragma unroll
        for (int i = 0; i < 16; ++i) { const int l = i ^ j; if (l > i) ce_asc(L[l], L[i]); }
}
constexpr int TK_CS = 144, TK_LO = 36864;
__device__ __forceinline__ void topk_pass(const Ptrs& P, int h, int tok0, const LAS unsigned char* lds, const int p, int lane, int w, unsigned (&L0)[16], unsigned (&L1)[16]) {
    const int r = lane & 31, hi = lane >> 5;
#pragma unroll
    for (int i = 0; i < 16; ++i) { L0[i] = 0u; L1[i] = 0u; }
    bf16x8 qf[2][4];
#pragma unroll
    for (int tt = 0; tt < 2; ++tt)
#pragma unroll
        for (int ks = 0; ks < 4; ++ks) qf[tt][ks] = *(const bf16x8*)(P.QP + (size_t)(tok0 + w * 64 + tt * 32 + r) * 1024 + h * 128 + p * 64 + ks * 16 + hi * 8);
    const LAS unsigned char* ka = lds + (size_t)(p * 128 + r) * TK_CS + hi * 16;
#pragma unroll
    for (int nt = 0; nt < 4; ++nt) {
        bf16x8 ah[4], al[4];
#pragma unroll
        for (int ks = 0; ks < 4; ++ks) { ah[ks] = *(const LAS bf16x8*)(ka + nt * 32 * TK_CS + ks * 32); al[ks] = *(const LAS bf16x8*)(ka + TK_LO + nt * 32 * TK_CS + ks * 32); }
        rk::f32x16 acc0 = {}, acc1 = {};
#pragma unroll
        for (int ks = 0; ks < 4; ++ks) { acc0 = __builtin_amdgcn_mfma_f32_32x32x16_bf16(ah[ks], qf[0][ks], acc0, 0, 0, 0); acc0 = __builtin_amdgcn_mfma_f32_32x32x16_bf16(al[ks], qf[0][ks], acc0, 0, 0, 0);
            acc1 = __builtin_amdgcn_mfma_f32_32x32x16_bf16(ah[ks], qf[1][ks], acc1, 0, 0, 0); acc1 = __builtin_amdgcn_mfma_f32_32x32x16_bf16(al[ks], qf[1][ks], acc1, 0, 0, 0); }
        unsigned B0[16], B1[16];
#pragma unroll
        for (int rg = 0; rg < 16; ++rg) { const unsigned tag = (unsigned)(127 - (nt * 32 + (rg & 3) + 8 * (rg >> 2) + 4 * hi));
            B0[rg] = (enc_key(acc0[rg]) & ~0x7Fu) | tag; B1[rg] = (enc_key(acc1[rg]) & ~0x7Fu) | tag; }
        sort16_asc(B0); sort16_asc(B1);
        if (nt == 0) {
#pragma unroll
            for (int i = 0; i < 16; ++i) { L0[i] = B0[15 - i]; L1[i] = B1[15 - i]; }
        } else { merge16_desc(L0, B0); merge16_desc(L1, B1); }
    }
}
__device__ __forceinline__ void peer_topk(const Ptrs& P, int h, int tok0, LAS unsigned char* lds, int tid_in) {
    int tid = tid_in; asm volatile("" : "+v"(tid));
    const int lane = tid & 63, w = tid >> 6, r = lane & 31, hi = lane >> 5;
    {
        const int row = tid >> 1, d0 = (tid & 1) * 32; const float* src = P.sub_keys + ((size_t)h * 256 + row) * 64 + d0;
#pragma unroll
        for (int j = 0; j < 4; ++j) { const f32x4 a = *(const f32x4*)(src + 8 * j), b = *(const f32x4*)(src + 8 * j + 4);
            const float x[8] = {a.x, a.y, a.z, a.w, b.x, b.y, b.z, b.w}; float lo[8]; v4u vh, vl;
#pragma unroll
            for (int e = 0; e < 8; ++e) { const float hb = __uint_as_float(f2bf(x[e]) << 16); lo[e] = x[e] - hb; }
            vh.x = pk2(x[0], x[1]); vh.y = pk2(x[2], x[3]); vh.z = pk2(x[4], x[5]); vh.w = pk2(x[6], x[7]);
            vl.x = pk2(lo[0], lo[1]); vl.y = pk2(lo[2], lo[3]); vl.z = pk2(lo[4], lo[5]); vl.w = pk2(lo[6], lo[7]);
            *(LAS v4u*)(lds + row * TK_CS + (d0 + 8 * j) * 2) = vh; *(LAS v4u*)(lds + TK_LO + row * TK_CS + (d0 + 8 * j) * 2) = vl; }
    }
    __syncthreads();
    unsigned L00[16], L01[16], L10[16], L11[16];
    topk_pass(P, h, tok0, lds, 0, lane, w, L00, L01);
    topk_pass(P, h, tok0, lds, 1, lane, w, L10, L11);
    unsigned M1[2][16];
#pragma unroll
    for (int i = 0; i < 16; ++i) { M1[0][i] = hi ? L01[i] : L00[i]; M1[1][i] = hi ? L11[i] : L10[i]; }
    { unsigned R0[16], R1[16];
#pragma unroll
      for (int i = 0; i < 16; ++i) { const unsigned s0 = hi ? L00[i] : L01[i], s1 = hi ? L10[i] : L11[i]; R0[15 - i] = (unsigned)__shfl_xor((int)s0, 32); R1[15 - i] = (unsigned)__shfl_xor((int)s1, 32); }
      merge16_desc(M1[0], R0); merge16_desc(M1[1], R1); }
    const int t = tok0 + w * 64 + hi * 32 + r;
    unsigned F[16];
#pragma unroll
    for (int i = 0; i < 16; ++i) F[i] = 0u;
    float v1[16], v2[16];
#pragma unroll
    for (int i = 0; i < 16; ++i) { v1[i] = dec_key((M1[0][i] & ~0x7Fu) | 0x40u); v2[i] = dec_key((M1[1][i] & ~0x7Fu) | 0x40u); }
    {
        constexpr int CA[64] = {0,0,0,0,0,0,0,0,0,0,0,0,0,0,0,0, 1,1,1,1,1,1,1,1, 2,2,2,2,2, 3,3,3,3, 4,4,4, 5,5, 6,6, 7,7, 8, 9, 10, 11, 12, 13, 14, 15, 0,0,0,0,0,0,0,0,0,0,0,0,0,0};
        constexpr int CB[64] = {0,1,2,3,4,5,6,7,8,9,10,11,12,13,14,15, 0,1,2,3,4,5,6,7, 0,1,2,3,4, 0,1,2,3, 0,1,2, 0,1, 0,1, 0,1, 0, 0, 0, 0, 0, 0, 0, 0, 0,0,0,0,0,0,0,0,0,0,0,0,0,0};
#pragma unroll
        for (int bt = 0; bt < 4; ++bt) { unsigned Bc[16];
#pragma unroll
            for (int i = 0; i < 16; ++i) { const int c_ = bt * 16 + i; Bc[i] = (c_ < 50) ? ((enc_key(v1[CA[c_]] + v2[CB[c_]]) & ~0xFFu) | (unsigned)(255 - (16 * CA[c_] + CB[c_]))) : 0u; }
            if (bt == 0) {
#pragma unroll
                for (int i = 0; i < 16; ++i) F[i] = Bc[i];
            } else { sort16_asc(Bc); merge16_desc(F, Bc); } }
    }
    float sv[16]; unsigned id[16];
    unsigned TA[4] = {0u, 0u, 0u, 0u}, TB[4] = {0u, 0u, 0u, 0u};
#pragma unroll
    for (int j = 0; j < 16; ++j) { TA[j >> 2] |= (127u - (M1[0][j] & 0x7Fu)) << (8 * (j & 3)); TB[j >> 2] |= (127u - (M1[1][j] & 0x7Fu)) << (8 * (j & 3)); }
#pragma unroll
    for (int i = 0; i < 16; ++i) {
        sv[i] = dec_key((F[i] & ~0xFFu) | 0x80u);
        const unsigned ab = 255u - (F[i] & 0xFFu), a = ab >> 4, b = ab & 15u;
        const unsigned la0 = __builtin_amdgcn_perm(TA[1], TA[0], a & 7u), la1 = __builtin_amdgcn_perm(TA[3], TA[2], a & 7u);
        const unsigned lb0 = __builtin_amdgcn_perm(TB[1], TB[0], b & 7u), lb1 = __builtin_amdgcn_perm(TB[3], TB[2], b & 7u);
        const unsigned la = ((a & 8u) ? la1 : la0) & 0xFFu, lb = ((b & 8u) ? lb1 : lb0) & 0xFFu;
        id[i] = la * 128u + lb;
    }
    float z = 0.f;
#pragma unroll
    for (int i = 0; i < 16; ++i) { sv[i] = __expf(sv[i] - sv[0]); z += sv[i]; }
    const float rz = 1.0f / z;
    float* gdst = P.GATE + (size_t)t * 128 + h * 16;
#pragma unroll
    for (int i = 0; i < 16; i += 4) *(f32x4*)(gdst + i) = (f32x4){sv[i] * rz, sv[i + 1] * rz, sv[i + 2] * rz, sv[i + 3] * rz};
    unsigned short* idst = P.IDX + (size_t)t * 128 + h * 16;
    *(v4u*)idst = (v4u){id[0] | (id[1] << 16), id[2] | (id[3] << 16), id[4] | (id[5] << 16), id[6] | (id[7] << 16)};
    *(v4u*)(idst + 8) = (v4u){id[8] | (id[9] << 16), id[10] | (id[11] << 16), id[12] | (id[13] << 16), id[14] | (id[15] << 16)};
    __syncthreads();
}

__device__ __forceinline__ float gelu_erf(float x) { return 0.5f * x * (1.0f + erff(x * 0.70710678118654752f)); }
typedef float f32x2v __attribute__((ext_vector_type(2)));
__device__ __forceinline__ void ld_row4(const unsigned char* row, int lane, float (&r)[32]) {
    const v4u u = *(const v4u*)(row + lane * 16); const unsigned w[4] = {u.x, u.y, u.z, u.w};
#pragma unroll
    for (int d = 0; d < 4; ++d) {
        const f32x2v a = __builtin_amdgcn_cvt_scalef32_pk_f32_fp4(w[d], 1.0f, 0), b = __builtin_amdgcn_cvt_scalef32_pk_f32_fp4(w[d], 1.0f, 1), c2 = __builtin_amdgcn_cvt_scalef32_pk_f32_fp4(w[d], 1.0f, 2), d2 = __builtin_amdgcn_cvt_scalef32_pk_f32_fp4(w[d], 1.0f, 3);
        r[8 * d] = a.x; r[8 * d + 1] = a.y; r[8 * d + 2] = b.x; r[8 * d + 3] = b.y; r[8 * d + 4] = c2.x; r[8 * d + 5] = c2.y; r[8 * d + 6] = d2.x; r[8 * d + 7] = d2.y; }
}
__device__ __forceinline__ void ld_row4p(const unsigned char* row, int lane, f32x2v (&r)[16]) {
    const v4u u = *(const v4u*)(row + lane * 16); const unsigned w[4] = {u.x, u.y, u.z, u.w};
#pragma unroll
    for (int d = 0; d < 4; ++d) { r[4 * d] = __builtin_amdgcn_cvt_scalef32_pk_f32_fp4(w[d], 1.0f, 0); r[4 * d + 1] = __builtin_amdgcn_cvt_scalef32_pk_f32_fp4(w[d], 1.0f, 1);
        r[4 * d + 2] = __builtin_amdgcn_cvt_scalef32_pk_f32_fp4(w[d], 1.0f, 2); r[4 * d + 3] = __builtin_amdgcn_cvt_scalef32_pk_f32_fp4(w[d], 1.0f, 3); }
}
__device__ __forceinline__ void peer_token(const Ptrs& P, int t, int lane) {
    float x2[32];
    const float ssl = __builtin_nontemporal_load(P.SSQ + (size_t)t * 32 + (lane & 31));
    unsigned idxv[2]; float wv[2], gate[2];
#pragma unroll
    for (int kb = 0; kb < 2; ++kb) { idxv[kb] = __builtin_nontemporal_load(P.IDX + (size_t)t * 128 + kb * 64 + lane); gate[kb] = __builtin_nontemporal_load(P.GATE + (size_t)t * 128 + kb * 64 + lane); }
    const float ss_t = wave_sum(lane < 32 ? ssl : 0.f);
    const float rs_t = 1.0f / sqrtf(ss_t * (1.0f / DMODEL) + 1e-6f);
    float* orow = P.out + (size_t)t * 2048 + lane * 4;
    f32x4 ov[8];
#pragma unroll
    for (int j = 0; j < 8; ++j) ov[j] = __builtin_nontemporal_load((const f32x4*)(orow + 256 * j));
#pragma unroll
    for (int j = 0; j < 8; ++j) { const f32x4 g = *(const f32x4*)(P.norm2_g + 256 * j + lane * 4);
        x2[4 * j] = ov[j].x * g.x * rs_t; x2[4 * j + 1] = ov[j].y * g.y * rs_t; x2[4 * j + 2] = ov[j].z * g.z * rs_t; x2[4 * j + 3] = ov[j].w * g.w * rs_t; }
#pragma unroll
    for (int kb = 0; kb < 2; ++kb) {
        float p[64];
#pragma unroll
        for (int i = 0; i < 64; ++i) {
            const unsigned e = (unsigned)__builtin_amdgcn_readlane((int)idxv[kb], i);
            f32x2v r[16]; ld_row4p(P.U8 + (size_t)e * ROW6, lane, r);
            f32x2v a0 = {0.f, 0.f}, a1 = {0.f, 0.f};
#pragma unroll
            for (int q = 0; q < 8; ++q) { a0 = __builtin_elementwise_fma(r[2 * q], (f32x2v){x2[4 * q], x2[4 * q + 1]}, a0); a1 = __builtin_elementwise_fma(r[2 * q + 1], (f32x2v){x2[4 * q + 2], x2[4 * q + 3]}, a1); }
            p[i] = (a0.x + a0.y) + (a1.x + a1.y);
        }
#pragma unroll
        for (int o = 32, n = 64; o >= 1; o >>= 1, n >>= 1) {
            const bool up = (lane & o) != 0;
#pragma unroll
            for (int i = 0; i < n / 2; ++i) { const float keep = up ? p[i + n / 2] : p[i], send = up ? p[i] : p[i + n / 2]; p[i] = keep + __shfl_xor(send, o); }
        }
        const unsigned e = idxv[kb];
        const f32x2v sc = *(const f32x2v*)(P.USC + 2 * (size_t)e);
        const float hk = gelu_erf(p[0] * sc.x);
        wv[kb] = gate[kb] * hk * sc.y;
    }
    float acc[32];
#pragma unroll
    for (int i = 0; i < 32; ++i) acc[i] = 0.f;
#pragma unroll
    for (int kb = 0; kb < 2; ++kb) {
#pragma unroll 16
        for (int i = 0; i < 64; ++i) {
            const unsigned e = (unsigned)__builtin_amdgcn_readlane((int)idxv[kb], i);
            const float wk = __uint_as_float((unsigned)__builtin_amdgcn_readlane((int)__float_as_uint(wv[kb]), i));
            f32x2v r[16]; ld_row4p(P.V8 + (size_t)e * ROW6, lane, r);
            const f32x2v wk2 = {wk, wk};
#pragma unroll
            for (int q = 0; q < 16; ++q) { const f32x2v a = __builtin_elementwise_fma(r[q], wk2, (f32x2v){acc[2 * q], acc[2 * q + 1]}); acc[2 * q] = a.x; acc[2 * q + 1] = a.y; }
        }
    }
#pragma unroll
    for (int q = 0; q < 8; ++q) { f32x4* o = (f32x4*)(orow + 256 * q); f32x4 v = ov[q];
        v.x += acc[4 * q]; v.y += acc[4 * q + 1]; v.z += acc[4 * q + 2]; v.w += acc[4 * q + 3]; __builtin_nontemporal_store(v, o); }
}
struct AttnQueue {
    gu32* ctr; volatile LAS unsigned* slot; int tid; unsigned q0;
    __device__ __forceinline__ bool next(int i, attn_body::AttnUnit& u) const {
        if (tid == 0) {
            unsigned k = slot[2], v = 0xFFFFFFFFu;
            while (k < 8u) { const unsigned q = (q0 + k) & 7u; const unsigned t = __hip_atomic_fetch_add(ctr + 64 * q, 1u, RLX_AGENT); if (t < 128u) { v = (q << 16) | t; break; } ++k; }
            slot[2] = k; slot[i & 1] = v;
        }
        __syncthreads();
        const unsigned v = (unsigned)__builtin_amdgcn_readfirstlane((int)slot[i & 1]);
        if (v == 0xFFFFFFFFu) return false;
        const unsigned q = v >> 16, t = v & 0xFFFFu;
        u.qb = 31 - (int)(t >> 2); u.bh = (int)(q + 8u * (t & 3u)); return true;
    }
    __device__ __forceinline__ void a_ready(const attn_body::AttnUnit&) const {}
    __device__ __forceinline__ void done(const attn_body::AttnUnit&) const {}
};

struct Args { const float* in[23]; float* out; unsigned char* ws; };

__device__ __forceinline__ int lane_id_fresh() { int l; asm volatile("v_mbcnt_lo_u32_b32 %0, -1, 0\n\tv_mbcnt_hi_u32_b32 %0, -1, %0" : "=v"(l)); return l; }
__device__ __forceinline__ Frame make_frame(unsigned char* lds, int wv) {
    Frame F; F.lds = (LAS unsigned char*)lds; F.MISC = (volatile LAS unsigned*)(F.lds + MISC_OFF); F.ctl = nullptr;
    F.lane = lane_id_fresh(); F.wave = wv; F.tid = wv * 64 + F.lane;
    F.G = gridDim.x; { const int bx = blockIdx.x; F.vcu = (F.G % 8 == 0) ? (bx % 8) * (F.G / 8) + bx / 8 : bx; }
    return F;
}
typedef __attribute__((address_space(4))) const unsigned long long kau64;
__device__ __forceinline__ Ptrs make_ptrs(kau64* ka) {
    Ptrs P; struct { const float* in[23]; } args;
#pragma unroll
    for (int i = 0; i < 23; ++i) args.in[i] = (const float*)(GAS const float*)ka[i];
    float* outp = (float*)(GAS float*)ka[23]; unsigned char* ws = (unsigned char*)(GAS unsigned char*)ka[24];
    P.x = args.in[0]; P.norm1_g = args.in[1]; P.w_in = args.in[2]; P.mu = args.in[3]; P.w_decay_up = args.in[4]; P.w0 = args.in[5]; P.w_iclr_up = args.in[6]; P.a0 = args.in[7];
    P.w_gate_up = args.in[8]; P.k_k = args.in[9]; P.k_a = args.in[10]; P.r_k = args.in[11]; P.lnx_g = args.in[12]; P.lnx_b = args.in[13]; P.fox_b_f = args.in[14];
    P.q_norm_g = args.in[15]; P.k_norm_g = args.in[16]; P.w_out = args.in[17]; P.norm2_g = args.in[18]; P.w_q = args.in[19]; P.sub_keys = args.in[20]; P.peer_u = args.in[21]; P.peer_v = args.in[22];
    P.out = outp;
    P.WQT = (bf16*)(ws + WS_WQT); P.LWT = (bf16*)(ws + WS_LWT); P.WOT = (bf16*)(ws + WS_WOT); P.WINT = (bf16*)(ws + WS_WINT); P.LA = (bf16*)(ws + WS_LA);
    P.XN = (bf16*)(ws + WS_XN); P.PROJ = (bf16*)(ws + WS_PROJ); P.MIXED = (bf16*)(ws + WS_MIXED); P.KP = (bf16*)(ws + WS_KP); P.AV = (bf16*)(ws + WS_AV); P.BV = (bf16*)(ws + WS_BV);
    P.QP = (bf16*)(ws + WS_QP); P.G = (bf16*)((unsigned char*)outp + OUT_G); P.AIC = (bf16*)((unsigned char*)outp + OUT_AIC);
    P.C2 = (float*)(ws + WS_C2); P.BON = (float*)(ws + WS_BON); P.Y = (float*)(ws + WS_XN); P.DEC = (float*)((unsigned char*)outp + OUT_DEC);
    P.GATE = (float*)(ws + WS_GATE); P.USC = (float*)(ws + WS_USC); P.VSC = (float*)(ws + WS_VSC); P.SSQ = (float*)(ws + WS_SSQ);
    P.IDX = (unsigned short*)(ws + WS_IDX); P.U8 = ws + WS_U8; P.V8 = ws + WS_V8;
    return P;
}
#define PHASE_BEGIN() Frame F = make_frame(lds, wv_); const int gw = F.vcu * NWAVES + F.wave, NGW = F.G * NWAVES; (void)gw; (void)NGW; kau64* ka_ = (kau64*)__builtin_amdgcn_kernarg_segment_ptr(); asm volatile("" : "+s"(ka_)); \
    const Ptrs P = make_ptrs(ka_); unsigned char* ws_ = (unsigned char*)(GAS unsigned char*)ka_[24]; (void)ws_; \
    const int lane = F.lane, tid = F.tid; (void)lane; (void)tid
constexpr int TBL_SPLIT = 2 * NEXP - 10240;
__global__ void __launch_bounds__(NWAVES * 64, 2) hymba_fwd(Args args) {
    extern __shared__ __attribute__((aligned(16))) unsigned char lds[];
    const int wv_ = __builtin_amdgcn_readfirstlane((int)threadIdx.x >> 6);
    { Frame F = make_frame(lds, wv_);
    for (int u = F.tid; u < (LDS_BYTES - LDSCTL_OFF) / 4; u += NWAVES * 64) ((LAS unsigned*)(F.lds + LDSCTL_OFF))[u] = 0u;
    __syncthreads();
    { kau64* kb_ = (kau64*)__builtin_amdgcn_kernarg_segment_ptr(); F.ctl = (gu32*)((GAS unsigned char*)kb_[24] + WS_CTL); }
    (void)xcd_barrier_post((unsigned*)(F.ctl + CW_BAR), F.MISC + 8, F.tid); }
#ifdef PROBE_MASK
#define STAMP(k) do { if (blockIdx.x == 0 && wv_ == 0) { unsigned long long t_; __builtin_amdgcn_sched_barrier(0); asm volatile("s_memrealtime %0\n\ts_waitcnt lgkmcnt(0)" : "=s"(t_) :: "memory"); __builtin_amdgcn_sched_barrier(0); if (lane_id_fresh() == 0) { ((volatile LAS unsigned*)((LAS unsigned char*)lds + MISC_OFF))[64 + (k)] = (unsigned)t_; } } } while (0)
#else
#define STAMP(k) do {} while (0)
#endif
#define GRID_BAR() do { kau64* kb_ = (kau64*)__builtin_amdgcn_kernarg_segment_ptr(); asm volatile("" : "+s"(kb_)); XcdBarrier b_; b_.bar = (unsigned*)((gu32*)((GAS unsigned char*)kb_[24] + WS_CTL) + CW_BAR); b_.x = xb_xcc_id(); b_.st = (volatile LAS unsigned*)((LAS unsigned char*)lds + MISC_OFF) + 8; xcd_barrier(b_, wv_ * 64 + lane_id_fresh()); } while (0)

    STAMP(0);
    { PHASE_BEGIN();
        LAS float* scr = (LAS float*)(F.lds + RING_OFF + F.wave * 16384);
        constexpr int B_IN = 32 * 26, B_O = 32 * 8, B_Q = 32 * 4, I_L = 2 * 32;
        {
            auto item_of = [&](int it) -> TrItem { int r = it;
                if (r < B_IN) return TrItem{P.w_in, P.WINT, 2048, NIN, 2048, r / 26, r % 26}; r -= B_IN;
                if (r < B_O) return TrItem{P.w_out, P.WOT, 2048, 2048, 2048, r / 8, r % 8}; r -= B_O;
                return TrItem{P.w_q, P.WQT, 2048, 1024, 2048, r / 4, r % 4}; };
            LAS float* bscr = (LAS float*)(F.lds + RING_OFF); TrRegs T0, T1; int it = (int)blockIdx.x;
            if (it < B_IN + B_O + B_Q) tr_load(item_of(it), tid, T0);
            for (; it < B_IN + B_O + B_Q; it += F.G) { const int nx = it + F.G;
                if (nx < B_IN + B_O + B_Q) tr_load(item_of(nx), tid, T1);
                tr_finish(item_of(it), T0, bscr, tid); T0 = T1; }
        }
        for (int it = gw; it < 3 * I_L; it += NGW) {
            int r = it;
            if (r < I_L) { p0_transpose_item(P.w_decay_up, 64, 1024, P.LWT, 128, scr, r / 32, r % 32, lane); continue; } r -= I_L;
            if (r < I_L) { p0_transpose_item(P.w_iclr_up, 64, 1024, P.LWT + 1024 * 128, 128, scr, r / 32, r % 32, lane); continue; } r -= I_L;
            p0_transpose_item(P.w_gate_up, 128, 1024, P.LWT + 2 * 1024 * 128, 128, scr, r / 32, r % 32, lane);
        }
        STAMP(16);
        { const int rem1 = ((M / 256) * (PJ / 256)) % F.G; table_rows(P, 0, rem1 != 0 ? TBL_SPLIT : 2 * NEXP, gw, NGW, lane); }
        STAMP(17);
        xn_rows(P, gw, NGW, lane);
    }
    GRID_BAR(); STAMP(1);
    { PHASE_BEGIN();
        pg8::Gemm g{P.XN, P.WINT, M, PJ, DMODEL}; pg8::StaticOrder S; S.init(M, PJ, F.G, (int)blockIdx.x);
        pg8::EpiBf16<0> E{P.PROJ, PJ, nullptr, 0, 0, 1.f};
        pg8::gemm_phase<pg8::EpiBf16<0>, pg8::StaticOrder, PG8_ALIGN, PG8_SP2>(F.lds + RING_OFF, g, S, E, tid);
        { const int rem1 = ((M / 256) * (PJ / 256)) % F.G;
          if (rem1 != 0 && (int)blockIdx.x >= rem1) table_rows(P, TBL_SPLIT, 2 * NEXP, ((int)blockIdx.x - rem1) * NWAVES + F.wave, (F.G - rem1) * NWAVES, lane); }
    }
    GRID_BAR(); STAMP(2);
    { PHASE_BEGIN();
        for (int c = F.vcu; c < FOX_NCH; c += F.G) fox_scan_local(P, c, F.wave, lane);
        prep_phase(P, gw, NGW, lane);
    }
    GRID_BAR(); STAMP(3);
    { PHASE_BEGIN();
        for (int c = F.vcu; c < FOX_NCH; c += F.G) fox_scan_fix(P, c, F.wave, lane);
        pg8::Gemm g{P.LA, P.LWT, M, 3072, 128, 4, (size_t)M * 128 * 2}; pg8::StaticOrder S; S.init(M, 3072, F.G, (int)blockIdx.x);
        pg8::EpiLora3 E{P.w0, P.a0, P.DEC, P.AIC, P.G};
        pg8::gemm_phase<pg8::EpiLora3, pg8::StaticOrder, PG8_ALIGN, PG8_SP2>(F.lds + RING_OFF, g, S, E, tid);
    }
    GRID_BAR(); STAMP(4);
    STAMP(5);
    { PHASE_BEGIN(); rk::S1Regs R; int u = (int)blockIdx.x; if (u < 4096) rk::s1_load(P, u, tid, R);
#ifdef PROBE_MASK
      if (blockIdx.x == 0 && F.wave == 0) { unsigned long long t_; asm volatile("s_memrealtime %0\n\ts_waitcnt lgkmcnt(0)" : "=s"(t_) :: "memory"); if (lane == 0) ((volatile LAS unsigned*)((LAS unsigned char*)lds + MISC_OFF))[103] = (unsigned)t_; }
#endif
      for (; u < 4096; u += F.G) rk::s1_unit(P, u, u + F.G, R, F.lds + RING_OFF, tid, F.wave); }
    GRID_BAR(); STAMP(13);
    { PHASE_BEGIN();
        if (blockIdx.x < 64) rk::s2_block(P, (int)blockIdx.x >> 1, (int)blockIdx.x & 1, F.lds + RING_OFF, tid, F.wave);
        STAMP(18);
        {
            static_assert(attn_body::ATTN_LDS_BYTES <= RING_BYTES, "attention LDS");
            const attn_body::AttnTensors AT{(const attn_body::bf16*)(P.PROJ + C_FQ), (const attn_body::bf16*)(P.PROJ + C_FK), (const attn_body::bf16*)(P.PROJ + C_FV), (attn_body::bf16*)(P.MIXED + 1024), P.C2};
            const AttnQueue S{(gu32*)(ws_ + WS_CTL) + CW_QUEUE, F.MISC + 16, tid, xb_xcc_id() & 7u};
            attn_body::attn_phase<AttnQueue>((char*)lds + RING_OFF, AT, S, tid);
            STAMP(14);
        }
    }
    GRID_BAR(); STAMP(6);
    { PHASE_BEGIN();
        post_phase(P, gw, NGW, lane);
    }
    GRID_BAR(); STAMP(7);
    { PHASE_BEGIN();
        pg8::Gemm g{P.MIXED, P.WOT, M, DMODEL, DMODEL}; pg8::StaticOrder S; S.init(M, DMODEL, F.G, (int)blockIdx.x);
        pg8::EpiResNorm E{P.x, P.out, P.XN, P.norm2_g, (float*)(ws_ + WS_SSQ), DMODEL};
        pg8::gemm_phase<pg8::EpiResNorm, pg8::StaticOrder, PG8_ALIGN, PG8_SP2>(F.lds + RING_OFF, g, S, E, tid);
    }
    GRID_BAR(); STAMP(8);
    STAMP(9);
    { PHASE_BEGIN();
        pg8::Gemm g{P.XN, P.WQT, M, 1024, DMODEL}; pg8::StaticOrder S; S.init(M, 1024, F.G, (int)blockIdx.x);
        pg8::EpiBf16RowNorm E{P.QP, 1024, (const float*)(ws_ + WS_SSQ), 1.0f / DMODEL, 1e-6f};
        pg8::gemm_phase<pg8::EpiBf16RowNorm, pg8::StaticOrder, PG8_ALIGN, PG8_SP2>(F.lds + RING_OFF, g, S, E, tid);
    }
    GRID_BAR(); STAMP(10);
    { PHASE_BEGIN(); for (int it = (int)blockIdx.x; it < 8 * (M / 512); it += F.G) peer_topk(P, it & 7, (it >> 3) * 512, F.lds + RING_OFF, tid); }
    GRID_BAR(); STAMP(11);
    { PHASE_BEGIN(); for (int t = gw; t < M; t += NGW) peer_token(P, t, lane); }
#ifdef PROBE_MASK
    GRID_BAR();
    STAMP(12);
    if (blockIdx.x == 0 && wv_ == 0) { asm volatile("s_waitcnt lgkmcnt(0)" ::: "memory"); volatile LAS unsigned* ts_ = (volatile LAS unsigned*)((LAS unsigned char*)lds + MISC_OFF) + 64; unsigned tot = 0;
      for (int k = 0; k < 12; ++k) if ((PROBE_MASK >> k) & 1) tot += ts_[k + 1] - ts_[k];
      if ((PROBE_MASK >> 12) & 1) tot += ts_[13] - ts_[5];
      if ((PROBE_MASK >> 13) & 1) tot += ts_[6] - ts_[13];
      if ((PROBE_MASK >> 15) & 1) tot += ts_[15] - ts_[11];
      if ((PROBE_MASK >> 16) & 1) tot += ts_[12] - ts_[15];
      for (int k = 0; k < 7; ++k) if ((PROBE_MASK >> (17 + k)) & 1) tot += ((volatile LAS unsigned*)((LAS unsigned char*)lds + MISC_OFF))[96 + k];
      if ((PROBE_MASK >> 24) & 1) tot += ts_[16] - ts_[0];
      if ((PROBE_MASK >> 25) & 1) tot += ts_[17] - ts_[16];
      if ((PROBE_MASK >> 26) & 1) tot += ts_[1] - ts_[17];
      if ((PROBE_MASK >> 27) & 1) tot += ts_[18] - ts_[13];
      if ((PROBE_MASK >> 28) & 1) tot += ts_[14] - ts_[18];
      if ((PROBE_MASK >> 14) & 1) tot += ts_[14] - ts_[13];
      if ((PROBE_MASK >> 29) & 1) tot += ts_[19] - ts_[5];
      const unsigned long long t0_ = __builtin_amdgcn_s_memrealtime(); while ((unsigned)(__builtin_amdgcn_s_memrealtime() - t0_) < tot) __builtin_amdgcn_s_sleep(8); }
#endif
}

extern "C" void kernel_launch(void* const* d_in, const int* in_sizes, int n_in, void* d_out, int out_size, void* d_ws, size_t ws_size, hipStream_t stream) {
    static int grid = 0;
    if (grid == 0) {
        if (n_in != 23 || out_size != M * DMODEL || ws_size < WS_END) { fprintf(stderr, "kernel_launch: unexpected shapes (n_in %d, out %d, ws %zu); nothing launched\n", n_in, out_size, ws_size); grid = -1; return; }
        int dev = 0, cus = 0;
        if (hipGetDevice(&dev) != hipSuccess || hipDeviceGetAttribute(&cus, hipDeviceAttributeMultiprocessorCount, dev) != hipSuccess) { grid = -1; return; }
        if (hipFuncSetAttribute((const void*)hymba_fwd, hipFuncAttributeMaxDynamicSharedMemorySize, LDS_BYTES) != hipSuccess) { fprintf(stderr, "kernel_launch: hipFuncSetAttribute failed\n"); grid = -1; return; }
        int per_cu = 0;
        if (hipOccupancyMaxActiveBlocksPerMultiprocessor(&per_cu, (const void*)hymba_fwd, NWAVES * 64, LDS_BYTES) != hipSuccess || per_cu < 1) fprintf(stderr, "kernel_launch: occupancy query reports %d\n", per_cu);
        (void)hipGetLastError();
        grid = cus;
    }
    if (grid < 0) return;
    if (hipMemsetAsync((char*)d_ws + WS_CTL, 0, CTL_ZERO_BYTES, stream) != hipSuccess) return;
    Args a{};
    for (int i = 0; i < 23; ++i) a.in[i] = (const float*)d_in[i];
    a.out = (float*)d_out; a.ws = (unsigned char*)d_ws;
    hipLaunchKernelGGL(hymba_fwd, dim3(grid), dim3(NWAVES * 64), LDS_BYTES, stream, a);
}
```
